# Optimizing an MI355X kernel written in HIP

```python
import jax, jax.numpy as jnp
from jax import lax
import numpy as np

D_MODEL = 2048
BATCH = 4
SEQ = 8192
DEPTH = 1

D_MIX = D_MODEL
D_CONV = D_MIX // 2
CONV_WIDTH = 3
N_HEADS = 8
HEAD_DIM = 128
D_ATTN = N_HEADS * HEAD_DIM
N_KV_HEADS = 2
GQA_GROUP = N_HEADS // N_KV_HEADS
D_KV = N_KV_HEADS * HEAD_DIM
N_BRANCH = 3
CMP_LEN = 32
CMP_STRIDE = 16
CMP_HIDDEN = 256
SLC_LEN = 64
N_SLC = 16
WINDOW = 512
Q_BLOCK = 128
ROPE_THETA = 10000.0
D_FF = 4 * D_MODEL
EPS = 1e-6
FORCE_BONUS = 1e4
D_IN = 3 * D_CONV + D_ATTN + 2 * N_BRANCH * D_KV + N_BRANCH * N_HEADS

kernel_name = "hybrid_shortconv_nsa_adaln_block"


def rms_norm(x, g):
    xf = x.astype(jnp.float32)
    y = xf * lax.rsqrt(jnp.mean(xf * xf, axis=-1, keepdims=True) + EPS)
    return (y * g.astype(jnp.float32)).astype(x.dtype)


def modulate(h, shift, scale):
    return h * (1 + scale[:, None, :]) + shift[:, None, :]


def rope_tables(seq):
    inv = ROPE_THETA ** (-jnp.arange(0, HEAD_DIM, 2, dtype=jnp.float32) / HEAD_DIM)
    ang = jnp.arange(seq, dtype=jnp.float32)[:, None] * inv[None, :]
    return jnp.cos(ang), jnp.sin(ang)


def apply_rope(x, cos, sin):
    xf = x.astype(jnp.float32)
    x1, x2 = jnp.split(xf, 2, axis=-1)
    c = cos[:, None, :]
    s = sin[:, None, :]
    return jnp.concatenate([x1 * c - x2 * s, x2 * c + x1 * s], axis=-1).astype(x.dtype)


def masked_softmax(s, mask):
    s = jnp.where(mask, s, jnp.finfo(jnp.float32).min)
    p = jax.nn.softmax(s, axis=-1)
    return jnp.where(mask, p, 0.0)


def split_points():
    sizes = [D_CONV, D_CONV, D_CONV, D_ATTN] + [D_KV] * (2 * N_BRANCH) + [N_BRANCH * N_HEADS]
    return [int(v) for v in np.cumsum(sizes)[:-1]]


def short_conv_mixer(u_b, u_c, u_h, conv_w, conv_b):
    v = u_c * u_h
    S = v.shape[1]
    vp = jnp.pad(v, ((0, 0), (CONV_WIDTH - 1, 0), (0, 0)))
    z = conv_b + sum(conv_w[k] * vp[:, k:k + S] for k in range(CONV_WIDTH))
    return u_b * z


def compress(kv, pe, w1, w2):
    S = kv.shape[2]
    n_cmp = (S - CMP_LEN) // CMP_STRIDE + 1
    idx = jnp.arange(n_cmp)[:, None] * CMP_STRIDE + jnp.arange(CMP_LEN)[None, :]
    blocks = kv[:, :, idx, :] + pe
    flat = blocks.reshape(blocks.shape[:3] + (CMP_LEN * HEAD_DIM,))
    return jax.nn.gelu(flat @ w1) @ w2


def nsa_attention(q, k_cmp, v_cmp, k_slc, v_slc, k_win, v_win, gates):
    B, _, S, _ = q.shape
    n_cmp = k_cmp.shape[2]
    n_slc = S // SLC_LEN
    top = min(N_SLC, n_slc)
    n_qb = S // Q_BLOCK
    scale = HEAD_DIM ** -0.5
    cmp_end = jnp.arange(n_cmp) * CMP_STRIDE + CMP_LEN - 1
    ci = jnp.arange(n_cmp)[:, None]
    sj = jnp.arange(n_slc)[None, :]
    cmp_to_slc = ((ci * CMP_STRIDE <= sj * SLC_LEN + SLC_LEN - 1)
                  & (ci * CMP_STRIDE + CMP_LEN - 1 >= sj * SLC_LEN)).astype(jnp.float32)
    k_blocks = k_slc.reshape(B, N_KV_HEADS, n_slc, SLC_LEN, HEAD_DIM)
    v_blocks = v_slc.reshape(B, N_KV_HEADS, n_slc, SLC_LEN, HEAD_DIM)
    pad = ((0, 0), (0, 0), (WINDOW, 0), (0, 0))
    k_wp = jnp.pad(k_win, pad)
    v_wp = jnp.pad(v_win, pad)
    bi = jnp.arange(B)[:, None, None, None]
    gi = jnp.arange(N_KV_HEADS)[None, :, None, None]
    blk_ids = jnp.arange(n_slc)[None, :]
    in_blk = jnp.arange(SLC_LEN)

    def one_block(qb):
        qs = qb * Q_BLOCK
        t = qs + jnp.arange(Q_BLOCK)
        qbk = lax.dynamic_slice_in_dim(q, qs, Q_BLOCK, axis=2).reshape(
            B, N_KV_HEADS, GQA_GROUP, Q_BLOCK, HEAD_DIM)
        s = jnp.einsum('bgrqd,bgnd->bgrqn', qbk, k_cmp).astype(jnp.float32) * scale
        p_cmp = masked_softmax(s, cmp_end[None, :] <= t[:, None])
        o_cmp = jnp.einsum('bgrqn,bgnd->bgrqd', p_cmp.astype(v_cmp.dtype), v_cmp)
        imp = jnp.einsum('bgrqn,nj->bgqj', p_cmp, cmp_to_slc)
        cur = (t // SLC_LEN)[:, None]
        valid = blk_ids * SLC_LEN <= t[:, None]
        forced = (blk_ids == 0) | (blk_ids == cur) | (blk_ids == cur - 1)
        score = jnp.where(valid, imp + jnp.where(forced, FORCE_BONUS, 0.0), -1.0)
        _, sel = lax.top_k(score, top)
        k_sel = k_blocks[bi, gi, sel].reshape(B, N_KV_HEADS, Q_BLOCK, top * SLC_LEN, HEAD_DIM)
        v_sel = v_blocks[bi, gi, sel].reshape(B, N_KV_HEADS, Q_BLOCK, top * SLC_LEN, HEAD_DIM)
        pos = (sel[..., None] * SLC_LEN + in_blk).reshape(B, N_KV_HEADS, Q_BLOCK, top * SLC_LEN)
        s = jnp.einsum('bgrqd,bgqkd->bgrqk', qbk, k_sel).astype(jnp.float32) * scale
        p = masked_softmax(s, (pos <= t[:, None])[:, :, None])
        o_slc = jnp.einsum('bgrqk,bgqkd->bgrqd', p.astype(v_sel.dtype), v_sel)
        kw = lax.dynamic_slice_in_dim(k_wp, qs, WINDOW + Q_BLOCK, axis=2)
        vw = lax.dynamic_slice_in_dim(v_wp, qs, WINDOW + Q_BLOCK, axis=2)
        kpos = (qs - WINDOW + jnp.arange(WINDOW + Q_BLOCK))[None, :]
        wmask = (kpos >= 0) & (kpos <= t[:, None]) & (kpos > t[:, None] - WINDOW)
        s = jnp.einsum('bgrqd,bgkd->bgrqk', qbk, kw).astype(jnp.float32) * scale
        p = masked_softmax(s, wmask)
        o_win = jnp.einsum('bgrqk,bgkd->bgrqd', p.astype(vw.dtype), vw)
        g = lax.dynamic_slice_in_dim(gates, qs, Q_BLOCK, axis=1).reshape(
            B, Q_BLOCK, N_KV_HEADS, GQA_GROUP, N_BRANCH).transpose(0, 2, 3, 1, 4)
        return g[..., 0:1] * o_cmp + g[..., 1:2] * o_slc + g[..., 2:3] * o_win

    out = lax.map(one_block, jnp.arange(n_qb))
    return out.transpose(1, 0, 4, 2, 3, 5).reshape(B, S, D_ATTN)


def setup_inputs(seed: int = 0) -> dict:
    key = jax.random.key(seed)
    ks = jax.random.split(key, 24)
    f32 = jnp.float32

    def nrm(k, shape, s):
        return jax.random.normal(k, shape, f32) * s

    L = DEPTH
    return {
        "x": nrm(ks[0], (BATCH, SEQ, D_MODEL), 1.0),
        "c": nrm(ks[1], (BATCH, D_MODEL), 1.0),
        "w_ada": nrm(ks[2], (L, D_MODEL, 6 * D_MODEL), 0.5 * D_MODEL ** -0.5),
        "b_ada": nrm(ks[3], (L, 6 * D_MODEL), 0.02),
        "norm1_g": 1.0 + nrm(ks[4], (L, D_MODEL), 0.02),
        "w_in": nrm(ks[5], (L, D_MODEL, D_IN), D_MODEL ** -0.5),
        "conv_w": nrm(ks[6], (L, CONV_WIDTH, D_CONV), CONV_WIDTH ** -0.5),
        "conv_b": nrm(ks[7], (L, D_CONV), 0.02),
        "cmp_pe_k": nrm(ks[8], (L, CMP_LEN, HEAD_DIM), 0.1),
        "cmp_pe_v": nrm(ks[9], (L, CMP_LEN, HEAD_DIM), 0.1),
        "cmp_w1_k": nrm(ks[10], (L, CMP_LEN * HEAD_DIM, CMP_HIDDEN), (CMP_LEN * HEAD_DIM) ** -0.5),
        "cmp_w2_k": nrm(ks[11], (L, CMP_HIDDEN, HEAD_DIM), CMP_HIDDEN ** -0.5),
        "cmp_w1_v": nrm(ks[12], (L, CMP_LEN * HEAD_DIM, CMP_HIDDEN), (CMP_LEN * HEAD_DIM) ** -0.5),
        "cmp_w2_v": nrm(ks[13], (L, CMP_HIDDEN, HEAD_DIM), CMP_HIDDEN ** -0.5),
        "gnorm_conv_g": 1.0 + nrm(ks[14], (L, D_CONV), 0.02),
        "gnorm_attn_g": 1.0 + nrm(ks[15], (L, D_ATTN), 0.02),
        "w_out": nrm(ks[16], (L, D_MIX, D_MODEL), D_MIX ** -0.5),
        "norm2_g": 1.0 + nrm(ks[17], (L, D_MODEL), 0.02),
        "w_ff1": nrm(ks[18], (L, D_MODEL, D_FF), D_MODEL ** -0.5),
        "w_ff2": nrm(ks[19], (L, D_FF, D_MODEL), D_FF ** -0.5),
        "normf_g": 1.0 + nrm(ks[20], (D_MODEL,), 0.02),
    }


def reference(x, c, w_ada, b_ada, norm1_g, w_in, conv_w, conv_b, cmp_pe_k, cmp_pe_v,
              cmp_w1_k, cmp_w2_k, cmp_w1_v, cmp_w2_v, gnorm_conv_g, gnorm_attn_g,
              w_out, norm2_g, w_ff1, w_ff2, normf_g):
    B, S, _ = x.shape
    cos, sin = rope_tables(S)
    mod_all = jnp.einsum('bd,ldm->lbm', jax.nn.silu(c), w_ada) + b_ada[:, None, :]
    cuts = split_points()

    def kv_heads(t, rope):
        t = t.reshape(B, S, N_KV_HEADS, HEAD_DIM)
        if rope:
            t = apply_rope(t, cos, sin)
        return t.transpose(0, 2, 1, 3)

    for l in range(DEPTH):
        sh1, sc1, g1, sh2, sc2, g2 = jnp.split(mod_all[l], 6, axis=-1)
        h = modulate(rms_norm(x, norm1_g[l]), sh1, sc1)
        u = h @ w_in[l]
        u_b, u_c, u_h, q, kc, vc, ksl, vsl, kwn, vwn, gl = jnp.split(u, cuts, axis=-1)
        y_conv = short_conv_mixer(u_b, u_c, u_h, conv_w[l], conv_b[l])
        q = apply_rope(q.reshape(B, S, N_HEADS, HEAD_DIM), cos, sin).transpose(0, 2, 1, 3)
        k_cmp = compress(kv_heads(kc, True), cmp_pe_k[l], cmp_w1_k[l], cmp_w2_k[l])
        v_cmp = compress(kv_heads(vc, False), cmp_pe_v[l], cmp_w1_v[l], cmp_w2_v[l])
        gates = jax.nn.sigmoid(gl.astype(jnp.float32)).astype(x.dtype).reshape(
            B, S, N_HEADS, N_BRANCH)
        y_attn = nsa_attention(q, k_cmp, v_cmp, kv_heads(ksl, True), kv_heads(vsl, False),
                               kv_heads(kwn, True), kv_heads(vwn, False), gates)
        mixed = jnp.concatenate([rms_norm(y_conv, gnorm_conv_g[l]),
                                 rms_norm(y_attn, gnorm_attn_g[l])], axis=-1)
        x = x + g1[:, None, :] * (mixed @ w_out[l])
        h = modulate(rms_norm(x, norm2_g[l]), sh2, sc2)
        x = x + g2[:, None, :] * (jnp.square(jax.nn.relu(h @ w_ff1[l])) @ w_ff2[l])
    return rms_norm(x, normf_g)
```

```cpp
#include <hip/hip_runtime.h>
#include <hip/hip_cooperative_groups.h>
#include <cstdint>
#include <cstdio>
namespace cg = cooperative_groups;

#ifndef ONE_LAUNCH
#define ONE_LAUNCH 0
#endif
#ifndef FAST_ATTN
#define FAST_ATTN 0
#endif

#define LAS __attribute__((address_space(3)))
typedef _Float16 h16;
typedef _Float16 half8 __attribute__((ext_vector_type(8)));
typedef _Float16 half4 __attribute__((ext_vector_type(4)));
typedef _Float16 half2v __attribute__((ext_vector_type(2)));
typedef float f32x4 __attribute__((ext_vector_type(4)));
typedef float f32x2 __attribute__((ext_vector_type(2)));
typedef unsigned u32x4 __attribute__((ext_vector_type(4)));
typedef unsigned u32x2 __attribute__((ext_vector_type(2)));

constexpr int NB = 4, SEQ = 8192, NT = NB * SEQ, DM = 2048, DIN = 5656, DINP = 5888, DFF = 8192;
constexpr int OFF_UB = 0, OFF_UC = 1024, OFF_UH = 2048, OFF_Q = 3072, OFF_KC = 4096, OFF_VC = 4352, OFF_KS = 4608, OFF_VS = 4864,
              OFF_KW = 5120, OFF_VW = 5376, OFF_GL = 5632;
constexpr float EPS = 1e-6f;
constexpr int NTHR = 512;
constexpr int LDS_BYTES = 136 * 1024;

constexpr size_t WS_MOD   = 4096;
constexpr size_t WS_B1P   = WS_MOD + (size_t)4 * 12288 * 4;
constexpr size_t WS_WIN   = WS_B1P + (size_t)2 * 32 * 256 * 4;
constexpr size_t WS_WOUT  = WS_WIN + (size_t)DINP * DM * 2;
constexpr size_t WS_W1    = WS_WOUT + (size_t)DM * DM * 2;
constexpr size_t WS_W2    = WS_W1 + (size_t)DFF * DM * 2;
constexpr size_t WS_CW1K  = WS_W2 + (size_t)DFF * DM * 2;
constexpr size_t WS_CW1V  = WS_CW1K + (size_t)256 * 4096 * 2;
constexpr size_t WS_CW2K  = WS_CW1V + (size_t)256 * 4096 * 2;
constexpr size_t WS_CW2V  = WS_CW2K + (size_t)128 * 256 * 2;
constexpr size_t WS_KCMP  = WS_CW2V + (size_t)128 * 256 * 2;
constexpr size_t WS_VCMP  = WS_KCMP + (size_t)8 * 512 * 128 * 2;
constexpr size_t WS_H     = WS_VCMP + (size_t)8 * 512 * 128 * 2;
constexpr size_t WS_BIG   = WS_H + (size_t)NT * DM * 2;
constexpr size_t WS_U     = WS_BIG;
constexpr size_t WS_YACC  = WS_U + (size_t)NT * DINP * 2;
constexpr size_t WS_HID   = WS_BIG;
constexpr size_t WS_END   = WS_BIG + (size_t)NT * DFF * 2;
static_assert(WS_YACC + (size_t)NT * 1024 * 4 <= WS_END, "ws map");
static_assert(WS_END <= (size_t)1073741824, "ws map fits 4x largest tensor");
static_assert(WS_WIN % 256 == 0 && WS_H % 256 == 0 && WS_BIG % 256 == 0 && WS_YACC % 256 == 0, "alignment");

namespace pg8 {
constexpr int BM = 256, BK = 64, HALF = 128, HTB = HALF * BK * 2, STAGE_BYTES = 8 * HTB, NXCD = 8, WGM = 8;
__host__ __device__ __forceinline__ int lds_byte(int r, int c) { const int st = (r >> 4) * 2 + (c >> 5), rr = r & 15, cc = c & 31, ob = rr * 64 + cc * 2; return st * 1024 + (ob ^ (((ob >> 9) & 1) << 5)); }
__host__ __device__ __forceinline__ void stage_rc(int b, int& R, int& C) { const int st = b / 1024, sb = b % 1024, swz = sb ^ (((sb >> 9) & 1) << 5); R = (st >> 1) * 16 + swz / 64; C = (st & 1) * 32 + (swz % 64) / 2; }
__host__ __device__ __forceinline__ int perm32(int rho) { const int n = rho >> 4, i = rho & 15; return 8 * (i >> 2) + 4 * n + (i & 3); }

struct Unit { int pm, pn; };
struct Gemm { const h16* A; const h16* Bt; int M, N, K; };

struct StaticOrder {
    int nM, nN, nwg, G, c;
    __host__ __device__ void init(int M, int N, int G_, int c_) { nM = M / BM; nN = N / BM; nwg = nM * nN; G = G_; c = c_; }
    __host__ __device__ bool next(int i, Unit& u) const {
        const long L = (long)i * G + c; if (L >= nwg) return false;
        int wgid = (int)L; { const int q = nwg / NXCD, r = nwg % NXCD, xcd = wgid % NXCD, off = wgid / NXCD; wgid = (xcd < r ? xcd * (q + 1) : r * (q + 1) + (xcd - r) * q) + off; }
        const int nig = WGM * nN, gid = wgid / nig, fm = gid * WGM, gsz = (nM - fm) < WGM ? (nM - fm) : WGM;
        u.pm = fm + ((wgid % nig) % gsz); u.pn = (wgid % nig) / gsz; return true;
    }
    __device__ __forceinline__ void a_ready(const Unit&) const {}
    __device__ __forceinline__ void done(const Unit&) const {}
};

__device__ __forceinline__ unsigned pk_h2(float lo, float hi) { half2v v; v.x = (h16)lo; v.y = (h16)hi; return __builtin_bit_cast(unsigned, v); }

template <int ACT> struct EpiF16 {
    static constexpr bool PERM = true, AFTER_DRAIN = false;
    h16* O; int ldc;
    __device__ __forceinline__ void operator()(const f32x4 (&acc)[2][2][4][2], const Unit& u, int wr, int wc, int fr, int fq) const {
        const int row0 = u.pm * BM + wr * 64 + fr; const int col0 = u.pn * BM + wc * 32 + 8 * fq;
#pragma unroll
        for (int ai = 0; ai < 2; ++ai)
#pragma unroll
            for (int m = 0; m < 4; ++m) { h16* rowp = O + (size_t)(row0 + ai * HALF + m * 16) * ldc + col0;
#pragma unroll
                for (int bj = 0; bj < 2; ++bj) { f32x4 v0 = acc[ai][bj][m][0], v1 = acc[ai][bj][m][1];
                    if (ACT == 1) {
#pragma unroll
                        for (int j = 0; j < 4; ++j) { const float a = fmaxf(v0[j], 0.f), b = fmaxf(v1[j], 0.f); v0[j] = a * a; v1[j] = b * b; } }
                    u32x4 w; w.x = pk_h2(v0[0], v0[1]); w.y = pk_h2(v0[2], v0[3]); w.z = pk_h2(v1[0], v1[1]); w.w = pk_h2(v1[2], v1[3]);
                    *(u32x4*)(rowp + bj * HALF) = w; } }
    }
};
struct EpiRes {
    static constexpr bool PERM = false, AFTER_DRAIN = false;
    const float* base; float* out; const float* gate; int gate_ld;
    __device__ __forceinline__ void operator()(const f32x4 (&acc)[2][2][4][2], const Unit& u, int wr, int wc, int fr, int fq) const {
        const int row0 = u.pm * BM + wr * 64 + fr, col0 = u.pn * BM + wc * 32 + 4 * fq; const int b = (u.pm * BM) / SEQ;
        f32x4 gv[2][2];
#pragma unroll
        for (int bj = 0; bj < 2; ++bj)
#pragma unroll
            for (int n = 0; n < 2; ++n) gv[bj][n] = *(const f32x4*)(gate + (size_t)b * gate_ld + col0 + bj * HALF + n * 16);
#pragma unroll
        for (int ai = 0; ai < 2; ++ai)
#pragma unroll
            for (int m = 0; m < 4; ++m) { const size_t ro = (size_t)(row0 + ai * HALF + m * 16) * DM + col0;
#pragma unroll
                for (int bj = 0; bj < 2; ++bj)
#pragma unroll
                    for (int n = 0; n < 2; ++n) { const f32x4 bv = *(const f32x4*)(base + ro + bj * HALF + n * 16);
                        *(f32x4*)(out + ro + bj * HALF + n * 16) = bv + gv[bj][n] * acc[ai][bj][m][n]; } }
    }
};

template <class Epi, class Sched>
__device__ __forceinline__ void gemm_phase(LAS unsigned char* lds, const Gemm g, const Sched& S, const Epi& E) {
    const int tid = threadIdx.x, wid = __builtin_amdgcn_readfirstlane(tid >> 6), lane = tid & 63, wr = wid >> 2, wc = wid & 3, fr = lane & 15, fq = lane >> 4;
    const int K = g.K, nt = K / BK;
    unsigned voffA[2], voffB[2];
#pragma unroll
    for (int i = 0; i < 2; ++i) { int R, C; stage_rc(tid * 16 + i * 8192, R, C); const int Rb = Epi::PERM ? ((R & ~31) + perm32(R & 31)) : R;
        voffA[i] = (unsigned)(R * K + C) * 2u; voffB[i] = (unsigned)(Rb * K + C) * 2u; }
    const size_t kstep = (size_t)(BK * 2);
    const size_t hstep = (size_t)HALF * K * 2;
    const size_t tstep = 2 * hstep;
    const unsigned ldsw = (unsigned)wid * 1024u;
    const int aoff = lds_byte(wr * 64 + fr, fq * 8), boff = lds_byte(wc * 32 + fr, fq * 8);
#define PG8_SA(b, h) (((b) * 2 + (h)) * HTB)
#define PG8_SB(b, h) ((4 + (b) * 2 + (h)) * HTB)
#define PG8_STAGE(bufoff, gbase, voff) do { _Pragma("unroll") for (int _i = 0; _i < 2; ++_i) \
        __builtin_amdgcn_global_load_lds((const unsigned*)((const char*)(gbase) + (voff)[_i]), (LAS unsigned*)(lds + (bufoff) + ldsw + _i * 8192), 16, 0, 0); } while (0)
#define PG8_LDA(dst, b, h) do { _Pragma("unroll") for (int m = 0; m < 4; ++m) _Pragma("unroll") for (int k = 0; k < 2; ++k) dst[m][k] = *(const LAS half8*)(lds + PG8_SA(b, h) + aoff + m * 2048 + k * 1024); } while (0)
#define PG8_LDB(dst, b, h) do { _Pragma("unroll") for (int n = 0; n < 2; ++n) _Pragma("unroll") for (int k = 0; k < 2; ++k) dst[n][k] = *(const LAS half8*)(lds + PG8_SB(b, h) + boff + n * 2048 + k * 1024); } while (0)
#define PG8_MMA(ai, bj, At, Bt) do { __builtin_amdgcn_s_setprio(1); _Pragma("unroll") for (int m = 0; m < 4; ++m) _Pragma("unroll") for (int n = 0; n < 2; ++n) _Pragma("unroll") for (int k = 0; k < 2; ++k) \
        acc[ai][bj][m][n] = __builtin_amdgcn_mfma_f32_16x16x32_f16(Bt[n][k], At[m][k], acc[ai][bj][m][n], 0, 0, 0); __builtin_amdgcn_s_setprio(0); } while (0)
#define PG8_WAIT_V(n) asm volatile("s_waitcnt vmcnt(" #n ")" ::: "memory")
#define PG8_WAIT_L(n) asm volatile("s_waitcnt lgkmcnt(" #n ")" ::: "memory")
#define PG8_BAR __builtin_amdgcn_s_barrier()
#define PG8_SCHED __builtin_amdgcn_sched_barrier(0)
    Unit cur, nxt; int ui = 0;
    if (!S.next(0, cur)) return;
    f32x4 acc[2][2][4][2];
#pragma unroll
    for (int a = 0; a < 2; ++a)
#pragma unroll
        for (int b = 0; b < 2; ++b)
#pragma unroll
            for (int m = 0; m < 4; ++m)
#pragma unroll
                for (int n = 0; n < 2; ++n) acc[a][b][m][n] = (f32x4){0.f, 0.f, 0.f, 0.f};
    half8 At[4][2], B0[2][2], B1[2][2];
    const char* cA = (const char*)g.A + (size_t)cur.pm * tstep; const char* cB = (const char*)g.Bt + (size_t)cur.pn * tstep;
    S.a_ready(cur);
    PG8_STAGE(PG8_SB(0, 0), cB, voffB); PG8_STAGE(PG8_SA(0, 0), cA, voffA); PG8_STAGE(PG8_SB(0, 1), cB + hstep, voffB); PG8_STAGE(PG8_SA(0, 1), cA + hstep, voffA);
    if (wr == 1) PG8_BAR;
    PG8_WAIT_V(4); PG8_BAR;
    PG8_STAGE(PG8_SB(1, 0), cB + kstep, voffB); PG8_STAGE(PG8_SA(1, 0), cA + kstep, voffA); PG8_STAGE(PG8_SB(1, 1), cB + hstep + kstep, voffB);
    PG8_WAIT_V(6); PG8_BAR;
    for (;;) {
        const bool has_next = S.next(ui + 1, nxt);
        const char* nA = has_next ? (const char*)g.A + (size_t)nxt.pm * tstep : cA; const char* nB = has_next ? (const char*)g.Bt + (size_t)nxt.pn * tstep : cB;
        for (int t = 0; t < nt; t += 2) {
            const bool last = (t == nt - 2);
            const char* a1 = cA + (size_t)(t + 1) * kstep;
            const char* a2 = last ? nA : cA + (size_t)(t + 2) * kstep; const char* b2 = last ? nB : cB + (size_t)(t + 2) * kstep;
            const char* a3 = a2 + kstep; const char* b3 = b2 + kstep;
            if (last && has_next) S.a_ready(nxt);
            PG8_LDB(B0, 0, 0); PG8_SCHED; PG8_LDA(At, 0, 0); PG8_STAGE(PG8_SA(1, 1), a1 + hstep, voffA);
            PG8_WAIT_L(8); PG8_BAR; PG8_WAIT_L(0); PG8_MMA(0, 0, At, B0); PG8_BAR; PG8_SCHED;
            PG8_LDB(B1, 0, 1); PG8_STAGE(PG8_SB(0, 0), b2, voffB);
            PG8_BAR; PG8_WAIT_L(0); PG8_MMA(0, 1, At, B1); PG8_BAR;
            PG8_LDA(At, 0, 1); PG8_STAGE(PG8_SA(0, 0), a2, voffA);
            PG8_BAR; PG8_WAIT_L(0); PG8_MMA(1, 0, At, B0); PG8_BAR; PG8_SCHED;
            PG8_STAGE(PG8_SB(0, 1), b2 + hstep, voffB);
            PG8_WAIT_V(6); PG8_BAR; PG8_MMA(1, 1, At, B1); PG8_BAR;
            PG8_LDB(B0, 1, 0); PG8_SCHED; PG8_LDA(At, 1, 0); PG8_STAGE(PG8_SA(0, 1), a2 + hstep, voffA);
            PG8_WAIT_L(8); PG8_BAR; PG8_WAIT_L(0); PG8_MMA(0, 0, At, B0); PG8_BAR; PG8_SCHED;
            PG8_LDB(B1, 1, 1); PG8_STAGE(PG8_SB(1, 0), b3, voffB);
            PG8_BAR; PG8_WAIT_L(0); PG8_MMA(0, 1, At, B1); PG8_BAR;
            PG8_LDA(At, 1, 1); PG8_STAGE(PG8_SA(1, 0), a3, voffA);
            PG8_BAR; PG8_WAIT_L(0); PG8_MMA(1, 0, At, B0); PG8_BAR; PG8_SCHED;
            PG8_STAGE(PG8_SB(1, 1), b3 + hstep, voffB);
            PG8_WAIT_V(6); PG8_BAR; PG8_MMA(1, 1, At, B1); PG8_BAR;
        }
        E(acc, cur, wr, wc, fr, fq); S.done(cur);
        if (!has_next) break;
#pragma unroll
        for (int a = 0; a < 2; ++a)
#pragma unroll
            for (int b = 0; b < 2; ++b)
#pragma unroll
                for (int m = 0; m < 4; ++m)
#pragma unroll
                    for (int n = 0; n < 2; ++n) acc[a][b][m][n] = (f32x4){0.f, 0.f, 0.f, 0.f};
        cur = nxt; cA = nA; cB = nB; ++ui;
    }
    PG8_WAIT_V(0);
    if (wr == 0) PG8_BAR;
    PG8_BAR;
#undef PG8_SA
#undef PG8_SB
#undef PG8_STAGE
#undef PG8_LDA
#undef PG8_LDB
#undef PG8_MMA
#undef PG8_WAIT_V
#undef PG8_WAIT_L
#undef PG8_BAR
#undef PG8_SCHED
}
}

__device__ __forceinline__ float wave_sum(float v) {
#pragma unroll
    for (int o = 1; o < 64; o <<= 1) v += __shfl_xor(v, o);
    return v;
}
__device__ __forceinline__ float wave_max(float v) {
#pragma unroll
    for (int o = 1; o < 64; o <<= 1) v = fmaxf(v, __shfl_xor(v, o));
    return v;
}
__device__ __forceinline__ float bcast_lane(float v, int j) { return __builtin_bit_cast(float, __builtin_amdgcn_readlane(__builtin_bit_cast(int, v), j)); }

struct Ptrs {
    const float* in[21]; float* out; unsigned char* ws;
};

constexpr int P0_ADA = 192, P0_B1 = 64;
constexpr int P0_TWIN = 32 * 92, P0_TWOUT = 32 * 32, P0_TW1 = 32 * 128, P0_TW2 = 128 * 32, P0_TC1 = 64 * 4, P0_TC2 = 4 * 2;
constexpr int P0_OFF_B1 = P0_ADA, P0_OFF_TWIN = P0_OFF_B1 + P0_B1, P0_OFF_TWOUT = P0_OFF_TWIN + P0_TWIN, P0_OFF_TW1 = P0_OFF_TWOUT + P0_TWOUT,
              P0_OFF_TW2 = P0_OFF_TW1 + P0_TW1, P0_OFF_TC1K = P0_OFF_TW2 + P0_TW2, P0_OFF_TC1V = P0_OFF_TC1K + P0_TC1, P0_OFF_TC2K = P0_OFF_TC1V + P0_TC1,
              P0_OFF_TC2V = P0_OFF_TC2K + P0_TC2, P0_ITEMS = P0_OFF_TC2V + P0_TC2;

__device__ __forceinline__ void transpose_tile(const float* __restrict__ W, int K, int N, h16* __restrict__ Wt, int item, LAS float* scr, int tid) {
    const int nkt = K / 64; const int kt = item % nkt, ntl = item / nkt;
    { const int r = tid >> 4, c4 = tid & 15;
#pragma unroll
      for (int i = 0; i < 2; ++i) { const int k = kt * 64 + r + 32 * i, n = ntl * 64 + 4 * c4;
          f32x4 v = (f32x4){0.f, 0.f, 0.f, 0.f}; if (n < N) v = *(const f32x4*)(W + (size_t)k * N + n);
#pragma unroll
          for (int j = 0; j < 4; ++j) scr[(r + 32 * i) * 65 + 4 * c4 + j] = v[j]; } }
    __syncthreads();
    { const int n = tid >> 3, kc = tid & 7; half8 o;
#pragma unroll
      for (int j = 0; j < 8; ++j) o[j] = (h16)scr[(8 * kc + j) * 65 + n];
      *(half8*)(Wt + (size_t)(ntl * 64 + n) * K + kt * 64 + 8 * kc) = o; }
    __syncthreads();
}

__device__ __forceinline__ void p0_prologue(const Ptrs& P, LAS unsigned char* lds, int G, int bid) {
    const int tid = threadIdx.x;
    LAS float* scr = (LAS float*)lds;
    unsigned char* ws = P.ws;
    for (int it = bid; it < P0_ITEMS; it += G) {
        if (it < P0_ADA) {
            LAS float* sc = scr;
            LAS float* red = scr + 8192;
            const float* c = P.in[1];
            for (int i = tid; i < 8192; i += NTHR) { const float v = c[i]; sc[i] = v / (1.f + __expf(-v)); }
            __syncthreads();
            const int cl = tid & 15, kg = tid >> 4;
            f32x4 a0 = {0, 0, 0, 0}, a1 = a0, a2 = a0, a3 = a0;
            const float* W = P.in[2] + 64 * it + 4 * cl;
#pragma unroll 4
            for (int k = kg; k < 2048; k += 32) { const f32x4 w = *(const f32x4*)(W + (size_t)k * 12288);
                a0 += sc[k] * w; a1 += sc[2048 + k] * w; a2 += sc[4096 + k] * w; a3 += sc[6144 + k] * w; }
#pragma unroll
            for (int j = 0; j < 4; ++j) { red[(kg * 4 + 0) * 64 + 4 * cl + j] = a0[j]; red[(kg * 4 + 1) * 64 + 4 * cl + j] = a1[j];
                red[(kg * 4 + 2) * 64 + 4 * cl + j] = a2[j]; red[(kg * 4 + 3) * 64 + 4 * cl + j] = a3[j]; }
            __syncthreads();
            if (tid < 256) { const int b = tid >> 6, col = tid & 63; float s = 0.f;
                for (int q = 0; q < 32; ++q) s += red[(q * 4 + b) * 64 + col];
                ((float*)(ws + WS_MOD))[b * 12288 + 64 * it + col] = s + P.in[3][64 * it + col]; }
            __syncthreads();
        } else if (it < P0_OFF_TWIN) {
            const int q = it - P0_OFF_B1, kv = q >> 5, part = q & 31;
            const float* pe = P.in[8 + kv]; const float* W1 = P.in[kv ? 12 : 10];
            const int col = tid & 255, kh = tid >> 8; float s = 0.f;
            for (int k = 128 * part + 64 * kh; k < 128 * part + 64 * kh + 64; ++k) s += pe[k] * W1[(size_t)k * 256 + col];
            scr[tid] = s; __syncthreads();
            if (tid < 256) ((float*)(ws + WS_B1P))[(kv * 32 + part) * 256 + tid] = scr[tid] + scr[tid + 256];
            __syncthreads();
        } else if (it < P0_OFF_TWOUT) transpose_tile(P.in[5], DM, DIN, (h16*)(ws + WS_WIN), it - P0_OFF_TWIN, scr, tid);
        else if (it < P0_OFF_TW1)     transpose_tile(P.in[16], DM, DM, (h16*)(ws + WS_WOUT), it - P0_OFF_TWOUT, scr, tid);
        else if (it < P0_OFF_TW2)     transpose_tile(P.in[18], DM, DFF, (h16*)(ws + WS_W1), it - P0_OFF_TW1, scr, tid);
        else if (it < P0_OFF_TC1K)    transpose_tile(P.in[19], DFF, DM, (h16*)(ws + WS_W2), it - P0_OFF_TW2, scr, tid);
        else if (it < P0_OFF_TC1V)    transpose_tile(P.in[10], 4096, 256, (h16*)(ws + WS_CW1K), it - P0_OFF_TC1K, scr, tid);
        else if (it < P0_OFF_TC2K)    transpose_tile(P.in[12], 4096, 256, (h16*)(ws + WS_CW1V), it - P0_OFF_TC1V, scr, tid);
        else if (it < P0_OFF_TC2V)    transpose_tile(P.in[11], 256, 128, (h16*)(ws + WS_CW2K), it - P0_OFF_TC2K, scr, tid);
        else                          transpose_tile(P.in[13], 256, 128, (h16*)(ws + WS_CW2V), it - P0_OFF_TC2V, scr, tid);
    }
}

__device__ __forceinline__ void norm_mod_rows(const float* __restrict__ X, const float* __restrict__ gw, const float* __restrict__ mod, int sh_off, int sc_off,
                                              h16* __restrict__ H, int G, int bid) {
    const int lane = threadIdx.x & 63, wave = threadIdx.x >> 6;
    for (int r = bid * 8 + wave; r < NT; r += G * 8) {
        const int b = r >> 13; const float* xr = X + (size_t)r * DM; f32x4 v[8]; float ss = 0.f;
#pragma unroll
        for (int i = 0; i < 8; ++i) { v[i] = *(const f32x4*)(xr + 4 * (lane + 64 * i)); ss += v[i][0] * v[i][0] + v[i][1] * v[i][1] + v[i][2] * v[i][2] + v[i][3] * v[i][3]; }
        ss = wave_sum(ss); const float rstd = rsqrtf(ss * (1.f / DM) + EPS);
        const float* mb = mod + (size_t)b * 12288;
#pragma unroll
        for (int i = 0; i < 8; ++i) { const int c = 4 * (lane + 64 * i);
            const f32x4 g = *(const f32x4*)(gw + c), sh = *(const f32x4*)(mb + sh_off + c), sc = *(const f32x4*)(mb + sc_off + c);
            const f32x4 o = (v[i] * rstd) * g * (1.f + sc) + sh;
            u32x2 w; w.x = pg8::pk_h2(o[0], o[1]); w.y = pg8::pk_h2(o[2], o[3]);
            *(u32x2*)(H + (size_t)r * DM + c) = w; }
    }
}
__device__ __forceinline__ void final_norm_rows(float* __restrict__ X, const float* __restrict__ gw, int G, int bid) {
    const int lane = threadIdx.x & 63, wave = threadIdx.x >> 6;
    for (int r = bid * 8 + wave; r < NT; r += G * 8) {
        float* xr = X + (size_t)r * DM; f32x4 v[8]; float ss = 0.f;
#pragma unroll
        for (int i = 0; i < 8; ++i) { v[i] = *(const f32x4*)(xr + 4 * (lane + 64 * i)); ss += v[i][0] * v[i][0] + v[i][1] * v[i][1] + v[i][2] * v[i][2] + v[i][3] * v[i][3]; }
        ss = wave_sum(ss); const float rstd = rsqrtf(ss * (1.f / DM) + EPS);
#pragma unroll
        for (int i = 0; i < 8; ++i) { const int c = 4 * (lane + 64 * i); const f32x4 g = *(const f32x4*)(gw + c); *(f32x4*)(xr + c) = (v[i] * rstd) * g; }
    }
}

__device__ __forceinline__ void post_u_rows(const Ptrs& P, int G, int bid) {
    const int lane = threadIdx.x & 63, wave = threadIdx.x >> 6;
    h16* U = (h16*)(P.ws + WS_U); h16* MIX = (h16*)(P.ws + WS_H);
    const float* cw = P.in[6]; const float* cb = P.in[7]; const float* gcv = P.in[14];
    const float inv = (float)exp2(-(double)lane * (13.287712379549449 / 64.0));
    for (int r = bid * 8 + wave; r < NT; r += G * 8) {
        const int pos = r & (SEQ - 1); h16* u = U + (size_t)r * DINP;
        const float ang = (float)pos * inv;
        double rev = (double)ang * 0.15915494309189535; rev -= __builtin_rint(rev);
        const float rf = (float)rev; const float cs = __builtin_amdgcn_cosf(rf), sn = __builtin_amdgcn_sinf(rf);
#pragma unroll
        for (int hd = 0; hd < 14; ++hd) {
            const int base = hd < 8 ? OFF_Q + 128 * hd : (hd < 10 ? OFF_KC + 128 * (hd - 8) : (hd < 12 ? OFF_KS + 128 * (hd - 10) : OFF_KW + 128 * (hd - 12)));
            const float x1 = (float)u[base + lane], x2 = (float)u[base + 64 + lane];
            u[base + lane] = (h16)(x1 * cs - x2 * sn); u[base + 64 + lane] = (h16)(x2 * cs + x1 * sn);
        }
        float y[16]; float ss = 0.f;
#pragma unroll
        for (int hf = 0; hf < 2; ++hf) {
            const int ch = 512 * hf + 8 * lane;
            const half8 ub = *(const half8*)(u + OFF_UB + ch), c0 = *(const half8*)(u + OFF_UC + ch), h0 = *(const half8*)(u + OFF_UH + ch);
            half8 c1 = c0 * (h16)0, h1 = c1, c2 = c1, h2 = c1;
            if (pos >= 1) { c1 = *(const half8*)(u - DINP + OFF_UC + ch); h1 = *(const half8*)(u - DINP + OFF_UH + ch); }
            if (pos >= 2) { c2 = *(const half8*)(u - 2 * DINP + OFF_UC + ch); h2 = *(const half8*)(u - 2 * DINP + OFF_UH + ch); }
#pragma unroll
            for (int j = 0; j < 8; ++j) {
                const float v0 = (float)c0[j] * (float)h0[j], v1 = (float)c1[j] * (float)h1[j], v2 = (float)c2[j] * (float)h2[j];
                const float z = cb[ch + j] + cw[ch + j] * v2 + cw[1024 + ch + j] * v1 + cw[2048 + ch + j] * v0;
                const float yy = (float)ub[j] * z; y[8 * hf + j] = yy; ss += yy * yy; }
        }
        ss = wave_sum(ss); const float rstd = rsqrtf(ss * (1.f / 1024.f) + EPS);
#pragma unroll
        for (int hf = 0; hf < 2; ++hf) { const int ch = 512 * hf + 8 * lane; half8 o;
#pragma unroll
            for (int j = 0; j < 8; ++j) o[j] = (h16)(y[8 * hf + j] * rstd * gcv[ch + j]);
            *(half8*)(MIX + (size_t)r * DM + ch) = o; }
    }
}

__device__ __forceinline__ float gelu_tanh(float x) {
    const float z = 0.7978845608028654f * (x + 0.044715f * x * x * x);
    const float e = __expf(2.f * z);
    const float th = 1.f - 2.f / (e + 1.f);
    return 0.5f * x * (1.f + th);
}
__device__ __forceinline__ void compress_phase(const Ptrs& P, LAS unsigned char* lds, int G, int bid) {
    const int tid = threadIdx.x, lane = tid & 63, w = tid >> 6, fr = lane & 15, fq = lane >> 4;
    const h16* U = (const h16*)(P.ws + WS_U);
    LAS h16* hid = (LAS h16*)lds;
    for (int unit = bid; unit < 256; unit += G) {
        const int kv = unit >> 7, bg = (unit >> 4) & 7, nb = unit & 15, b = bg >> 1, g = bg & 1, n0 = nb * 32;
        const h16* W1t = (const h16*)(P.ws + (kv ? WS_CW1V : WS_CW1K));
        const h16* W2t = (const h16*)(P.ws + (kv ? WS_CW2V : WS_CW2K));
        const float* b1p = (const float*)(P.ws + WS_B1P) + kv * 32 * 256;
        h16* OUT = (h16*)(P.ws + (kv ? WS_VCMP : WS_KCMP)) + (size_t)bg * 512 * 128;
        const int coff = (kv ? OFF_VC : OFF_KC) + g * 128;
        f32x4 acc[2][2];
#pragma unroll
        for (int i = 0; i < 2; ++i)
#pragma unroll
            for (int j = 0; j < 2; ++j) acc[i][j] = (f32x4){0.f, 0.f, 0.f, 0.f};
        for (int pos = 0; pos < 32; ++pos) {
#pragma unroll
            for (int ks = 0; ks < 4; ++ks) {
                half8 a[2], bb[2];
#pragma unroll
                for (int mt = 0; mt < 2; ++mt) { const int tok = 16 * (n0 + 16 * mt + fr) + pos;
                    half8 z;
#pragma unroll
                    for (int j = 0; j < 8; ++j) z[j] = (h16)0.f;
                    a[mt] = tok < SEQ ? *(const half8*)(U + (size_t)(b * SEQ + tok) * DINP + coff + 32 * ks + 8 * fq) : z; }
#pragma unroll
                for (int nt = 0; nt < 2; ++nt) bb[nt] = *(const half8*)(W1t + (size_t)(32 * w + 16 * nt + fr) * 4096 + pos * 128 + 32 * ks + 8 * fq);
#pragma unroll
                for (int mt = 0; mt < 2; ++mt)
#pragma unroll
                    for (int nt = 0; nt < 2; ++nt) acc[mt][nt] = __builtin_amdgcn_mfma_f32_16x16x32_f16(a[mt], bb[nt], acc[mt][nt], 0, 0, 0);
            }
        }
#pragma unroll
        for (int nt = 0; nt < 2; ++nt) { const int col = 32 * w + 16 * nt + fr; float bias = 0.f;
            for (int q = 0; q < 32; ++q) bias += b1p[q * 256 + col];
#pragma unroll
            for (int mt = 0; mt < 2; ++mt)
#pragma unroll
                for (int j = 0; j < 4; ++j) hid[(16 * mt + 4 * fq + j) * 264 + col] = (h16)gelu_tanh(acc[mt][nt][j] + bias); }
        __syncthreads();
        f32x4 acc2[2]; acc2[0] = (f32x4){0.f, 0.f, 0.f, 0.f}; acc2[1] = acc2[0];
#pragma unroll
        for (int ks = 0; ks < 8; ++ks) {
            const half8 bb = *(const half8*)(W2t + (size_t)(16 * w + fr) * 256 + 32 * ks + 8 * fq);
#pragma unroll
            for (int mt = 0; mt < 2; ++mt) { const half8 a = *(const LAS half8*)(hid + (16 * mt + fr) * 264 + 32 * ks + 8 * fq);
                acc2[mt] = __builtin_amdgcn_mfma_f32_16x16x32_f16(a, bb, acc2[mt], 0, 0, 0); }
        }
#pragma unroll
        for (int mt = 0; mt < 2; ++mt)
#pragma unroll
            for (int j = 0; j < 4; ++j) OUT[(size_t)(n0 + 16 * mt + 4 * fq + j) * 128 + 16 * w + fr] = (h16)acc2[mt][j];
        __syncthreads();
    }
}

__device__ __forceinline__ void dot4(const h16* __restrict__ kp, const LAS float* qf, float (&s)[4]) {
    s[0] = s[1] = s[2] = s[3] = 0.f;
#pragma unroll 4
    for (int c = 0; c < 16; ++c) { const half8 kk = *(const half8*)(kp + 8 * c);
#pragma unroll
        for (int j = 0; j < 8; ++j) { const float kf = (float)kk[j];
            s[0] += qf[8 * c + j] * kf; s[1] += qf[128 + 8 * c + j] * kf; s[2] += qf[256 + 8 * c + j] * kf; s[3] += qf[384 + 8 * c + j] * kf; } }
}
__device__ __forceinline__ void attn_simple(const Ptrs& P, LAS unsigned char* lds, int G, int bid) {
    const int lane = threadIdx.x & 63, wave = threadIdx.x >> 6;
    const h16* U = (const h16*)(P.ws + WS_U); float* Y = (float*)(P.ws + WS_YACC);
    LAS float* qf = (LAS float*)lds + wave * 1280;
    LAS float* pbar = qf + 512;
    LAS float* impv = pbar + 512;
    const float scale = 0.08838834764831845f;
    for (int wu = bid * 8 + wave; wu < NB * 2 * SEQ; wu += G * 8) {
        const int b = wu >> 14, g = (wu >> 13) & 1, t = wu & (SEQ - 1);
        const size_t row = (size_t)b * SEQ + t; const h16* urow = U + row * DINP;
#pragma unroll
        for (int hh = 0; hh < 4; ++hh) { const half2v q2 = *(const half2v*)(urow + OFF_Q + (4 * g + hh) * 128 + 2 * lane); qf[hh * 128 + 2 * lane] = (float)q2.x; qf[hh * 128 + 2 * lane + 1] = (float)q2.y; }
        float gt[4][3];
#pragma unroll
        for (int hh = 0; hh < 4; ++hh)
#pragma unroll
            for (int br = 0; br < 3; ++br) { const float x = (float)urow[OFF_GL + (4 * g + hh) * 3 + br]; gt[hh][br] = 1.f / (1.f + __expf(-x)); }
        f32x2 y[4];
#pragma unroll
        for (int hh = 0; hh < 4; ++hh) y[hh] = (f32x2){0.f, 0.f};
        const int nvalid = t >= 31 ? ((t - 31) >> 4) + 1 : 0;
        const h16* KC = (const h16*)(P.ws + WS_KCMP) + (size_t)(b * 2 + g) * 512 * 128;
        const h16* VC = (const h16*)(P.ws + WS_VCMP) + (size_t)(b * 2 + g) * 512 * 128;
        {
            float p[8][4];
#pragma unroll
            for (int c = 0; c < 8; ++c) { const int n = 64 * c + lane; float s[4] = {0.f, 0.f, 0.f, 0.f};
                if (64 * c < nvalid) dot4(KC + (size_t)n * 128, qf, s);
#pragma unroll
                for (int hh = 0; hh < 4; ++hh) p[c][hh] = n < nvalid ? s[hh] * scale : -3.0e38f; }
#pragma unroll
            for (int hh = 0; hh < 4; ++hh) { float m = -3.0e38f;
#pragma unroll
                for (int c = 0; c < 8; ++c) m = fmaxf(m, p[c][hh]);
                m = wave_max(m); float l = 0.f;
#pragma unroll
                for (int c = 0; c < 8; ++c) { const int n = 64 * c + lane; const float e = n < nvalid ? __expf(p[c][hh] - m) : 0.f; p[c][hh] = e; l += e; }
                l = wave_sum(l); const float il = l > 0.f ? 1.f / l : 0.f;
#pragma unroll
                for (int c = 0; c < 8; ++c) p[c][hh] *= il; }
#pragma unroll
            for (int c = 0; c < 8; ++c) pbar[64 * c + lane] = (p[c][0] + p[c][1]) + (p[c][2] + p[c][3]);
            f32x2 o[4];
#pragma unroll
            for (int hh = 0; hh < 4; ++hh) o[hh] = (f32x2){0.f, 0.f};
#pragma unroll
            for (int c = 0; c < 8; ++c) {
                if (64 * c < nvalid) { const int je = (nvalid - 64 * c) < 64 ? (nvalid - 64 * c) : 64;
                    for (int j = 0; j < je; ++j) { const half2v v2 = *(const half2v*)(VC + (size_t)(64 * c + j) * 128 + 2 * lane); const f32x2 vf = {(float)v2.x, (float)v2.y};
#pragma unroll
                        for (int hh = 0; hh < 4; ++hh) o[hh] += bcast_lane(p[c][hh], j) * vf; } } }
#pragma unroll
            for (int hh = 0; hh < 4; ++hh) y[hh] += gt[hh][0] * o[hh];
        }
        unsigned long long sel_lo, sel_hi;
        {
            const int cur = t >> 6;
            float sc2[2];
#pragma unroll
            for (int q = 0; q < 2; ++q) { const int j = lane + 64 * q; float im = 0.f;
#pragma unroll
                for (int d = -1; d <= 3; ++d) { const int n = 4 * j + d; if (n >= 0 && n < 512) im += pbar[n]; }
                const bool valid = 64 * j <= t; const bool forced = (j == 0) || (j == cur) || (j == cur - 1);
                sc2[q] = valid ? im + (forced ? 1.0e4f : 0.f) : -1.f; impv[j] = sc2[q]; }
            int rk0 = 0, rk1 = 0;
            for (int j = 0; j < 128; ++j) { const float v = impv[j];
                rk0 += (v > sc2[0] || (v == sc2[0] && j < lane)) ? 1 : 0;
                rk1 += (v > sc2[1] || (v == sc2[1] && j < lane + 64)) ? 1 : 0; }
            sel_lo = __ballot(rk0 < 16 && 64 * lane <= t);
            sel_hi = __ballot(rk1 < 16 && 64 * (lane + 64) <= t);
        }
#pragma unroll 1
        for (int br = 1; br < 3; ++br) {
            const h16* KB = U + (size_t)b * SEQ * DINP + (br == 1 ? OFF_KS : OFF_KW) + g * 128;
            const h16* VB = U + (size_t)b * SEQ * DINP + (br == 1 ? OFF_VS : OFF_VW) + g * 128;
            float m[4], l[4]; f32x2 o[4];
#pragma unroll
            for (int hh = 0; hh < 4; ++hh) { m[hh] = -1.0e30f; l[hh] = 0.f; o[hh] = (f32x2){0.f, 0.f}; }
            const int nchunk = br == 1 ? 128 : 8; const int wstart = t - 511;
#pragma unroll 1
            for (int ci = 0; ci < nchunk; ++ci) {
                int p0;
                if (br == 1) { const bool on = ci < 64 ? ((sel_lo >> ci) & 1ull) : ((sel_hi >> (ci - 64)) & 1ull); if (!on) continue; p0 = 64 * ci; }
                else { p0 = wstart + 64 * ci; if (p0 + 63 < 0) continue; }
                const int pos = p0 + lane; const bool valid = pos >= 0 && pos <= t;
                float s[4] = {0.f, 0.f, 0.f, 0.f};
                if (valid) dot4(KB + (size_t)pos * DINP, qf, s);
                float pr[4];
#pragma unroll
                for (int hh = 0; hh < 4; ++hh) { const float sv = valid ? s[hh] * scale : -3.0e38f; const float mb = wave_max(sv); const float mn = fmaxf(m[hh], mb);
                    const float al = __expf(m[hh] - mn); const float e = valid ? __expf(sv - mn) : 0.f; pr[hh] = e;
                    l[hh] = l[hh] * al + wave_sum(e); o[hh] *= al; m[hh] = mn; }
                const int j0 = p0 < 0 ? -p0 : 0; const int je = (t - p0) < 63 ? (t - p0) : 63;
                for (int j = j0; j <= je; ++j) { const half2v v2 = *(const half2v*)(VB + (size_t)(p0 + j) * DINP + 2 * lane); const f32x2 vf = {(float)v2.x, (float)v2.y};
#pragma unroll
                    for (int hh = 0; hh < 4; ++hh) o[hh] += bcast_lane(pr[hh], j) * vf; }
            }
#pragma unroll
            for (int hh = 0; hh < 4; ++hh) y[hh] += (gt[hh][br] / l[hh]) * o[hh];
        }
#pragma unroll
        for (int hh = 0; hh < 4; ++hh) *(f32x2*)(Y + row * 1024 + (4 * g + hh) * 128 + 2 * lane) = y[hh];
    }
}

__device__ __forceinline__ void attn_norm_rows(const Ptrs& P, int G, int bid) {
    const int lane = threadIdx.x & 63, wave = threadIdx.x >> 6;
    const float* Y = (const float*)(P.ws + WS_YACC); h16* MIX = (h16*)(P.ws + WS_H); const float* gw = P.in[15];
    for (int r = bid * 8 + wave; r < NT; r += G * 8) {
        f32x4 v[4]; float ss = 0.f;
#pragma unroll
        for (int i = 0; i < 4; ++i) { v[i] = *(const f32x4*)(Y + (size_t)r * 1024 + 4 * (lane + 64 * i)); ss += v[i][0] * v[i][0] + v[i][1] * v[i][1] + v[i][2] * v[i][2] + v[i][3] * v[i][3]; }
        ss = wave_sum(ss); const float rstd = rsqrtf(ss * (1.f / 1024.f) + EPS);
#pragma unroll
        for (int i = 0; i < 4; ++i) { const int c = 4 * (lane + 64 * i); const f32x4 g = *(const f32x4*)(gw + c); const f32x4 o = v[i] * rstd * g;
            u32x2 w; w.x = pg8::pk_h2(o[0], o[1]); w.y = pg8::pk_h2(o[2], o[3]);
            *(u32x2*)(MIX + (size_t)r * DM + 1024 + c) = w; }
    }
}

constexpr int NPHASE = 12;
struct Args { Ptrs p; int ph_lo, ph_hi; };

__global__ void __launch_bounds__(NTHR, 2) mega(Args args) {
    extern __shared__ __attribute__((aligned(16))) unsigned char lds_raw[];
    LAS unsigned char* lds = (LAS unsigned char*)lds_raw;
    const Ptrs& P = args.p;
    const int G = gridDim.x, bid = blockIdx.x;
    unsigned char* ws = P.ws;
    const float* mod = (const float*)(ws + WS_MOD);
    const int lo = args.ph_lo, hi = args.ph_hi;
#define PHASE_BEGIN(n) if (lo <= (n) && (n) < hi) {
#define PHASE_END(n) if ((n) + 1 < hi) { cg::this_grid().sync(); } }
    PHASE_BEGIN(0) p0_prologue(P, lds, G, bid); PHASE_END(0)
    PHASE_BEGIN(1) norm_mod_rows(P.in[0], P.in[4], mod, 0, 2048, (h16*)(ws + WS_H), G, bid); PHASE_END(1)
    PHASE_BEGIN(2) { pg8::Gemm g{(const h16*)(ws + WS_H), (const h16*)(ws + WS_WIN), NT, DINP, DM}; pg8::StaticOrder S; S.init(NT, DINP, G, bid);
                  pg8::EpiF16<0> E{(h16*)(ws + WS_U), DINP}; pg8::gemm_phase(lds, g, S, E); } PHASE_END(2)
    PHASE_BEGIN(3) post_u_rows(P, G, bid); PHASE_END(3)
    PHASE_BEGIN(4) compress_phase(P, lds, G, bid); PHASE_END(4)
    PHASE_BEGIN(5) PHASE_END(5)
    PHASE_BEGIN(6) attn_norm_rows(P, G, bid); PHASE_END(6)
    PHASE_BEGIN(7) { pg8::Gemm g{(const h16*)(ws + WS_H), (const h16*)(ws + WS_WOUT), NT, DM, DM}; pg8::StaticOrder S; S.init(NT, DM, G, bid);
                  pg8::EpiRes E{P.in[0], P.out, mod + 2 * 2048, 12288}; pg8::gemm_phase(lds, g, S, E); } PHASE_END(7)
    PHASE_BEGIN(8) norm_mod_rows(P.out, P.in[17], mod, 3 * 2048, 4 * 2048, (h16*)(ws + WS_H), G, bid); PHASE_END(8)
    PHASE_BEGIN(9) { pg8::Gemm g{(const h16*)(ws + WS_H), (const h16*)(ws + WS_W1), NT, DFF, DM}; pg8::StaticOrder S; S.init(NT, DFF, G, bid);
                  pg8::EpiF16<1> E{(h16*)(ws + WS_HID), DFF}; pg8::gemm_phase(lds, g, S, E); } PHASE_END(9)
    PHASE_BEGIN(10) { pg8::Gemm g{(const h16*)(ws + WS_HID), (const h16*)(ws + WS_W2), NT, DM, DFF}; pg8::StaticOrder S; S.init(NT, DM, G, bid);
                   pg8::EpiRes E{P.out, P.out, mod + 5 * 2048, 12288}; pg8::gemm_phase(lds, g, S, E); } PHASE_END(10)
    PHASE_BEGIN(11) final_norm_rows(P.out, P.in[20], G, bid); PHASE_END(11)
}

__global__ void __launch_bounds__(NTHR, 2) attn_simple_kernel(Args args) {
    extern __shared__ __attribute__((aligned(16))) unsigned char lds_raw[];
    attn_simple(args.p, (LAS unsigned char*)lds_raw, gridDim.x, blockIdx.x);
}

extern "C" void kernel_launch(void* const* d_in, const int* in_sizes, int n_in, void* d_out, int out_size, void* d_ws, size_t ws_size, hipStream_t stream) {
    static int grid = 0;
    if (grid == 0) {
        if (n_in != 21 || out_size != NT * DM || ws_size < WS_END) { fprintf(stderr, "kernel_launch: unexpected shapes (n_in %d out %d ws %zu need %zu)\n", n_in, out_size, ws_size, (size_t)WS_END); grid = -1; return; }
        int dev = 0, cus = 0, per_cu = 0;
        hipGetDevice(&dev); hipDeviceGetAttribute(&cus, hipDeviceAttributeMultiprocessorCount, dev);
        if (hipFuncSetAttribute((const void*)mega, hipFuncAttributeMaxDynamicSharedMemorySize, LDS_BYTES) != hipSuccess) { fprintf(stderr, "kernel_launch: hipFuncSetAttribute failed\n"); grid = -1; return; }
        if (hipOccupancyMaxActiveBlocksPerMultiprocessor(&per_cu, (const void*)mega, NTHR, LDS_BYTES) != hipSuccess || per_cu < 1) { fprintf(stderr, "kernel_launch: occupancy query says %d\n", per_cu); per_cu = 1; }
        (void)hipGetLastError();
        grid = cus * 1;
        fprintf(stderr, "kernel_launch: cus %d per_cu %d grid %d\n", cus, per_cu, grid);
    }
    if (grid < 0) return;
    Args a{};
    for (int i = 0; i < 21; ++i) a.p.in[i] = (const float*)d_in[i];
    a.p.out = (float*)d_out; a.p.ws = (unsigned char*)d_ws;
#if ONE_LAUNCH
    a.ph_lo = 0; a.ph_hi = NPHASE;
    void* kargs[] = {&a};
    hipError_t e = hipLaunchCooperativeKernel((const void*)mega, dim3(grid), dim3(NTHR), kargs, LDS_BYTES, stream);
    if (e != hipSuccess) fprintf(stderr, "cooperative launch failed: %s (grid %d)\n", hipGetErrorString(e), grid);
#else
    for (int ph = 0; ph < NPHASE; ++ph) {
        a.ph_lo = ph; a.ph_hi = ph + 1;
        if (ph == 5) hipLaunchKernelGGL(attn_simple_kernel, dim3(grid * 4), dim3(NTHR), 48 * 1024, stream, a);
        else hipLaunchKernelGGL(mega, dim3(grid), dim3(NTHR), LDS_BYTES, stream, a);
    }
#endif
}
```

```cpp
#include <hip/hip_runtime.h>
#include <hip/hip_cooperative_groups.h>
#include <cstdint>
#include <cstdio>
namespace cg = cooperative_groups;

#ifndef ONE_LAUNCH
#define ONE_LAUNCH 1
#endif
#ifndef FAST_ATTN
#define FAST_ATTN 1
#endif

#define LAS __attribute__((address_space(3)))
typedef _Float16 h16;
typedef _Float16 half8 __attribute__((ext_vector_type(8)));
typedef _Float16 half4 __attribute__((ext_vector_type(4)));
typedef _Float16 half2v __attribute__((ext_vector_type(2)));
typedef float f32x4 __attribute__((ext_vector_type(4)));
typedef float f32x2 __attribute__((ext_vector_type(2)));
typedef unsigned u32x4 __attribute__((ext_vector_type(4)));
typedef unsigned u32x2 __attribute__((ext_vector_type(2)));

constexpr int NB = 4, SEQ = 8192, NT = NB * SEQ, DM = 2048, DIN = 5656, DINP = 5888, DFF = 8192;
constexpr int OFF_UB = 0, OFF_UC = 1024, OFF_UH = 2048, OFF_Q = 3072, OFF_KC = 4096, OFF_VC = 4352, OFF_KS = 4608, OFF_VS = 4864,
              OFF_KW = 5120, OFF_VW = 5376, OFF_GL = 5632;
constexpr float EPS = 1e-6f;
constexpr int NTHR = 512;
constexpr int LDS_BYTES = 136 * 1024;

constexpr size_t WS_MOD   = 4096;
constexpr size_t WS_B1P   = WS_MOD + (size_t)4 * 12288 * 4;
constexpr size_t WS_WIN   = WS_B1P + (size_t)2 * 32 * 256 * 4;
constexpr size_t WS_WOUT  = WS_WIN + (size_t)DINP * DM * 2;
constexpr size_t WS_W1    = WS_WOUT + (size_t)DM * DM * 2;
constexpr size_t WS_W2    = WS_W1 + (size_t)DFF * DM * 2;
constexpr size_t WS_CW1K  = WS_W2 + (size_t)DFF * DM * 2;
constexpr size_t WS_CW1V  = WS_CW1K + (size_t)256 * 4096 * 2;
constexpr size_t WS_CW2K  = WS_CW1V + (size_t)256 * 4096 * 2;
constexpr size_t WS_CW2V  = WS_CW2K + (size_t)128 * 256 * 2;
constexpr size_t WS_KCMP  = WS_CW2V + (size_t)128 * 256 * 2;
constexpr size_t WS_VCMP  = WS_KCMP + (size_t)8 * 512 * 128 * 2;
constexpr size_t WS_H     = WS_VCMP + (size_t)8 * 512 * 128 * 2;
constexpr size_t WS_BIG   = WS_H + (size_t)NT * DM * 2;
constexpr size_t WS_U     = WS_BIG;
constexpr size_t WS_YACC  = WS_U + (size_t)NT * DINP * 2;
constexpr size_t WS_HID   = WS_BIG;
constexpr size_t WS_END   = WS_BIG + (size_t)NT * DFF * 2;
static_assert(WS_YACC + (size_t)NT * 1024 * 4 <= WS_END, "ws map");
static_assert(WS_END <= (size_t)1073741824, "ws map fits 4x largest tensor");
static_assert(WS_WIN % 256 == 0 && WS_H % 256 == 0 && WS_BIG % 256 == 0 && WS_YACC % 256 == 0, "alignment");

namespace pg8 {
constexpr int BM = 256, BK = 64, HALF = 128, HTB = HALF * BK * 2, STAGE_BYTES = 8 * HTB, NXCD = 8, WGM = 8;
__host__ __device__ __forceinline__ int lds_byte(int r, int c) { const int st = (r >> 4) * 2 + (c >> 5), rr = r & 15, cc = c & 31, ob = rr * 64 + cc * 2; return st * 1024 + (ob ^ (((ob >> 9) & 1) << 5)); }
__host__ __device__ __forceinline__ void stage_rc(int b, int& R, int& C) { const int st = b / 1024, sb = b % 1024, swz = sb ^ (((sb >> 9) & 1) << 5); R = (st >> 1) * 16 + swz / 64; C = (st & 1) * 32 + (swz % 64) / 2; }
__host__ __device__ __forceinline__ int perm32(int rho) { const int n = rho >> 4, i = rho & 15; return 8 * (i >> 2) + 4 * n + (i & 3); }

struct Unit { int pm, pn; };
struct Gemm { const h16* A; const h16* Bt; int M, N, K; };

struct StaticOrder {
    int nM, nN, nwg, G, c;
    __host__ __device__ void init(int M, int N, int G_, int c_) { nM = M / BM; nN = N / BM; nwg = nM * nN; G = G_; c = c_; }
    __host__ __device__ bool next(int i, Unit& u) const {
        const long L = (long)i * G + c; if (L >= nwg) return false;
        int wgid = (int)L; { const int q = nwg / NXCD, r = nwg % NXCD, xcd = wgid % NXCD, off = wgid / NXCD; wgid = (xcd < r ? xcd * (q + 1) : r * (q + 1) + (xcd - r) * q) + off; }
        const int nig = WGM * nN, gid = wgid / nig, fm = gid * WGM, gsz = (nM - fm) < WGM ? (nM - fm) : WGM;
        u.pm = fm + ((wgid % nig) % gsz); u.pn = (wgid % nig) / gsz; return true;
    }
    __device__ __forceinline__ void a_ready(const Unit&) const {}
    __device__ __forceinline__ void done(const Unit&) const {}
};

__device__ __forceinline__ unsigned pk_h2(float lo, float hi) { half2v v; v.x = (h16)lo; v.y = (h16)hi; return __builtin_bit_cast(unsigned, v); }

template <int ACT> struct EpiF16 {
    static constexpr bool PERM = true, AFTER_DRAIN = false;
    h16* O; int ldc;
    __device__ __forceinline__ void operator()(const f32x4 (&acc)[2][2][4][2], const Unit& u, int wr, int wc, int fr, int fq) const {
        const int row0 = u.pm * BM + wr * 64 + fr; const int col0 = u.pn * BM + wc * 32 + 8 * fq;
#pragma unroll
        for (int ai = 0; ai < 2; ++ai)
#pragma unroll
            for (int m = 0; m < 4; ++m) { h16* rowp = O + (size_t)(row0 + ai * HALF + m * 16) * ldc + col0;
#pragma unroll
                for (int bj = 0; bj < 2; ++bj) { f32x4 v0 = acc[ai][bj][m][0], v1 = acc[ai][bj][m][1];
                    if (ACT == 1) {
#pragma unroll
                        for (int j = 0; j < 4; ++j) { const float a = fmaxf(v0[j], 0.f), b = fmaxf(v1[j], 0.f); v0[j] = a * a; v1[j] = b * b; } }
                    u32x4 w; w.x = pk_h2(v0[0], v0[1]); w.y = pk_h2(v0[2], v0[3]); w.z = pk_h2(v1[0], v1[1]); w.w = pk_h2(v1[2], v1[3]);
                    *(u32x4*)(rowp + bj * HALF) = w; } }
    }
};
struct EpiRes {
    static constexpr bool PERM = false, AFTER_DRAIN = false;
    const float* base; float* out; const float* gate; int gate_ld;
    __device__ __forceinline__ void operator()(const f32x4 (&acc)[2][2][4][2], const Unit& u, int wr, int wc, int fr, int fq) const {
        const int row0 = u.pm * BM + wr * 64 + fr, col0 = u.pn * BM + wc * 32 + 4 * fq; const int b = (u.pm * BM) / SEQ;
        f32x4 gv[2][2];
#pragma unroll
        for (int bj = 0; bj < 2; ++bj)
#pragma unroll
            for (int n = 0; n < 2; ++n) gv[bj][n] = *(const f32x4*)(gate + (size_t)b * gate_ld + col0 + bj * HALF + n * 16);
#pragma unroll
        for (int ai = 0; ai < 2; ++ai)
#pragma unroll
            for (int m = 0; m < 4; ++m) { const size_t ro = (size_t)(row0 + ai * HALF + m * 16) * DM + col0;
#pragma unroll
                for (int bj = 0; bj < 2; ++bj)
#pragma unroll
                    for (int n = 0; n < 2; ++n) { const f32x4 bv = *(const f32x4*)(base + ro + bj * HALF + n * 16);
                        *(f32x4*)(out + ro + bj * HALF + n * 16) = bv + gv[bj][n] * acc[ai][bj][m][n]; } }
    }
};

template <class Epi, class Sched>
__device__ __forceinline__ void gemm_phase(LAS unsigned char* lds, const Gemm g, const Sched& S, const Epi& E) {
    const int tid = threadIdx.x, wid = __builtin_amdgcn_readfirstlane(tid >> 6), lane = tid & 63, wr = wid >> 2, wc = wid & 3, fr = lane & 15, fq = lane >> 4;
    const int K = g.K, nt = K / BK;
    unsigned voffA[2], voffB[2];
#pragma unroll
    for (int i = 0; i < 2; ++i) { int R, C; stage_rc(tid * 16 + i * 8192, R, C); const int Rb = Epi::PERM ? ((R & ~31) + perm32(R & 31)) : R;
        voffA[i] = (unsigned)(R * K + C) * 2u; voffB[i] = (unsigned)(Rb * K + C) * 2u; }
    const size_t kstep = (size_t)(BK * 2);
    const size_t hstep = (size_t)HALF * K * 2;
    const size_t tstep = 2 * hstep;
    const unsigned ldsw = (unsigned)wid * 1024u;
    const int aoff = lds_byte(wr * 64 + fr, fq * 8), boff = lds_byte(wc * 32 + fr, fq * 8);
#define PG8_SA(b, h) (((b) * 2 + (h)) * HTB)
#define PG8_SB(b, h) ((4 + (b) * 2 + (h)) * HTB)
#define PG8_STAGE(bufoff, gbase, voff) do { _Pragma("unroll") for (int _i = 0; _i < 2; ++_i) \
        __builtin_amdgcn_global_load_lds((const unsigned*)((const char*)(gbase) + (voff)[_i]), (LAS unsigned*)(lds + (bufoff) + ldsw + _i * 8192), 16, 0, 0); } while (0)
#define PG8_LDA(dst, b, h) do { _Pragma("unroll") for (int m = 0; m < 4; ++m) _Pragma("unroll") for (int k = 0; k < 2; ++k) dst[m][k] = *(const LAS half8*)(lds + PG8_SA(b, h) + aoff + m * 2048 + k * 1024); } while (0)
#define PG8_LDB(dst, b, h) do { _Pragma("unroll") for (int n = 0; n < 2; ++n) _Pragma("unroll") for (int k = 0; k < 2; ++k) dst[n][k] = *(const LAS half8*)(lds + PG8_SB(b, h) + boff + n * 2048 + k * 1024); } while (0)
#define PG8_MMA(ai, bj, At, Bt) do { __builtin_amdgcn_s_setprio(1); _Pragma("unroll") for (int m = 0; m < 4; ++m) _Pragma("unroll") for (int n = 0; n < 2; ++n) _Pragma("unroll") for (int k = 0; k < 2; ++k) \
        acc[ai][bj][m][n] = __builtin_amdgcn_mfma_f32_16x16x32_f16(Bt[n][k], At[m][k], acc[ai][bj][m][n], 0, 0, 0); __builtin_amdgcn_s_setprio(0); } while (0)
#define PG8_WAIT_V(n) asm volatile("s_waitcnt vmcnt(" #n ")" ::: "memory")
#define PG8_WAIT_L(n) asm volatile("s_waitcnt lgkmcnt(" #n ")" ::: "memory")
#define PG8_BAR __builtin_amdgcn_s_barrier()
#define PG8_SCHED __builtin_amdgcn_sched_barrier(0)
    Unit cur, nxt; int ui = 0;
    if (!S.next(0, cur)) return;
    f32x4 acc[2][2][4][2];
#pragma unroll
    for (int a = 0; a < 2; ++a)
#pragma unroll
        for (int b = 0; b < 2; ++b)
#pragma unroll
            for (int m = 0; m < 4; ++m)
#pragma unroll
                for (int n = 0; n < 2; ++n) acc[a][b][m][n] = (f32x4){0.f, 0.f, 0.f, 0.f};
    half8 At[4][2], B0[2][2], B1[2][2];
    const char* cA = (const char*)g.A + (size_t)cur.pm * tstep; const char* cB = (const char*)g.Bt + (size_t)cur.pn * tstep;
    S.a_ready(cur);
    PG8_STAGE(PG8_SB(0, 0), cB, voffB); PG8_STAGE(PG8_SA(0, 0), cA, voffA); PG8_STAGE(PG8_SB(0, 1), cB + hstep, voffB); PG8_STAGE(PG8_SA(0, 1), cA + hstep, voffA);
    if (wr == 1) PG8_BAR;
    PG8_WAIT_V(4); PG8_BAR;
    PG8_STAGE(PG8_SB(1, 0), cB + kstep, voffB); PG8_STAGE(PG8_SA(1, 0), cA + kstep, voffA); PG8_STAGE(PG8_SB(1, 1), cB + hstep + kstep, voffB);
    PG8_WAIT_V(6); PG8_BAR;
    for (;;) {
        const bool has_next = S.next(ui + 1, nxt);
        const char* nA = has_next ? (const char*)g.A + (size_t)nxt.pm * tstep : cA; const char* nB = has_next ? (const char*)g.Bt + (size_t)nxt.pn * tstep : cB;
        for (int t = 0; t < nt; t += 2) {
            const bool last = (t == nt - 2);
            const char* a1 = cA + (size_t)(t + 1) * kstep;
            const char* a2 = last ? nA : cA + (size_t)(t + 2) * kstep; const char* b2 = last ? nB : cB + (size_t)(t + 2) * kstep;
            const char* a3 = a2 + kstep; const char* b3 = b2 + kstep;
            if (last && has_next) S.a_ready(nxt);
            PG8_LDB(B0, 0, 0); PG8_SCHED; PG8_LDA(At, 0, 0); PG8_STAGE(PG8_SA(1, 1), a1 + hstep, voffA);
            PG8_WAIT_L(8); PG8_BAR; PG8_WAIT_L(0); PG8_MMA(0, 0, At, B0); PG8_BAR; PG8_SCHED;
            PG8_LDB(B1, 0, 1); PG8_STAGE(PG8_SB(0, 0), b2, voffB);
            PG8_BAR; PG8_WAIT_L(0); PG8_MMA(0, 1, At, B1); PG8_BAR;
            PG8_LDA(At, 0, 1); PG8_STAGE(PG8_SA(0, 0), a2, voffA);
            PG8_BAR; PG8_WAIT_L(0); PG8_MMA(1, 0, At, B0); PG8_BAR; PG8_SCHED;
            PG8_STAGE(PG8_SB(0, 1), b2 + hstep, voffB);
            PG8_WAIT_V(6); PG8_BAR; PG8_MMA(1, 1, At, B1); PG8_BAR;
            PG8_LDB(B0, 1, 0); PG8_SCHED; PG8_LDA(At, 1, 0); PG8_STAGE(PG8_SA(0, 1), a2 + hstep, voffA);
            PG8_WAIT_L(8); PG8_BAR; PG8_WAIT_L(0); PG8_MMA(0, 0, At, B0); PG8_BAR; PG8_SCHED;
            PG8_LDB(B1, 1, 1); PG8_STAGE(PG8_SB(1, 0), b3, voffB);
            PG8_BAR; PG8_WAIT_L(0); PG8_MMA(0, 1, At, B1); PG8_BAR;
            PG8_LDA(At, 1, 1); PG8_STAGE(PG8_SA(1, 0), a3, voffA);
            PG8_BAR; PG8_WAIT_L(0); PG8_MMA(1, 0, At, B0); PG8_BAR; PG8_SCHED;
            PG8_STAGE(PG8_SB(1, 1), b3 + hstep, voffB);
            PG8_WAIT_V(6); PG8_BAR; PG8_MMA(1, 1, At, B1); PG8_BAR;
        }
        E(acc, cur, wr, wc, fr, fq); S.done(cur);
        if (!has_next) break;
#pragma unroll
        for (int a = 0; a < 2; ++a)
#pragma unroll
            for (int b = 0; b < 2; ++b)
#pragma unroll
                for (int m = 0; m < 4; ++m)
#pragma unroll
                    for (int n = 0; n < 2; ++n) acc[a][b][m][n] = (f32x4){0.f, 0.f, 0.f, 0.f};
        cur = nxt; cA = nA; cB = nB; ++ui;
    }
    PG8_WAIT_V(0);
    if (wr == 0) PG8_BAR;
    PG8_BAR;
#undef PG8_SA
#undef PG8_SB
#undef PG8_STAGE
#undef PG8_LDA
#undef PG8_LDB
#undef PG8_MMA
#undef PG8_WAIT_V
#undef PG8_WAIT_L
#undef PG8_BAR
#undef PG8_SCHED
}
}

__device__ __forceinline__ float wave_sum(float v) {
#pragma unroll
    for (int o = 1; o < 64; o <<= 1) v += __shfl_xor(v, o);
    return v;
}
__device__ __forceinline__ float wave_max(float v) {
#pragma unroll
    for (int o = 1; o < 64; o <<= 1) v = fmaxf(v, __shfl_xor(v, o));
    return v;
}
__device__ __forceinline__ float bcast_lane(float v, int j) { return __builtin_bit_cast(float, __builtin_amdgcn_readlane(__builtin_bit_cast(int, v), j)); }

struct Ptrs {
    const float* in[21]; float* out; unsigned char* ws;
};

constexpr int P0_ADA = 192, P0_B1 = 64;
constexpr int P0_TWIN = 32 * 92, P0_TWOUT = 32 * 32, P0_TW1 = 32 * 128, P0_TW2 = 128 * 32, P0_TC1 = 64 * 4, P0_TC2 = 4 * 2;
constexpr int P0_OFF_B1 = P0_ADA, P0_OFF_TWIN = P0_OFF_B1 + P0_B1, P0_OFF_TWOUT = P0_OFF_TWIN + P0_TWIN, P0_OFF_TW1 = P0_OFF_TWOUT + P0_TWOUT,
              P0_OFF_TW2 = P0_OFF_TW1 + P0_TW1, P0_OFF_TC1K = P0_OFF_TW2 + P0_TW2, P0_OFF_TC1V = P0_OFF_TC1K + P0_TC1, P0_OFF_TC2K = P0_OFF_TC1V + P0_TC1,
              P0_OFF_TC2V = P0_OFF_TC2K + P0_TC2, P0_ITEMS = P0_OFF_TC2V + P0_TC2;

__device__ __forceinline__ void transpose_tile(const float* __restrict__ W, int K, int N, h16* __restrict__ Wt, int item, LAS float* scr, int tid) {
    const int nkt = K / 64; const int kt = item % nkt, ntl = item / nkt;
    { const int r = tid >> 4, c4 = tid & 15;
#pragma unroll
      for (int i = 0; i < 2; ++i) { const int k = kt * 64 + r + 32 * i, n = ntl * 64 + 4 * c4;
          f32x4 v = (f32x4){0.f, 0.f, 0.f, 0.f}; if (n < N) v = *(const f32x4*)(W + (size_t)k * N + n);
#pragma unroll
          for (int j = 0; j < 4; ++j) scr[(r + 32 * i) * 65 + 4 * c4 + j] = v[j]; } }
    __syncthreads();
    { const int n = tid >> 3, kc = tid & 7; half8 o;
#pragma unroll
      for (int j = 0; j < 8; ++j) o[j] = (h16)scr[(8 * kc + j) * 65 + n];
      *(half8*)(Wt + (size_t)(ntl * 64 + n) * K + kt * 64 + 8 * kc) = o; }
    __syncthreads();
}

__device__ __forceinline__ void p0_prologue(const Ptrs& P, LAS unsigned char* lds, int G, int bid) {
    const int tid = threadIdx.x;
    LAS float* scr = (LAS float*)lds;
    unsigned char* ws = P.ws;
    for (int it = bid; it < P0_ITEMS; it += G) {
        if (it < P0_ADA) {
            LAS float* sc = scr;
            LAS float* red = scr + 8192;
            const float* c = P.in[1];
            for (int i = tid; i < 8192; i += NTHR) { const float v = c[i]; sc[i] = v / (1.f + __expf(-v)); }
            __syncthreads();
            const int cl = tid & 15, kg = tid >> 4;
            f32x4 a0 = {0, 0, 0, 0}, a1 = a0, a2 = a0, a3 = a0;
            const float* W = P.in[2] + 64 * it + 4 * cl;
#pragma unroll 4
            for (int k = kg; k < 2048; k += 32) { const f32x4 w = *(const f32x4*)(W + (size_t)k * 12288);
                a0 += sc[k] * w; a1 += sc[2048 + k] * w; a2 += sc[4096 + k] * w; a3 += sc[6144 + k] * w; }
#pragma unroll
            for (int j = 0; j < 4; ++j) { red[(kg * 4 + 0) * 64 + 4 * cl + j] = a0[j]; red[(kg * 4 + 1) * 64 + 4 * cl + j] = a1[j];
                red[(kg * 4 + 2) * 64 + 4 * cl + j] = a2[j]; red[(kg * 4 + 3) * 64 + 4 * cl + j] = a3[j]; }
            __syncthreads();
            if (tid < 256) { const int b = tid >> 6, col = tid & 63; float s = 0.f;
                for (int q = 0; q < 32; ++q) s += red[(q * 4 + b) * 64 + col];
                ((float*)(ws + WS_MOD))[b * 12288 + 64 * it + col] = s + P.in[3][64 * it + col]; }
            __syncthreads();
        } else if (it < P0_OFF_TWIN) {
            const int q = it - P0_OFF_B1, kv = q >> 5, part = q & 31;
            const float* pe = P.in[8 + kv]; const float* W1 = P.in[kv ? 12 : 10];
            const int col = tid & 255, kh = tid >> 8; float s = 0.f;
            for (int k = 128 * part + 64 * kh; k < 128 * part + 64 * kh + 64; ++k) s += pe[k] * W1[(size_t)k * 256 + col];
            scr[tid] = s; __syncthreads();
            if (tid < 256) ((float*)(ws + WS_B1P))[(kv * 32 + part) * 256 + tid] = scr[tid] + scr[tid + 256];
            __syncthreads();
        } else if (it < P0_OFF_TWOUT) transpose_tile(P.in[5], DM, DIN, (h16*)(ws + WS_WIN), it - P0_OFF_TWIN, scr, tid);
        else if (it < P0_OFF_TW1)     transpose_tile(P.in[16], DM, DM, (h16*)(ws + WS_WOUT), it - P0_OFF_TWOUT, scr, tid);
        else if (it < P0_OFF_TW2)     transpose_tile(P.in[18], DM, DFF, (h16*)(ws + WS_W1), it - P0_OFF_TW1, scr, tid);
        else if (it < P0_OFF_TC1K)    transpose_tile(P.in[19], DFF, DM, (h16*)(ws + WS_W2), it - P0_OFF_TW2, scr, tid);
        else if (it < P0_OFF_TC1V)    transpose_tile(P.in[10], 4096, 256, (h16*)(ws + WS_CW1K), it - P0_OFF_TC1K, scr, tid);
        else if (it < P0_OFF_TC2K)    transpose_tile(P.in[12], 4096, 256, (h16*)(ws + WS_CW1V), it - P0_OFF_TC1V, scr, tid);
        else if (it < P0_OFF_TC2V)    transpose_tile(P.in[11], 256, 128, (h16*)(ws + WS_CW2K), it - P0_OFF_TC2K, scr, tid);
        else                          transpose_tile(P.in[13], 256, 128, (h16*)(ws + WS_CW2V), it - P0_OFF_TC2V, scr, tid);
    }
}

__device__ __forceinline__ void norm_mod_rows(const float* __restrict__ X, const float* __restrict__ gw, const float* __restrict__ mod, int sh_off, int sc_off,
                                              h16* __restrict__ H, int G, int bid) {
    const int lane = threadIdx.x & 63, wave = threadIdx.x >> 6;
    for (int r = bid * 8 + wave; r < NT; r += G * 8) {
        const int b = r >> 13; const float* xr = X + (size_t)r * DM; f32x4 v[8]; float ss = 0.f;
#pragma unroll
        for (int i = 0; i < 8; ++i) { v[i] = *(const f32x4*)(xr + 4 * (lane + 64 * i)); ss += v[i][0] * v[i][0] + v[i][1] * v[i][1] + v[i][2] * v[i][2] + v[i][3] * v[i][3]; }
        ss = wave_sum(ss); const float rstd = rsqrtf(ss * (1.f / DM) + EPS);
        const float* mb = mod + (size_t)b * 12288;
#pragma unroll
        for (int i = 0; i < 8; ++i) { const int c = 4 * (lane + 64 * i);
            const f32x4 g = *(const f32x4*)(gw + c), sh = *(const f32x4*)(mb + sh_off + c), sc = *(const f32x4*)(mb + sc_off + c);
            const f32x4 o = (v[i] * rstd) * g * (1.f + sc) + sh;
            u32x2 w; w.x = pg8::pk_h2(o[0], o[1]); w.y = pg8::pk_h2(o[2], o[3]);
            *(u32x2*)(H + (size_t)r * DM + c) = w; }
    }
}
__device__ __forceinline__ void final_norm_rows(float* __restrict__ X, const float* __restrict__ gw, int G, int bid) {
    const int lane = threadIdx.x & 63, wave = threadIdx.x >> 6;
    for (int r = bid * 8 + wave; r < NT; r += G * 8) {
        float* xr = X + (size_t)r * DM; f32x4 v[8]; float ss = 0.f;
#pragma unroll
        for (int i = 0; i < 8; ++i) { v[i] = *(const f32x4*)(xr + 4 * (lane + 64 * i)); ss += v[i][0] * v[i][0] + v[i][1] * v[i][1] + v[i][2] * v[i][2] + v[i][3] * v[i][3]; }
        ss = wave_sum(ss); const float rstd = rsqrtf(ss * (1.f / DM) + EPS);
#pragma unroll
        for (int i = 0; i < 8; ++i) { const int c = 4 * (lane + 64 * i); const f32x4 g = *(const f32x4*)(gw + c); *(f32x4*)(xr + c) = (v[i] * rstd) * g; }
    }
}

__device__ __forceinline__ void post_u_rows(const Ptrs& P, int G, int bid) {
    const int lane = threadIdx.x & 63, wave = threadIdx.x >> 6;
    h16* U = (h16*)(P.ws + WS_U); h16* MIX = (h16*)(P.ws + WS_H);
    const float* cw = P.in[6]; const float* cb = P.in[7]; const float* gcv = P.in[14];
    const float inv = (float)exp2(-(double)lane * (13.287712379549449 / 64.0));
    for (int r = bid * 8 + wave; r < NT; r += G * 8) {
        const int pos = r & (SEQ - 1); h16* u = U + (size_t)r * DINP;
        const float ang = (float)pos * inv;
        double rev = (double)ang * 0.15915494309189535; rev -= __builtin_rint(rev);
        const float rf = (float)rev; const float cs = __builtin_amdgcn_cosf(rf), sn = __builtin_amdgcn_sinf(rf);
#pragma unroll
        for (int hd = 0; hd < 14; ++hd) {
            const int base = hd < 8 ? OFF_Q + 128 * hd : (hd < 10 ? OFF_KC + 128 * (hd - 8) : (hd < 12 ? OFF_KS + 128 * (hd - 10) : OFF_KW + 128 * (hd - 12)));
            const float x1 = (float)u[base + lane], x2 = (float)u[base + 64 + lane];
            u[base + lane] = (h16)(x1 * cs - x2 * sn); u[base + 64 + lane] = (h16)(x2 * cs + x1 * sn);
        }
        float y[16]; float ss = 0.f;
#pragma unroll
        for (int hf = 0; hf < 2; ++hf) {
            const int ch = 512 * hf + 8 * lane;
            const half8 ub = *(const half8*)(u + OFF_UB + ch), c0 = *(const half8*)(u + OFF_UC + ch), h0 = *(const half8*)(u + OFF_UH + ch);
            half8 c1 = c0 * (h16)0, h1 = c1, c2 = c1, h2 = c1;
            if (pos >= 1) { c1 = *(const half8*)(u - DINP + OFF_UC + ch); h1 = *(const half8*)(u - DINP + OFF_UH + ch); }
            if (pos >= 2) { c2 = *(const half8*)(u - 2 * DINP + OFF_UC + ch); h2 = *(const half8*)(u - 2 * DINP + OFF_UH + ch); }
#pragma unroll
            for (int j = 0; j < 8; ++j) {
                const float v0 = (float)c0[j] * (float)h0[j], v1 = (float)c1[j] * (float)h1[j], v2 = (float)c2[j] * (float)h2[j];
                const float z = cb[ch + j] + cw[ch + j] * v2 + cw[1024 + ch + j] * v1 + cw[2048 + ch + j] * v0;
                const float yy = (float)ub[j] * z; y[8 * hf + j] = yy; ss += yy * yy; }
        }
        ss = wave_sum(ss); const float rstd = rsqrtf(ss * (1.f / 1024.f) + EPS);
#pragma unroll
        for (int hf = 0; hf < 2; ++hf) { const int ch = 512 * hf + 8 * lane; half8 o;
#pragma unroll
            for (int j = 0; j < 8; ++j) o[j] = (h16)(y[8 * hf + j] * rstd * gcv[ch + j]);
            *(half8*)(MIX + (size_t)r * DM + ch) = o; }
    }
}

__device__ __forceinline__ float gelu_tanh(float x) {
    const float z = 0.7978845608028654f * (x + 0.044715f * x * x * x);
    const float e = __expf(2.f * z);
    const float th = 1.f - 2.f / (e + 1.f);
    return 0.5f * x * (1.f + th);
}
__device__ __forceinline__ void compress_phase(const Ptrs& P, LAS unsigned char* lds, int G, int bid) {
    const int tid = threadIdx.x, lane = tid & 63, w = tid >> 6, fr = lane & 15, fq = lane >> 4;
    const h16* U = (const h16*)(P.ws + WS_U);
    LAS h16* hid = (LAS h16*)lds;
    for (int unit = bid; unit < 256; unit += G) {
        const int kv = unit >> 7, bg = (unit >> 4) & 7, nb = unit & 15, b = bg >> 1, g = bg & 1, n0 = nb * 32;
        const h16* W1t = (const h16*)(P.ws + (kv ? WS_CW1V : WS_CW1K));
        const h16* W2t = (const h16*)(P.ws + (kv ? WS_CW2V : WS_CW2K));
        const float* b1p = (const float*)(P.ws + WS_B1P) + kv * 32 * 256;
        h16* OUT = (h16*)(P.ws + (kv ? WS_VCMP : WS_KCMP)) + (size_t)bg * 512 * 128;
        const int coff = (kv ? OFF_VC : OFF_KC) + g * 128;
        f32x4 acc[2][2];
#pragma unroll
        for (int i = 0; i < 2; ++i)
#pragma unroll
            for (int j = 0; j < 2; ++j) acc[i][j] = (f32x4){0.f, 0.f, 0.f, 0.f};
        for (int pos = 0; pos < 32; ++pos) {
#pragma unroll
            for (int ks = 0; ks < 4; ++ks) {
                half8 a[2], bb[2];
#pragma unroll
                for (int mt = 0; mt < 2; ++mt) { const int tok = 16 * (n0 + 16 * mt + fr) + pos;
                    half8 z;
#pragma unroll
                    for (int j = 0; j < 8; ++j) z[j] = (h16)0.f;
                    a[mt] = tok < SEQ ? *(const half8*)(U + (size_t)(b * SEQ + tok) * DINP + coff + 32 * ks + 8 * fq) : z; }
#pragma unroll
                for (int nt = 0; nt < 2; ++nt) bb[nt] = *(const half8*)(W1t + (size_t)(32 * w + 16 * nt + fr) * 4096 + pos * 128 + 32 * ks + 8 * fq);
#pragma unroll
                for (int mt = 0; mt < 2; ++mt)
#pragma unroll
                    for (int nt = 0; nt < 2; ++nt) acc[mt][nt] = __builtin_amdgcn_mfma_f32_16x16x32_f16(a[mt], bb[nt], acc[mt][nt], 0, 0, 0);
            }
        }
#pragma unroll
        for (int nt = 0; nt < 2; ++nt) { const int col = 32 * w + 16 * nt + fr; float bias = 0.f;
            for (int q = 0; q < 32; ++q) bias += b1p[q * 256 + col];
#pragma unroll
            for (int mt = 0; mt < 2; ++mt)
#pragma unroll
                for (int j = 0; j < 4; ++j) hid[(16 * mt + 4 * fq + j) * 264 + col] = (h16)gelu_tanh(acc[mt][nt][j] + bias); }
        __syncthreads();
        f32x4 acc2[2]; acc2[0] = (f32x4){0.f, 0.f, 0.f, 0.f}; acc2[1] = acc2[0];
#pragma unroll
        for (int ks = 0; ks < 8; ++ks) {
            const half8 bb = *(const half8*)(W2t + (size_t)(16 * w + fr) * 256 + 32 * ks + 8 * fq);
#pragma unroll
            for (int mt = 0; mt < 2; ++mt) { const half8 a = *(const LAS half8*)(hid + (16 * mt + fr) * 264 + 32 * ks + 8 * fq);
                acc2[mt] = __builtin_amdgcn_mfma_f32_16x16x32_f16(a, bb, acc2[mt], 0, 0, 0); }
        }
#pragma unroll
        for (int mt = 0; mt < 2; ++mt)
#pragma unroll
            for (int j = 0; j < 4; ++j) OUT[(size_t)(n0 + 16 * mt + 4 * fq + j) * 128 + 16 * w + fr] = (h16)acc2[mt][j];
        __syncthreads();
    }
}

__device__ __forceinline__ void dot4(const h16* __restrict__ kp, const LAS float* qf, float (&s)[4]) {
    s[0] = s[1] = s[2] = s[3] = 0.f;
#pragma unroll 4
    for (int c = 0; c < 16; ++c) { const half8 kk = *(const half8*)(kp + 8 * c);
#pragma unroll
        for (int j = 0; j < 8; ++j) { const float kf = (float)kk[j];
            s[0] += qf[8 * c + j] * kf; s[1] += qf[128 + 8 * c + j] * kf; s[2] += qf[256 + 8 * c + j] * kf; s[3] += qf[384 + 8 * c + j] * kf; } }
}
__device__ __forceinline__ void attn_simple(const Ptrs& P, LAS unsigned char* lds, int G, int bid) {
    const int lane = threadIdx.x & 63, wave = threadIdx.x >> 6;
    const h16* U = (const h16*)(P.ws + WS_U); float* Y = (float*)(P.ws + WS_YACC);
    LAS float* qf = (LAS float*)lds + wave * 1280;
    LAS float* pbar = qf + 512;
    LAS float* impv = pbar + 512;
    const float scale = 0.08838834764831845f;
    for (int wu = bid * 8 + wave; wu < NB * 2 * SEQ; wu += G * 8) {
        const int b = wu >> 14, g = (wu >> 13) & 1, t = wu & (SEQ - 1);
        const size_t row = (size_t)b * SEQ + t; const h16* urow = U + row * DINP;
#pragma unroll
        for (int hh = 0; hh < 4; ++hh) { const half2v q2 = *(const half2v*)(urow + OFF_Q + (4 * g + hh) * 128 + 2 * lane); qf[hh * 128 + 2 * lane] = (float)q2.x; qf[hh * 128 + 2 * lane + 1] = (float)q2.y; }
        float gt[4][3];
#pragma unroll
        for (int hh = 0; hh < 4; ++hh)
#pragma unroll
            for (int br = 0; br < 3; ++br) { const float x = (float)urow[OFF_GL + (4 * g + hh) * 3 + br]; gt[hh][br] = 1.f / (1.f + __expf(-x)); }
        f32x2 y[4];
#pragma unroll
        for (int hh = 0; hh < 4; ++hh) y[hh] = (f32x2){0.f, 0.f};
        const int nvalid = t >= 31 ? ((t - 31) >> 4) + 1 : 0;
        const h16* KC = (const h16*)(P.ws + WS_KCMP) + (size_t)(b * 2 + g) * 512 * 128;
        const h16* VC = (const h16*)(P.ws + WS_VCMP) + (size_t)(b * 2 + g) * 512 * 128;
        {
            float p[8][4];
#pragma unroll
            for (int c = 0; c < 8; ++c) { const int n = 64 * c + lane; float s[4] = {0.f, 0.f, 0.f, 0.f};
                if (64 * c < nvalid) dot4(KC + (size_t)n * 128, qf, s);
#pragma unroll
                for (int hh = 0; hh < 4; ++hh) p[c][hh] = n < nvalid ? s[hh] * scale : -3.0e38f; }
#pragma unroll
            for (int hh = 0; hh < 4; ++hh) { float m = -3.0e38f;
#pragma unroll
                for (int c = 0; c < 8; ++c) m = fmaxf(m, p[c][hh]);
                m = wave_max(m); float l = 0.f;
#pragma unroll
                for (int c = 0; c < 8; ++c) { const int n = 64 * c + lane; const float e = n < nvalid ? __expf(p[c][hh] - m) : 0.f; p[c][hh] = e; l += e; }
                l = wave_sum(l); const float il = l > 0.f ? 1.f / l : 0.f;
#pragma unroll
                for (int c = 0; c < 8; ++c) p[c][hh] *= il; }
#pragma unroll
            for (int c = 0; c < 8; ++c) pbar[64 * c + lane] = (p[c][0] + p[c][1]) + (p[c][2] + p[c][3]);
            f32x2 o[4];
#pragma unroll
            for (int hh = 0; hh < 4; ++hh) o[hh] = (f32x2){0.f, 0.f};
#pragma unroll
            for (int c = 0; c < 8; ++c) {
                if (64 * c < nvalid) { const int je = (nvalid - 64 * c) < 64 ? (nvalid - 64 * c) : 64;
                    for (int j = 0; j < je; ++j) { const half2v v2 = *(const half2v*)(VC + (size_t)(64 * c + j) * 128 + 2 * lane); const f32x2 vf = {(float)v2.x, (float)v2.y};
#pragma unroll
                        for (int hh = 0; hh < 4; ++hh) o[hh] += bcast_lane(p[c][hh], j) * vf; } } }
#pragma unroll
            for (int hh = 0; hh < 4; ++hh) y[hh] += gt[hh][0] * o[hh];
        }
        unsigned long long sel_lo, sel_hi;
        {
            const int cur = t >> 6;
            float sc2[2];
#pragma unroll
            for (int q = 0; q < 2; ++q) { const int j = lane + 64 * q; float im = 0.f;
#pragma unroll
                for (int d = -1; d <= 3; ++d) { const int n = 4 * j + d; if (n >= 0 && n < 512) im += pbar[n]; }
                const bool valid = 64 * j <= t; const bool forced = (j == 0) || (j == cur) || (j == cur - 1);
                sc2[q] = valid ? im + (forced ? 1.0e4f : 0.f) : -1.f; impv[j] = sc2[q]; }
            int rk0 = 0, rk1 = 0;
            for (int j = 0; j < 128; ++j) { const float v = impv[j];
                rk0 += (v > sc2[0] || (v == sc2[0] && j < lane)) ? 1 : 0;
                rk1 += (v > sc2[1] || (v == sc2[1] && j < lane + 64)) ? 1 : 0; }
            sel_lo = __ballot(rk0 < 16 && 64 * lane <= t);
            sel_hi = __ballot(rk1 < 16 && 64 * (lane + 64) <= t);
        }
#pragma unroll 1
        for (int br = 1; br < 3; ++br) {
            const h16* KB = U + (size_t)b * SEQ * DINP + (br == 1 ? OFF_KS : OFF_KW) + g * 128;
            const h16* VB = U + (size_t)b * SEQ * DINP + (br == 1 ? OFF_VS : OFF_VW) + g * 128;
            float m[4], l[4]; f32x2 o[4];
#pragma unroll
            for (int hh = 0; hh < 4; ++hh) { m[hh] = -1.0e30f; l[hh] = 0.f; o[hh] = (f32x2){0.f, 0.f}; }
            const int nchunk = br == 1 ? 128 : 8; const int wstart = t - 511;
#pragma unroll 1
            for (int ci = 0; ci < nchunk; ++ci) {
                int p0;
                if (br == 1) { const bool on = ci < 64 ? ((sel_lo >> ci) & 1ull) : ((sel_hi >> (ci - 64)) & 1ull); if (!on) continue; p0 = 64 * ci; }
                else { p0 = wstart + 64 * ci; if (p0 + 63 < 0) continue; }
                const int pos = p0 + lane; const bool valid = pos >= 0 && pos <= t;
                float s[4] = {0.f, 0.f, 0.f, 0.f};
                if (valid) dot4(KB + (size_t)pos * DINP, qf, s);
                float pr[4];
#pragma unroll
                for (int hh = 0; hh < 4; ++hh) { const float sv = valid ? s[hh] * scale : -3.0e38f; const float mb = wave_max(sv); const float mn = fmaxf(m[hh], mb);
                    const float al = __expf(m[hh] - mn); const float e = valid ? __expf(sv - mn) : 0.f; pr[hh] = e;
                    l[hh] = l[hh] * al + wave_sum(e); o[hh] *= al; m[hh] = mn; }
                const int j0 = p0 < 0 ? -p0 : 0; const int je = (t - p0) < 63 ? (t - p0) : 63;
                for (int j = j0; j <= je; ++j) { const half2v v2 = *(const half2v*)(VB + (size_t)(p0 + j) * DINP + 2 * lane); const f32x2 vf = {(float)v2.x, (float)v2.y};
#pragma unroll
                    for (int hh = 0; hh < 4; ++hh) o[hh] += bcast_lane(pr[hh], j) * vf; }
            }
#pragma unroll
            for (int hh = 0; hh < 4; ++hh) y[hh] += (gt[hh][br] / l[hh]) * o[hh];
        }
#pragma unroll
        for (int hh = 0; hh < 4; ++hh) *(f32x2*)(Y + row * 1024 + (4 * g + hh) * 128 + 2 * lane) = y[hh];
    }
}


typedef short s16x4 __attribute__((ext_vector_type(4)));
typedef short s16x8 __attribute__((ext_vector_type(8)));
__device__ __forceinline__ void af_qk(const LAS unsigned char* kbuf, const half8 (&qf)[2][4], f32x4 (&s)[2][4], bool a0, bool a1, int fr, int fq) {
#pragma unroll
    for (int kt = 0; kt < 4; ++kt) {
        s[0][kt] = (f32x4){0.f, 0.f, 0.f, 0.f}; s[1][kt] = (f32x4){0.f, 0.f, 0.f, 0.f};
#pragma unroll
        for (int ks = 0; ks < 4; ++ks) { const half8 kf = *(const LAS half8*)(kbuf + (16 * kt + fr) * 272 + ks * 64 + fq * 16);
            if (a0) s[0][kt] = __builtin_amdgcn_mfma_f32_16x16x32_f16(kf, qf[0][ks], s[0][kt], 0, 0, 0);
            if (a1) s[1][kt] = __builtin_amdgcn_mfma_f32_16x16x32_f16(kf, qf[1][ks], s[1][kt], 0, 0, 0); }
    }
}
__device__ __forceinline__ void af_pv(const LAS unsigned char* vbuf, const half8 (&pf)[2][2], f32x4 (&o)[2][8], bool a0, bool a1, int fr, int fq) {
    typedef short v4i16_t __attribute__((ext_vector_type(4)));
#pragma unroll
    for (int kp = 0; kp < 2; ++kp)
#pragma unroll
        for (int dt = 0; dt < 8; ++dt) {
            const LAS unsigned char* ad = vbuf + (32 * kp + 4 * fq + (fr >> 2)) * 288 + (16 * dt + 4 * (fr & 3)) * 2;
            const s16x4 lo = __builtin_amdgcn_ds_read_tr16_b64_v4i16((LAS v4i16_t*)ad);
            const s16x4 hi = __builtin_amdgcn_ds_read_tr16_b64_v4i16((LAS v4i16_t*)(ad + 16 * 288));
            s16x8 v8; v8[0] = lo[0]; v8[1] = lo[1]; v8[2] = lo[2]; v8[3] = lo[3]; v8[4] = hi[0]; v8[5] = hi[1]; v8[6] = hi[2]; v8[7] = hi[3];
            const half8 vf = __builtin_bit_cast(half8, v8);
            if (a0) o[0][dt] = __builtin_amdgcn_mfma_f32_16x16x32_f16(vf, pf[0][kp], o[0][dt], 0, 0, 0);
            if (a1) o[1][dt] = __builtin_amdgcn_mfma_f32_16x16x32_f16(vf, pf[1][kp], o[1][dt], 0, 0, 0);
        }
}
__device__ __forceinline__ void af_maskz(f32x4 (&s)[4], int mbase, int mstep, int fq, int hi, int lo, float SC) {
#pragma unroll
    for (int kt = 0; kt < 4; ++kt)
#pragma unroll
        for (int jj = 0; jj < 4; ++jj) { const int met = mbase + mstep * (16 * kt + 4 * fq + jj); s[kt][jj] = (met <= hi && met > lo) ? s[kt][jj] * SC : -1.0e30f; }
}
__device__ __forceinline__ float af_colmax(const f32x4 (&s)[4]) {
    float v = -1.0e30f;
#pragma unroll
    for (int kt = 0; kt < 4; ++kt) v = fmaxf(v, fmaxf(fmaxf(s[kt][0], s[kt][1]), fmaxf(s[kt][2], s[kt][3])));
    v = fmaxf(v, __shfl_xor(v, 16)); v = fmaxf(v, __shfl_xor(v, 32)); return v;
}
__device__ __forceinline__ void af_pack(const f32x4 (&s)[4], half8 (&pf)[2]) {
#pragma unroll
    for (int kp = 0; kp < 2; ++kp) { half8 h;
#pragma unroll
        for (int jj = 0; jj < 4; ++jj) { h[jj] = (h16)s[2 * kp][jj]; h[4 + jj] = (h16)s[2 * kp + 1][jj]; }
        pf[kp] = h; }
}
__device__ __forceinline__ void af_online(f32x4 (&s)[4], float& m, float& l, f32x4 (&o)[8], half8 (&pf)[2]) {
    const float mn = fmaxf(m, af_colmax(s)); const float al = __builtin_amdgcn_exp2f(m - mn); m = mn; float ps = 0.f;
#pragma unroll
    for (int kt = 0; kt < 4; ++kt)
#pragma unroll
        for (int jj = 0; jj < 4; ++jj) { const float p = s[kt][jj] > -1.0e29f ? __builtin_amdgcn_exp2f(s[kt][jj] - mn) : 0.f; s[kt][jj] = p; ps += p; }
    l = l * al + ps;
#pragma unroll
    for (int dt = 0; dt < 8; ++dt) o[dt] *= al;
    af_pack(s, pf);
}
__device__ __forceinline__ void af_write(float* Y, size_t row, int colbase, const f32x4 (&o)[8], float sc, bool accumulate) {
#pragma unroll
    for (int dt = 0; dt < 8; ++dt) { float* p = Y + row * 1024 + colbase + 16 * dt; f32x4 v = o[dt] * sc; if (accumulate) v += *(const f32x4*)p; *(f32x4*)p = v; }
}
__device__ __forceinline__ float af_sigmoid(float x) { return 1.f / (1.f + __expf(-x)); }

#define AF_LOAD(kb_, vb_, gs_, r0_, needv_) do { _Pragma("unroll") for (int _c = 0; _c < 2; ++_c) { const int _id = tid + 512 * _c, _row = _id >> 4, _ch = _id & 15; \
      const size_t _o = (size_t)((r0_) + _row) * (gs_) + _ch * 8; tk[_c] = *(const u32x4*)((kb_) + _o); if (needv_) tv[_c] = *(const u32x4*)((vb_) + _o); } } while (0)
#define AF_STORE(buf_, needv_) do { _Pragma("unroll") for (int _c = 0; _c < 2; ++_c) { const int _id = tid + 512 * _c, _row = _id >> 4, _ch = _id & 15; \
      *(LAS u32x4*)(KT + (buf_) * 17408 + _row * 272 + _ch * 16) = tk[_c]; if (needv_) *(LAS u32x4*)(VT + (buf_) * 18432 + _row * 288 + _ch * 16) = tv[_c]; } } while (0)

__device__ __forceinline__ void attn_fast(const Ptrs& P, LAS unsigned char* lds, int G, int bid) {
    const int tid = threadIdx.x, lane = tid & 63, w = __builtin_amdgcn_readfirstlane(tid >> 6), fr = lane & 15, fq = lane >> 4, qi = fr >> 2, hh = fr & 3;
    LAS unsigned char* KT = lds;
    LAS unsigned char* VT = lds + 34816;
    LAS float* IMP = (LAS float*)(lds + 34816 + 36864) + w * (8 * 132);
    LAS unsigned* SELM = (LAS unsigned*)(lds + 34816 + 36864 + 33792);
    const h16* U = (const h16*)(P.ws + WS_U); float* Y = (float*)(P.ws + WS_YACC);
    const float SC = 0.08838834764831845f * 1.4426950408889634f;
    const int NEGBIG = -(1 << 30);
    for (int pr = bid; pr < 256; pr += G) {
#pragma unroll 1
      for (int hf = 0; hf < 2; ++hf) {
        const int b = pr >> 6, qb = hf ? 127 - (pr & 63) : (pr & 63);
#pragma unroll 1
        for (int g = 0; g < 2; ++g) {
            int tq[2]; tq[0] = 64 * qb + 8 * w + qi; tq[1] = tq[0] + 4;
            const h16* Ub = U + (size_t)b * SEQ * DINP;
            half8 qf[2][4];
#pragma unroll
            for (int ct = 0; ct < 2; ++ct)
#pragma unroll
                for (int ks = 0; ks < 4; ++ks) qf[ct][ks] = *(const half8*)(Ub + (size_t)tq[ct] * DINP + OFF_Q + (4 * g + hh) * 128 + 32 * ks + 8 * fq);
            for (int i = lane; i < 8 * 132; i += 64) IMP[i] = 0.f;
            u32x4 tk[2], tv[2];
            f32x4 s[2][4];
            const int colbase = (4 * g + hh) * 128 + 4 * fq;
            const h16* KC = (const h16*)(P.ws + WS_KCMP) + (size_t)(b * 2 + g) * 512 * 128;
            const h16* VC = (const h16*)(P.ws + WS_VCMP) + (size_t)(b * 2 + g) * 512 * 128;
            const int ntc = ((4 * qb + 2) >> 6) + 1;
            float m[2], l[2];
            m[0] = m[1] = -1.0e30f; l[0] = l[1] = 0.f;
            AF_LOAD(KC, VC, 128, 0, false); AF_STORE(0, false); __syncthreads();
#pragma unroll 1
            for (int T = 0; T < ntc; ++T) {
                if (T + 1 < ntc) AF_LOAD(KC, VC, 128, 64 * (T + 1), false);
                af_qk(KT + (T & 1) * 17408, qf, s, true, true, fr, fq);
#pragma unroll
                for (int ct = 0; ct < 2; ++ct) { af_maskz(s[ct], 1024 * T + 31, 16, fq, tq[ct], NEGBIG, SC);
                    const float mn = fmaxf(m[ct], af_colmax(s[ct])); const float al = __builtin_amdgcn_exp2f(m[ct] - mn); m[ct] = mn; float ps = 0.f;
#pragma unroll
                    for (int kt = 0; kt < 4; ++kt)
#pragma unroll
                        for (int jj = 0; jj < 4; ++jj) ps += s[ct][kt][jj] > -1.0e29f ? __builtin_amdgcn_exp2f(s[ct][kt][jj] - mn) : 0.f;
                    l[ct] = l[ct] * al + ps; }
                if (T + 1 < ntc) AF_STORE((T + 1) & 1, false);
                __syncthreads();
            }
            float il[2];
#pragma unroll
            for (int ct = 0; ct < 2; ++ct) { float lt = l[ct]; lt += __shfl_xor(lt, 16); lt += __shfl_xor(lt, 32); il[ct] = lt > 0.f ? 1.f / lt : 0.f; }
            f32x4 o[2][8];
#pragma unroll
            for (int ct = 0; ct < 2; ++ct)
#pragma unroll
                for (int dt = 0; dt < 8; ++dt) o[ct][dt] = (f32x4){0.f, 0.f, 0.f, 0.f};
            AF_LOAD(KC, VC, 128, 0, true); AF_STORE(0, true); __syncthreads();
#pragma unroll 1
            for (int T = 0; T < ntc; ++T) {
                if (T + 1 < ntc) AF_LOAD(KC, VC, 128, 64 * (T + 1), true);
                af_qk(KT + (T & 1) * 17408, qf, s, true, true, fr, fq);
                half8 pf[2][2];
#pragma unroll
                for (int ct = 0; ct < 2; ++ct) { af_maskz(s[ct], 1024 * T + 31, 16, fq, tq[ct], NEGBIG, SC);
#pragma unroll
                    for (int kt = 0; kt < 4; ++kt) {
#pragma unroll
                        for (int jj = 0; jj < 4; ++jj) s[ct][kt][jj] = s[ct][kt][jj] > -1.0e29f ? __builtin_amdgcn_exp2f(s[ct][kt][jj] - m[ct]) * il[ct] : 0.f;
                        float s4 = (s[ct][kt][0] + s[ct][kt][1]) + (s[ct][kt][2] + s[ct][kt][3]), s3 = s[ct][kt][3];
                        s4 += __shfl_xor(s4, 1); s4 += __shfl_xor(s4, 2); s3 += __shfl_xor(s3, 1); s3 += __shfl_xor(s3, 2);
                        if (hh == 0) { LAS float* ip = IMP + (4 * ct + qi) * 132 + 16 * T + 4 * kt + fq;
                            __hip_atomic_fetch_add(ip, s4, __ATOMIC_RELAXED, __HIP_MEMORY_SCOPE_WORKGROUP);
                            __hip_atomic_fetch_add(ip + 1, s3, __ATOMIC_RELAXED, __HIP_MEMORY_SCOPE_WORKGROUP); }
                    }
                    af_pack(s[ct], pf[ct]); }
                af_pv(VT + (T & 1) * 18432, pf, o, true, true, fr, fq);
                if (T + 1 < ntc) AF_STORE((T + 1) & 1, true);
                __syncthreads();
            }
#pragma unroll
            for (int ct = 0; ct < 2; ++ct) { const size_t row = (size_t)b * SEQ + tq[ct];
                const float g0 = af_sigmoid((float)U[row * DINP + OFF_GL + (4 * g + hh) * 3 + 0]);
                af_write(Y, row, colbase, o[ct], g0, false); }
            __syncthreads();
#pragma unroll 1
            for (int ql = 0; ql < 8; ++ql) {
                LAS float* rowp = IMP + ql * 132;
                float sc0, sc1;
                { const int j = lane; const bool valid = j <= qb, forced = (j == 0) || (j == qb) || (j == qb - 1); const float v = rowp[j]; sc0 = valid ? v + (forced ? 1.0e4f : 0.f) : -1.f; rowp[j] = sc0; }
                { const int j = lane + 64; const bool valid = j <= qb, forced = (j == 0) || (j == qb) || (j == qb - 1); const float v = rowp[j]; sc1 = valid ? v + (forced ? 1.0e4f : 0.f) : -1.f; rowp[j] = sc1; }
                int r0 = 0, r1 = 0;
                for (int j = 0; j <= qb; ++j) { const float v = rowp[j];
                    r0 += (v > sc0 || (v == sc0 && j < lane)) ? 1 : 0; r1 += (v > sc1 || (v == sc1 && j < lane + 64)) ? 1 : 0; }
                const unsigned long long blo = __ballot(r0 < 16 && lane <= qb), bhi = __ballot(r1 < 16 && lane + 64 <= qb);
                if (lane == 0) { LAS unsigned* sp = SELM + (8 * w + ql) * 4; sp[0] = (unsigned)blo; sp[1] = (unsigned)(blo >> 32); sp[2] = (unsigned)bhi; sp[3] = (unsigned)(bhi >> 32); }
            }
            __syncthreads();
#pragma unroll 1
            for (int br = 1; br < 3; ++br) {
                const h16* KB = Ub + (br == 1 ? OFF_KS : OFF_KW) + g * 128;
                const h16* VB = Ub + (br == 1 ? OFF_VS : OFF_VW) + g * 128;
                const int j_lo = br == 1 ? 0 : (qb >= 8 ? qb - 8 : 0);
                m[0] = m[1] = -1.0e30f; l[0] = l[1] = 0.f;
#pragma unroll
                for (int ct = 0; ct < 2; ++ct)
#pragma unroll
                    for (int dt = 0; dt < 8; ++dt) o[ct][dt] = (f32x4){0.f, 0.f, 0.f, 0.f};
                AF_LOAD(KB, VB, DINP, 64 * j_lo, true); AF_STORE(0, true); __syncthreads();
#pragma unroll 1
                for (int j = j_lo; j <= qb; ++j) {
                    const int bufi = (j - j_lo) & 1;
                    if (j + 1 <= qb) AF_LOAD(KB, VB, DINP, 64 * (j + 1), true);
                    int hi[2], lo[2]; bool act[2];
#pragma unroll
                    for (int ct = 0; ct < 2; ++ct) {
                        if (br == 1) { const unsigned wd = SELM[(8 * w + 4 * ct + qi) * 4 + (j >> 5)]; const bool bit = (wd >> (j & 31)) & 1u;
                            act[ct] = __ballot(bit) != 0ull; hi[ct] = bit ? tq[ct] : -1; lo[ct] = NEGBIG; }
                        else { act[ct] = true; hi[ct] = tq[ct]; lo[ct] = tq[ct] - 512; }
                    }
                    if (act[0] || act[1]) {
                        af_qk(KT + bufi * 17408, qf, s, act[0], act[1], fr, fq);
                        half8 pf[2][2];
#pragma unroll
                        for (int ct = 0; ct < 2; ++ct) {
                            if (act[ct]) { af_maskz(s[ct], 64 * j, 1, fq, hi[ct], lo[ct], SC); af_online(s[ct], m[ct], l[ct], o[ct], pf[ct]); }
                            else { pf[ct][0] = qf[ct][0]; pf[ct][1] = qf[ct][0]; }
                        }
                        af_pv(VT + bufi * 18432, pf, o, act[0], act[1], fr, fq);
                    }
                    if (j + 1 <= qb) AF_STORE(bufi ^ 1, true);
                    __syncthreads();
                }
#pragma unroll
                for (int ct = 0; ct < 2; ++ct) { const size_t row = (size_t)b * SEQ + tq[ct];
                    float lt = l[ct]; lt += __shfl_xor(lt, 16); lt += __shfl_xor(lt, 32);
                    const float gg = af_sigmoid((float)U[row * DINP + OFF_GL + (4 * g + hh) * 3 + br]);
                    af_write(Y, row, colbase, o[ct], lt > 0.f ? gg / lt : 0.f, true); }
            }
        }
      }
    }
}

__device__ __forceinline__ void attn_norm_rows(const Ptrs& P, int G, int bid) {
    const int lane = threadIdx.x & 63, wave = threadIdx.x >> 6;
    const float* Y = (const float*)(P.ws + WS_YACC); h16* MIX = (h16*)(P.ws + WS_H); const float* gw = P.in[15];
    for (int r = bid * 8 + wave; r < NT; r += G * 8) {
        f32x4 v[4]; float ss = 0.f;
#pragma unroll
        for (int i = 0; i < 4; ++i) { v[i] = *(const f32x4*)(Y + (size_t)r * 1024 + 4 * (lane + 64 * i)); ss += v[i][0] * v[i][0] + v[i][1] * v[i][1] + v[i][2] * v[i][2] + v[i][3] * v[i][3]; }
        ss = wave_sum(ss); const float rstd = rsqrtf(ss * (1.f / 1024.f) + EPS);
#pragma unroll
        for (int i = 0; i < 4; ++i) { const int c = 4 * (lane + 64 * i); const f32x4 g = *(const f32x4*)(gw + c); const f32x4 o = v[i] * rstd * g;
            u32x2 w; w.x = pg8::pk_h2(o[0], o[1]); w.y = pg8::pk_h2(o[2], o[3]);
            *(u32x2*)(MIX + (size_t)r * DM + 1024 + c) = w; }
    }
}

constexpr int NPHASE = 12;
struct Args { Ptrs p; int ph_lo, ph_hi; };

__global__ void __launch_bounds__(NTHR, 2) mega(Args args) {
    extern __shared__ __attribute__((aligned(16))) unsigned char lds_raw[];
    LAS unsigned char* lds = (LAS unsigned char*)lds_raw;
    const Ptrs& P = args.p;
    const int G = gridDim.x, bid = blockIdx.x;
    unsigned char* ws = P.ws;
    const float* mod = (const float*)(ws + WS_MOD);
    const int lo = args.ph_lo, hi = args.ph_hi;
#define PHASE_BEGIN(n) if (lo <= (n) && (n) < hi) {
#define PHASE_END(n) if ((n) + 1 < hi) { cg::this_grid().sync(); } }
    PHASE_BEGIN(0) p0_prologue(P, lds, G, bid); PHASE_END(0)
    PHASE_BEGIN(1) norm_mod_rows(P.in[0], P.in[4], mod, 0, 2048, (h16*)(ws + WS_H), G, bid); PHASE_END(1)
    PHASE_BEGIN(2) { pg8::Gemm g{(const h16*)(ws + WS_H), (const h16*)(ws + WS_WIN), NT, DINP, DM}; pg8::StaticOrder S; S.init(NT, DINP, G, bid);
                  pg8::EpiF16<0> E{(h16*)(ws + WS_U), DINP}; pg8::gemm_phase(lds, g, S, E); } PHASE_END(2)
    PHASE_BEGIN(3) post_u_rows(P, G, bid); PHASE_END(3)
    PHASE_BEGIN(4) compress_phase(P, lds, G, bid); PHASE_END(4)
#if FAST_ATTN
    PHASE_BEGIN(5) attn_fast(P, lds, G, bid); PHASE_END(5)
#else
    PHASE_BEGIN(5) PHASE_END(5)
#endif
    PHASE_BEGIN(6) attn_norm_rows(P, G, bid); PHASE_END(6)
    PHASE_BEGIN(7) { pg8::Gemm g{(const h16*)(ws + WS_H), (const h16*)(ws + WS_WOUT), NT, DM, DM}; pg8::StaticOrder S; S.init(NT, DM, G, bid);
                  pg8::EpiRes E{P.in[0], P.out, mod + 2 * 2048, 12288}; pg8::gemm_phase(lds, g, S, E); } PHASE_END(7)
    PHASE_BEGIN(8) norm_mod_rows(P.out, P.in[17], mod, 3 * 2048, 4 * 2048, (h16*)(ws + WS_H), G, bid); PHASE_END(8)
    PHASE_BEGIN(9) { pg8::Gemm g{(const h16*)(ws + WS_H), (const h16*)(ws + WS_W1), NT, DFF, DM}; pg8::StaticOrder S; S.init(NT, DFF, G, bid);
                  pg8::EpiF16<1> E{(h16*)(ws + WS_HID), DFF}; pg8::gemm_phase(lds, g, S, E); } PHASE_END(9)
    PHASE_BEGIN(10) { pg8::Gemm g{(const h16*)(ws + WS_HID), (const h16*)(ws + WS_W2), NT, DM, DFF}; pg8::StaticOrder S; S.init(NT, DM, G, bid);
                   pg8::EpiRes E{P.out, P.out, mod + 5 * 2048, 12288}; pg8::gemm_phase(lds, g, S, E); } PHASE_END(10)
    PHASE_BEGIN(11) final_norm_rows(P.out, P.in[20], G, bid); PHASE_END(11)
}

__global__ void __launch_bounds__(NTHR, 2) attn_simple_kernel(Args args) {
    extern __shared__ __attribute__((aligned(16))) unsigned char lds_raw[];
    attn_simple(args.p, (LAS unsigned char*)lds_raw, gridDim.x, blockIdx.x);
}

extern "C" void kernel_launch(void* const* d_in, const int* in_sizes, int n_in, void* d_out, int out_size, void* d_ws, size_t ws_size, hipStream_t stream) {
    static int grid = 0;
    if (grid == 0) {
        if (n_in != 21 || out_size != NT * DM || ws_size < WS_END) { fprintf(stderr, "kernel_launch: unexpected shapes (n_in %d out %d ws %zu need %zu)\n", n_in, out_size, ws_size, (size_t)WS_END); grid = -1; return; }
        int dev = 0, cus = 0, per_cu = 0;
        hipGetDevice(&dev); hipDeviceGetAttribute(&cus, hipDeviceAttributeMultiprocessorCount, dev);
        if (hipFuncSetAttribute((const void*)mega, hipFuncAttributeMaxDynamicSharedMemorySize, LDS_BYTES) != hipSuccess) { fprintf(stderr, "kernel_launch: hipFuncSetAttribute failed\n"); grid = -1; return; }
        if (hipOccupancyMaxActiveBlocksPerMultiprocessor(&per_cu, (const void*)mega, NTHR, LDS_BYTES) != hipSuccess || per_cu < 1) { fprintf(stderr, "kernel_launch: occupancy query says %d\n", per_cu); per_cu = 1; }
        (void)hipGetLastError();
        grid = cus * 1;
        fprintf(stderr, "kernel_launch: cus %d per_cu %d grid %d\n", cus, per_cu, grid);
    }
    if (grid < 0) return;
    Args a{};
    for (int i = 0; i < 21; ++i) a.p.in[i] = (const float*)d_in[i];
    a.p.out = (float*)d_out; a.p.ws = (unsigned char*)d_ws;
#if ONE_LAUNCH == 1
    a.ph_lo = 0; a.ph_hi = NPHASE;
    void* kargs[] = {&a};
    hipError_t e = hipLaunchCooperativeKernel((const void*)mega, dim3(grid), dim3(NTHR), kargs, LDS_BYTES, stream);
    if (e != hipSuccess) fprintf(stderr, "cooperative launch failed: %s (grid %d)\n", hipGetErrorString(e), grid);
#elif ONE_LAUNCH == 3
    {
        void* kargs[] = {&a};
        a.ph_lo = 0; a.ph_hi = 5;
        hipError_t e = hipLaunchCooperativeKernel((const void*)mega, dim3(grid), dim3(NTHR), kargs, LDS_BYTES, stream);
        if (e != hipSuccess) fprintf(stderr, "cooperative launch A failed: %s (grid %d)\n", hipGetErrorString(e), grid);
        hipLaunchKernelGGL(attn_simple_kernel, dim3(grid * 4), dim3(NTHR), 48 * 1024, stream, a);
        a.ph_lo = 6; a.ph_hi = NPHASE;
        e = hipLaunchCooperativeKernel((const void*)mega, dim3(grid), dim3(NTHR), kargs, LDS_BYTES, stream);
        if (e != hipSuccess) fprintf(stderr, "cooperative launch B failed: %s (grid %d)\n", hipGetErrorString(e), grid);
    }
#else
    for (int ph = 0; ph < NPHASE; ++ph) {
        a.ph_lo = ph; a.ph_hi = ph + 1;
        if (ph == 5) hipLaunchKernelGGL(attn_simple_kernel, dim3(grid * 4), dim3(NTHR), 48 * 1024, stream, a);
        else hipLaunchKernelGGL(mega, dim3(grid), dim3(NTHR), LDS_BYTES, stream, a);
    }
#endif
}
```

```cpp
#include <hip/hip_runtime.h>
#include <hip/hip_cooperative_groups.h>
#include <cstdint>
#include <cstdio>
namespace cg = cooperative_groups;

#ifndef ONE_LAUNCH
#define ONE_LAUNCH 1
#endif
#ifndef FAST_ATTN
#define FAST_ATTN 1
#endif

#define LAS __attribute__((address_space(3)))
typedef _Float16 h16;
typedef _Float16 half8 __attribute__((ext_vector_type(8)));
typedef _Float16 half4 __attribute__((ext_vector_type(4)));
typedef _Float16 half2v __attribute__((ext_vector_type(2)));
typedef float f32x4 __attribute__((ext_vector_type(4)));
typedef float f32x2 __attribute__((ext_vector_type(2)));
typedef unsigned u32x4 __attribute__((ext_vector_type(4)));
typedef unsigned u32x2 __attribute__((ext_vector_type(2)));

constexpr int NB = 4, SEQ = 8192, NT = NB * SEQ, DM = 2048, DIN = 5656, DINP = 5888, DFF = 8192;
constexpr int OFF_UB = 0, OFF_UC = 1024, OFF_UH = 2048, OFF_Q = 3072, OFF_KC = 4096, OFF_VC = 4352, OFF_KS = 4608, OFF_VS = 4864,
              OFF_KW = 5120, OFF_VW = 5376, OFF_GL = 5632;
constexpr float EPS = 1e-6f;
constexpr int NTHR = 512;
constexpr int LDS_BYTES = 136 * 1024;

constexpr size_t WS_BAR   = 0;
constexpr size_t WS_BAR_BYTES = 16384;
constexpr size_t WS_MOD   = 16384;
constexpr size_t WS_B1P   = WS_MOD + (size_t)4 * 12288 * 4;
constexpr size_t WS_WIN   = WS_B1P + (size_t)2 * 32 * 256 * 4;
constexpr size_t WS_WOUT  = WS_WIN + (size_t)DINP * DM * 2;
constexpr size_t WS_W1    = WS_WOUT + (size_t)DM * DM * 2;
constexpr size_t WS_W2    = WS_W1 + (size_t)DFF * DM * 2;
constexpr size_t WS_CW1K  = WS_W2 + (size_t)DFF * DM * 2;
constexpr size_t WS_CW1V  = WS_CW1K + (size_t)256 * 4096 * 2;
constexpr size_t WS_CW2K  = WS_CW1V + (size_t)256 * 4096 * 2;
constexpr size_t WS_CW2V  = WS_CW2K + (size_t)128 * 256 * 2;
constexpr size_t WS_KCMP  = WS_CW2V + (size_t)128 * 256 * 2;
constexpr size_t WS_VCMP  = WS_KCMP + (size_t)8 * 512 * 128 * 2;
constexpr size_t WS_H     = WS_VCMP + (size_t)8 * 512 * 128 * 2;
constexpr size_t WS_BIG   = WS_H + (size_t)NT * DM * 2;
constexpr size_t WS_U     = WS_BIG;
constexpr size_t WS_YACC  = WS_U + (size_t)NT * DINP * 2;
constexpr size_t WS_HID   = WS_BIG;
constexpr size_t WS_END   = WS_BIG + (size_t)NT * DFF * 2;
static_assert(WS_YACC + (size_t)NT * 1024 * 4 <= WS_END, "ws map");
static_assert(WS_END <= (size_t)1073741824, "ws map fits 4x largest tensor");
static_assert(WS_WIN % 256 == 0 && WS_H % 256 == 0 && WS_BIG % 256 == 0 && WS_YACC % 256 == 0, "alignment");

namespace pg8 {
constexpr int BM = 256, BK = 64, HALF = 128, HTB = HALF * BK * 2, STAGE_BYTES = 8 * HTB, NXCD = 8, WGM = 8;
__host__ __device__ __forceinline__ int lds_byte(int r, int c) { const int st = (r >> 4) * 2 + (c >> 5), rr = r & 15, cc = c & 31, ob = rr * 64 + cc * 2; return st * 1024 + (ob ^ (((ob >> 9) & 1) << 5)); }
__host__ __device__ __forceinline__ void stage_rc(int b, int& R, int& C) { const int st = b / 1024, sb = b % 1024, swz = sb ^ (((sb >> 9) & 1) << 5); R = (st >> 1) * 16 + swz / 64; C = (st & 1) * 32 + (swz % 64) / 2; }
__host__ __device__ __forceinline__ int perm32(int rho) { const int n = rho >> 4, i = rho & 15; return 8 * (i >> 2) + 4 * n + (i & 3); }

struct Unit { int pm, pn; };
struct Gemm { const h16* A; const h16* Bt; int M, N, K; };

struct StaticOrder {
    int nM, nN, nwg, G, c;
    __host__ __device__ void init(int M, int N, int G_, int c_) { nM = M / BM; nN = N / BM; nwg = nM * nN; G = G_; c = c_; }
    __host__ __device__ bool next(int i, Unit& u) const {
        const long L = (long)i * G + c; if (L >= nwg) return false;
        int wgid = (int)L; { const int q = nwg / NXCD, r = nwg % NXCD, xcd = wgid % NXCD, off = wgid / NXCD; wgid = (xcd < r ? xcd * (q + 1) : r * (q + 1) + (xcd - r) * q) + off; }
        const int nig = WGM * nN, gid = wgid / nig, fm = gid * WGM, gsz = (nM - fm) < WGM ? (nM - fm) : WGM;
        u.pm = fm + ((wgid % nig) % gsz); u.pn = (wgid % nig) / gsz; return true;
    }
    __device__ __forceinline__ void a_ready(const Unit&) const {}
    __device__ __forceinline__ void done(const Unit&) const {}
};

__device__ __forceinline__ unsigned pk_h2(float lo, float hi) { half2v v; v.x = (h16)lo; v.y = (h16)hi; return __builtin_bit_cast(unsigned, v); }

template <int ACT> struct EpiF16 {
    static constexpr bool PERM = true, AFTER_DRAIN = false;
    h16* O; int ldc;
    __device__ __forceinline__ void operator()(const f32x4 (&acc)[2][2][4][2], const Unit& u, int wr, int wc, int fr, int fq) const {
        const int row0 = u.pm * BM + wr * 64 + fr; const int col0 = u.pn * BM + wc * 32 + 8 * fq;
#pragma unroll
        for (int ai = 0; ai < 2; ++ai)
#pragma unroll
            for (int m = 0; m < 4; ++m) { h16* rowp = O + (size_t)(row0 + ai * HALF + m * 16) * ldc + col0;
#pragma unroll
                for (int bj = 0; bj < 2; ++bj) { f32x4 v0 = acc[ai][bj][m][0], v1 = acc[ai][bj][m][1];
                    if (ACT == 1) {
#pragma unroll
                        for (int j = 0; j < 4; ++j) { const float a = fmaxf(v0[j], 0.f), b = fmaxf(v1[j], 0.f); v0[j] = a * a; v1[j] = b * b; } }
                    u32x4 w; w.x = pk_h2(v0[0], v0[1]); w.y = pk_h2(v0[2], v0[3]); w.z = pk_h2(v1[0], v1[1]); w.w = pk_h2(v1[2], v1[3]);
                    *(u32x4*)(rowp + bj * HALF) = w; } }
    }
};
struct EpiRes {
    static constexpr bool PERM = false, AFTER_DRAIN = false;
    const float* base; float* out; const float* gate; int gate_ld;
    __device__ __forceinline__ void operator()(const f32x4 (&acc)[2][2][4][2], const Unit& u, int wr, int wc, int fr, int fq) const {
        const int row0 = u.pm * BM + wr * 64 + fr, col0 = u.pn * BM + wc * 32 + 4 * fq; const int b = (u.pm * BM) / SEQ;
        f32x4 gv[2][2];
#pragma unroll
        for (int bj = 0; bj < 2; ++bj)
#pragma unroll
            for (int n = 0; n < 2; ++n) gv[bj][n] = *(const f32x4*)(gate + (size_t)b * gate_ld + col0 + bj * HALF + n * 16);
#pragma unroll
        for (int ai = 0; ai < 2; ++ai)
#pragma unroll
            for (int m = 0; m < 4; ++m) { const size_t ro = (size_t)(row0 + ai * HALF + m * 16) * DM + col0;
#pragma unroll
                for (int bj = 0; bj < 2; ++bj)
#pragma unroll
                    for (int n = 0; n < 2; ++n) { const f32x4 bv = *(const f32x4*)(base + ro + bj * HALF + n * 16);
                        *(f32x4*)(out + ro + bj * HALF + n * 16) = bv + gv[bj][n] * acc[ai][bj][m][n]; } }
    }
};

template <class Epi, class Sched>
__device__ __forceinline__ void gemm_phase(LAS unsigned char* lds, const Gemm g, const Sched& S, const Epi& E) {
    const int tid = threadIdx.x, wid = __builtin_amdgcn_readfirstlane(tid >> 6), lane = tid & 63, wr = wid >> 2, wc = wid & 3, fr = lane & 15, fq = lane >> 4;
    const int K = g.K, nt = K / BK;
    unsigned voffA[2], voffB[2];
#pragma unroll
    for (int i = 0; i < 2; ++i) { int R, C; stage_rc(tid * 16 + i * 8192, R, C); const int Rb = Epi::PERM ? ((R & ~31) + perm32(R & 31)) : R;
        voffA[i] = (unsigned)(R * K + C) * 2u; voffB[i] = (unsigned)(Rb * K + C) * 2u; }
    const size_t kstep = (size_t)(BK * 2);
    const size_t hstep = (size_t)HALF * K * 2;
    const size_t tstep = 2 * hstep;
    const unsigned ldsw = (unsigned)wid * 1024u;
    const int aoff = lds_byte(wr * 64 + fr, fq * 8), boff = lds_byte(wc * 32 + fr, fq * 8);
#define PG8_SA(b, h) (((b) * 2 + (h)) * HTB)
#define PG8_SB(b, h) ((4 + (b) * 2 + (h)) * HTB)
#define PG8_STAGE(bufoff, gbase, voff) do { _Pragma("unroll") for (int _i = 0; _i < 2; ++_i) \
        __builtin_amdgcn_global_load_lds((const unsigned*)((const char*)(gbase) + (voff)[_i]), (LAS unsigned*)(lds + (bufoff) + ldsw + _i * 8192), 16, 0, 0); } while (0)
#define PG8_LDA(dst, b, h) do { _Pragma("unroll") for (int m = 0; m < 4; ++m) _Pragma("unroll") for (int k = 0; k < 2; ++k) dst[m][k] = *(const LAS half8*)(lds + PG8_SA(b, h) + aoff + m * 2048 + k * 1024); } while (0)
#define PG8_LDB(dst, b, h) do { _Pragma("unroll") for (int n = 0; n < 2; ++n) _Pragma("unroll") for (int k = 0; k < 2; ++k) dst[n][k] = *(const LAS half8*)(lds + PG8_SB(b, h) + boff + n * 2048 + k * 1024); } while (0)
#define PG8_MMA(ai, bj, At, Bt) do { __builtin_amdgcn_s_setprio(1); _Pragma("unroll") for (int m = 0; m < 4; ++m) _Pragma("unroll") for (int n = 0; n < 2; ++n) _Pragma("unroll") for (int k = 0; k < 2; ++k) \
        acc[ai][bj][m][n] = __builtin_amdgcn_mfma_f32_16x16x32_f16(Bt[n][k], At[m][k], acc[ai][bj][m][n], 0, 0, 0); __builtin_amdgcn_s_setprio(0); } while (0)
#define PG8_WAIT_V(n) asm volatile("s_waitcnt vmcnt(" #n ")" ::: "memory")
#define PG8_WAIT_L(n) asm volatile("s_waitcnt lgkmcnt(" #n ")" ::: "memory")
#define PG8_BAR __builtin_amdgcn_s_barrier()
#define PG8_SCHED __builtin_amdgcn_sched_barrier(0)
    Unit cur, nxt; int ui = 0;
    if (!S.next(0, cur)) return;
    f32x4 acc[2][2][4][2];
#pragma unroll
    for (int a = 0; a < 2; ++a)
#pragma unroll
        for (int b = 0; b < 2; ++b)
#pragma unroll
            for (int m = 0; m < 4; ++m)
#pragma unroll
                for (int n = 0; n < 2; ++n) acc[a][b][m][n] = (f32x4){0.f, 0.f, 0.f, 0.f};
    half8 At[4][2], B0[2][2], B1[2][2];
    const char* cA = (const char*)g.A + (size_t)cur.pm * tstep; const char* cB = (const char*)g.Bt + (size_t)cur.pn * tstep;
    S.a_ready(cur);
    PG8_STAGE(PG8_SB(0, 0), cB, voffB); PG8_STAGE(PG8_SA(0, 0), cA, voffA); PG8_STAGE(PG8_SB(0, 1), cB + hstep, voffB); PG8_STAGE(PG8_SA(0, 1), cA + hstep, voffA);
    if (wr == 1) PG8_BAR;
    PG8_WAIT_V(4); PG8_BAR;
    PG8_STAGE(PG8_SB(1, 0), cB + kstep, voffB); PG8_STAGE(PG8_SA(1, 0), cA + kstep, voffA); PG8_STAGE(PG8_SB(1, 1), cB + hstep + kstep, voffB);
    PG8_WAIT_V(6); PG8_BAR;
    for (;;) {
        const bool has_next = S.next(ui + 1, nxt);
        const char* nA = has_next ? (const char*)g.A + (size_t)nxt.pm * tstep : cA; const char* nB = has_next ? (const char*)g.Bt + (size_t)nxt.pn * tstep : cB;
        for (int t = 0; t < nt; t += 2) {
            const bool last = (t == nt - 2);
            const char* a1 = cA + (size_t)(t + 1) * kstep;
            const char* a2 = last ? nA : cA + (size_t)(t + 2) * kstep; const char* b2 = last ? nB : cB + (size_t)(t + 2) * kstep;
            const char* a3 = a2 + kstep; const char* b3 = b2 + kstep;
            if (last && has_next) S.a_ready(nxt);
            PG8_LDB(B0, 0, 0); PG8_SCHED; PG8_LDA(At, 0, 0); PG8_STAGE(PG8_SA(1, 1), a1 + hstep, voffA);
            PG8_WAIT_L(8); PG8_BAR; PG8_WAIT_L(0); PG8_MMA(0, 0, At, B0); PG8_BAR; PG8_SCHED;
            PG8_LDB(B1, 0, 1); PG8_STAGE(PG8_SB(0, 0), b2, voffB);
            PG8_BAR; PG8_WAIT_L(0); PG8_MMA(0, 1, At, B1); PG8_BAR;
            PG8_LDA(At, 0, 1); PG8_STAGE(PG8_SA(0, 0), a2, voffA);
            PG8_BAR; PG8_WAIT_L(0); PG8_MMA(1, 0, At, B0); PG8_BAR; PG8_SCHED;
            PG8_STAGE(PG8_SB(0, 1), b2 + hstep, voffB);
            PG8_WAIT_V(6); PG8_BAR; PG8_MMA(1, 1, At, B1); PG8_BAR;
            PG8_LDB(B0, 1, 0); PG8_SCHED; PG8_LDA(At, 1, 0); PG8_STAGE(PG8_SA(0, 1), a2 + hstep, voffA);
            PG8_WAIT_L(8); PG8_BAR; PG8_WAIT_L(0); PG8_MMA(0, 0, At, B0); PG8_BAR; PG8_SCHED;
            PG8_LDB(B1, 1, 1); PG8_STAGE(PG8_SB(1, 0), b3, voffB);
            PG8_BAR; PG8_WAIT_L(0); PG8_MMA(0, 1, At, B1); PG8_BAR;
            PG8_LDA(At, 1, 1); PG8_STAGE(PG8_SA(1, 0), a3, voffA);
            PG8_BAR; PG8_WAIT_L(0); PG8_MMA(1, 0, At, B0); PG8_BAR; PG8_SCHED;
            PG8_STAGE(PG8_SB(1, 1), b3 + hstep, voffB);
            PG8_WAIT_V(6); PG8_BAR; PG8_MMA(1, 1, At, B1); PG8_BAR;
        }
        E(acc, cur, wr, wc, fr, fq); S.done(cur);
        if (!has_next) break;
#pragma unroll
        for (int a = 0; a < 2; ++a)
#pragma unroll
            for (int b = 0; b < 2; ++b)
#pragma unroll
                for (int m = 0; m < 4; ++m)
#pragma unroll
                    for (int n = 0; n < 2; ++n) acc[a][b][m][n] = (f32x4){0.f, 0.f, 0.f, 0.f};
        cur = nxt; cA = nA; cB = nB; ++ui;
    }
    PG8_WAIT_V(0);
    if (wr == 0) PG8_BAR;
    PG8_BAR;
#undef PG8_SA
#undef PG8_SB
#undef PG8_STAGE
#undef PG8_LDA
#undef PG8_LDB
#undef PG8_MMA
#undef PG8_WAIT_V
#undef PG8_WAIT_L
#undef PG8_BAR
#undef PG8_SCHED
}
}

__device__ __forceinline__ float wave_sum(float v) {
#pragma unroll
    for (int o = 1; o < 64; o <<= 1) v += __shfl_xor(v, o);
    return v;
}
__device__ __forceinline__ float wave_max(float v) {
#pragma unroll
    for (int o = 1; o < 64; o <<= 1) v = fmaxf(v, __shfl_xor(v, o));
    return v;
}
__device__ __forceinline__ float bcast_lane(float v, int j) { return __builtin_bit_cast(float, __builtin_amdgcn_readlane(__builtin_bit_cast(int, v), j)); }

struct Ptrs {
    const float* in[21]; float* out; unsigned char* ws;
};

constexpr int P0_ADA = 192, P0_B1 = 64;
constexpr int P0_TWIN = 32 * 23, P0_TWOUT = 32 * 8, P0_TW1 = 32 * 32, P0_TW2 = 128 * 8, P0_TC1 = 64 * 1, P0_TC2 = 4 * 1;
constexpr int P0_OFF_B1 = P0_ADA, P0_OFF_TWIN = P0_OFF_B1 + P0_B1, P0_OFF_TWOUT = P0_OFF_TWIN + P0_TWIN, P0_OFF_TW1 = P0_OFF_TWOUT + P0_TWOUT,
              P0_OFF_TW2 = P0_OFF_TW1 + P0_TW1, P0_OFF_TC1K = P0_OFF_TW2 + P0_TW2, P0_OFF_TC1V = P0_OFF_TC1K + P0_TC1, P0_OFF_TC2K = P0_OFF_TC1V + P0_TC1,
              P0_OFF_TC2V = P0_OFF_TC2K + P0_TC2, P0_ITEMS = P0_OFF_TC2V + P0_TC2;

__device__ __forceinline__ void transpose_tile(const float* __restrict__ W, int K, int N, int Nout, h16* __restrict__ Wt, int item, LAS float* scr, int tid) {
    const int nkt = K / 64; const int kt = item % nkt, ntl = item / nkt;
    { const int c4 = tid & 63, r = tid >> 6; f32x4 v[8];
#pragma unroll
      for (int i = 0; i < 8; ++i) { const int k = kt * 64 + r + 8 * i, n = ntl * 256 + 4 * c4;
          v[i] = (f32x4){0.f, 0.f, 0.f, 0.f}; if (n < N) v[i] = *(const f32x4*)(W + (size_t)k * N + n); }
#pragma unroll
      for (int i = 0; i < 8; ++i) *(LAS f32x4*)(scr + (r + 8 * i) * 260 + 4 * c4) = v[i]; }
    __syncthreads();
    { const int n = tid >> 1, hf = tid & 1;
      if (ntl * 256 + n < Nout) {
#pragma unroll
          for (int q = 0; q < 4; ++q) { half8 o;
#pragma unroll
              for (int j = 0; j < 8; ++j) o[j] = (h16)scr[(32 * hf + 8 * q + j) * 260 + n];
              *(half8*)(Wt + (size_t)(ntl * 256 + n) * K + kt * 64 + 32 * hf + 8 * q) = o; } } }
    __syncthreads();
}

__device__ __forceinline__ void p0_prologue(const Ptrs& P, LAS unsigned char* lds, int G, int bid) {
    const int tid = threadIdx.x;
    LAS float* scr = (LAS float*)lds;
    unsigned char* ws = P.ws;
    for (int it = bid; it < P0_ITEMS; it += G) {
        if (it < P0_ADA) {
            LAS float* sc = scr;
            LAS float* red = scr + 8192;
            const float* c = P.in[1];
            for (int i = tid; i < 8192; i += NTHR) { const float v = c[i]; sc[i] = v / (1.f + __expf(-v)); }
            __syncthreads();
            const int cl = tid & 15, kg = tid >> 4;
            f32x4 a0 = {0, 0, 0, 0}, a1 = a0, a2 = a0, a3 = a0;
            const float* W = P.in[2] + 64 * it + 4 * cl;
#pragma unroll 4
            for (int k = kg; k < 2048; k += 32) { const f32x4 w = *(const f32x4*)(W + (size_t)k * 12288);
                a0 += sc[k] * w; a1 += sc[2048 + k] * w; a2 += sc[4096 + k] * w; a3 += sc[6144 + k] * w; }
#pragma unroll
            for (int j = 0; j < 4; ++j) { red[(kg * 4 + 0) * 64 + 4 * cl + j] = a0[j]; red[(kg * 4 + 1) * 64 + 4 * cl + j] = a1[j];
                red[(kg * 4 + 2) * 64 + 4 * cl + j] = a2[j]; red[(kg * 4 + 3) * 64 + 4 * cl + j] = a3[j]; }
            __syncthreads();
            if (tid < 256) { const int b = tid >> 6, col = tid & 63; float s = 0.f;
                for (int q = 0; q < 32; ++q) s += red[(q * 4 + b) * 64 + col];
                ((float*)(ws + WS_MOD))[b * 12288 + 64 * it + col] = s + P.in[3][64 * it + col]; }
            __syncthreads();
        } else if (it < P0_OFF_TWIN) {
            const int q = it - P0_OFF_B1, kv = q >> 5, part = q & 31;
            const float* pe = P.in[8 + kv]; const float* W1 = P.in[kv ? 12 : 10];
            const int col = tid & 255, kh = tid >> 8; float s = 0.f;
            for (int k = 128 * part + 64 * kh; k < 128 * part + 64 * kh + 64; ++k) s += pe[k] * W1[(size_t)k * 256 + col];
            scr[tid] = s; __syncthreads();
            if (tid < 256) ((float*)(ws + WS_B1P))[(kv * 32 + part) * 256 + tid] = scr[tid] + scr[tid + 256];
            __syncthreads();
        } else if (it < P0_OFF_TWOUT) transpose_tile(P.in[5], DM, DIN, DINP, (h16*)(ws + WS_WIN), it - P0_OFF_TWIN, scr, tid);
        else if (it < P0_OFF_TW1)     transpose_tile(P.in[16], DM, DM, DM, (h16*)(ws + WS_WOUT), it - P0_OFF_TWOUT, scr, tid);
        else if (it < P0_OFF_TW2)     transpose_tile(P.in[18], DM, DFF, DFF, (h16*)(ws + WS_W1), it - P0_OFF_TW1, scr, tid);
        else if (it < P0_OFF_TC1K)    transpose_tile(P.in[19], DFF, DM, DM, (h16*)(ws + WS_W2), it - P0_OFF_TW2, scr, tid);
        else if (it < P0_OFF_TC1V)    transpose_tile(P.in[10], 4096, 256, 256, (h16*)(ws + WS_CW1K), it - P0_OFF_TC1K, scr, tid);
        else if (it < P0_OFF_TC2K)    transpose_tile(P.in[12], 4096, 256, 256, (h16*)(ws + WS_CW1V), it - P0_OFF_TC1V, scr, tid);
        else if (it < P0_OFF_TC2V)    transpose_tile(P.in[11], 256, 128, 128, (h16*)(ws + WS_CW2K), it - P0_OFF_TC2K, scr, tid);
        else                          transpose_tile(P.in[13], 256, 128, 128, (h16*)(ws + WS_CW2V), it - P0_OFF_TC2V, scr, tid);
    }
}

__device__ __forceinline__ void norm_mod_rows(const float* __restrict__ X, const float* __restrict__ gw, const float* __restrict__ mod, int sh_off, int sc_off,
                                              h16* __restrict__ H, int G, int bid) {
    const int lane = threadIdx.x & 63, wave = threadIdx.x >> 6;
    for (int r = bid * 8 + wave; r < NT; r += G * 8) {
        const int b = r >> 13; const float* xr = X + (size_t)r * DM; f32x4 v[8]; float ss = 0.f;
#pragma unroll
        for (int i = 0; i < 8; ++i) { v[i] = *(const f32x4*)(xr + 4 * (lane + 64 * i)); ss += v[i][0] * v[i][0] + v[i][1] * v[i][1] + v[i][2] * v[i][2] + v[i][3] * v[i][3]; }
        ss = wave_sum(ss); const float rstd = rsqrtf(ss * (1.f / DM) + EPS);
        const float* mb = mod + (size_t)b * 12288;
#pragma unroll
        for (int i = 0; i < 8; ++i) { const int c = 4 * (lane + 64 * i);
            const f32x4 g = *(const f32x4*)(gw + c), sh = *(const f32x4*)(mb + sh_off + c), sc = *(const f32x4*)(mb + sc_off + c);
            const f32x4 o = (v[i] * rstd) * g * (1.f + sc) + sh;
            u32x2 w; w.x = pg8::pk_h2(o[0], o[1]); w.y = pg8::pk_h2(o[2], o[3]);
            *(u32x2*)(H + (size_t)r * DM + c) = w; }
    }
}
__device__ __forceinline__ void final_norm_rows(float* __restrict__ X, const float* __restrict__ gw, int G, int bid) {
    const int lane = threadIdx.x & 63, wave = threadIdx.x >> 6;
    for (int r = bid * 8 + wave; r < NT; r += G * 8) {
        float* xr = X + (size_t)r * DM; f32x4 v[8]; float ss = 0.f;
#pragma unroll
        for (int i = 0; i < 8; ++i) { v[i] = *(const f32x4*)(xr + 4 * (lane + 64 * i)); ss += v[i][0] * v[i][0] + v[i][1] * v[i][1] + v[i][2] * v[i][2] + v[i][3] * v[i][3]; }
        ss = wave_sum(ss); const float rstd = rsqrtf(ss * (1.f / DM) + EPS);
#pragma unroll
        for (int i = 0; i < 8; ++i) { const int c = 4 * (lane + 64 * i); const f32x4 g = *(const f32x4*)(gw + c); *(f32x4*)(xr + c) = (v[i] * rstd) * g; }
    }
}

__device__ __forceinline__ void post_u_rows(const Ptrs& P, int G, int bid) {
    const int lane = threadIdx.x & 63, wave = threadIdx.x >> 6;
    h16* U = (h16*)(P.ws + WS_U); h16* MIX = (h16*)(P.ws + WS_H);
    const float* cw = P.in[6]; const float* cb = P.in[7]; const float* gcv = P.in[14];
    const int hsel = lane >> 3, c8 = lane & 7;
    float inv[8];
#pragma unroll
    for (int e = 0; e < 8; ++e) inv[e] = (float)exp2(-(double)(8 * c8 + e) * (13.287712379549449 / 64.0));
    for (int r = bid * 8 + wave; r < NT; r += G * 8) {
        const int pos = r & (SEQ - 1); h16* u = U + (size_t)r * DINP;
        float cs[8], sn[8];
#pragma unroll
        for (int e = 0; e < 8; ++e) { const float ang = (float)pos * inv[e];
            double rev = (double)ang * 0.15915494309189535; rev -= __builtin_rint(rev);
            const float rf = (float)rev; cs[e] = __builtin_amdgcn_cosf(rf); sn[e] = __builtin_amdgcn_sinf(rf); }
#pragma unroll
        for (int rd = 0; rd < 2; ++rd) {
            const int base = rd == 0 ? OFF_Q + 128 * hsel : (hsel < 2 ? OFF_KC + 128 * hsel : (hsel < 4 ? OFF_KS + 128 * (hsel - 2) : OFF_KW + 128 * (hsel - 4)));
            if (rd == 0 || hsel < 6) {
                const half8 x1 = *(const half8*)(u + base + 8 * c8), x2 = *(const half8*)(u + base + 64 + 8 * c8); half8 o1, o2;
#pragma unroll
                for (int e = 0; e < 8; ++e) { const float a = (float)x1[e], bq = (float)x2[e]; o1[e] = (h16)(a * cs[e] - bq * sn[e]); o2[e] = (h16)(bq * cs[e] + a * sn[e]); }
                *(half8*)(u + base + 8 * c8) = o1; *(half8*)(u + base + 64 + 8 * c8) = o2; }
        }
        float y[16]; float ss = 0.f;
#pragma unroll
        for (int hf = 0; hf < 2; ++hf) {
            const int ch = 512 * hf + 8 * lane;
            const half8 ub = *(const half8*)(u + OFF_UB + ch), c0 = *(const half8*)(u + OFF_UC + ch), h0 = *(const half8*)(u + OFF_UH + ch);
            half8 c1 = c0 * (h16)0, h1 = c1, c2 = c1, h2 = c1;
            if (pos >= 1) { c1 = *(const half8*)(u - DINP + OFF_UC + ch); h1 = *(const half8*)(u - DINP + OFF_UH + ch); }
            if (pos >= 2) { c2 = *(const half8*)(u - 2 * DINP + OFF_UC + ch); h2 = *(const half8*)(u - 2 * DINP + OFF_UH + ch); }
#pragma unroll
            for (int j = 0; j < 8; ++j) {
                const float v0 = (float)c0[j] * (float)h0[j], v1 = (float)c1[j] * (float)h1[j], v2 = (float)c2[j] * (float)h2[j];
                const float z = cb[ch + j] + cw[ch + j] * v2 + cw[1024 + ch + j] * v1 + cw[2048 + ch + j] * v0;
                const float yy = (float)ub[j] * z; y[8 * hf + j] = yy; ss += yy * yy; }
        }
        ss = wave_sum(ss); const float rstd = rsqrtf(ss * (1.f / 1024.f) + EPS);
#pragma unroll
        for (int hf = 0; hf < 2; ++hf) { const int ch = 512 * hf + 8 * lane; half8 o;
#pragma unroll
            for (int j = 0; j < 8; ++j) o[j] = (h16)(y[8 * hf + j] * rstd * gcv[ch + j]);
            *(half8*)(MIX + (size_t)r * DM + ch) = o; }
    }
}

__device__ __forceinline__ float gelu_tanh(float x) {
    const float z = 0.7978845608028654f * (x + 0.044715f * x * x * x);
    const float e = __expf(2.f * z);
    const float th = 1.f - 2.f / (e + 1.f);
    return 0.5f * x * (1.f + th);
}
__device__ __forceinline__ void compress_phase(const Ptrs& P, LAS unsigned char* lds, int G, int bid) {
    const int tid = threadIdx.x, lane = tid & 63, w = tid >> 6, fr = lane & 15, fq = lane >> 4;
    const h16* U = (const h16*)(P.ws + WS_U);
    LAS h16* hid = (LAS h16*)lds;
    for (int unit = bid; unit < 256; unit += G) {
        const int kv = unit >> 7, bg = (unit >> 4) & 7, nb = unit & 15, b = bg >> 1, g = bg & 1, n0 = nb * 32;
        const h16* W1t = (const h16*)(P.ws + (kv ? WS_CW1V : WS_CW1K));
        const h16* W2t = (const h16*)(P.ws + (kv ? WS_CW2V : WS_CW2K));
        const float* b1p = (const float*)(P.ws + WS_B1P) + kv * 32 * 256;
        h16* OUT = (h16*)(P.ws + (kv ? WS_VCMP : WS_KCMP)) + (size_t)bg * 512 * 128;
        const int coff = (kv ? OFF_VC : OFF_KC) + g * 128;
        f32x4 acc[2][2];
#pragma unroll
        for (int i = 0; i < 2; ++i)
#pragma unroll
            for (int j = 0; j < 2; ++j) acc[i][j] = (f32x4){0.f, 0.f, 0.f, 0.f};
        half8 fa[2][4][2], fb[2][4][2];
        half8 zero8;
#pragma unroll
        for (int j = 0; j < 8; ++j) zero8[j] = (h16)0.f;
        const h16* arow[2]; bool aok0[2];
#pragma unroll
        for (int mt = 0; mt < 2; ++mt) arow[mt] = U + (size_t)(b * SEQ + 16 * (n0 + 16 * mt + fr)) * DINP + coff + 8 * fq;
        const h16* brow[2];
#pragma unroll
        for (int nt = 0; nt < 2; ++nt) brow[nt] = W1t + (size_t)(32 * w + 16 * nt + fr) * 4096 + 8 * fq;
        (void)aok0;
#define CP_LOAD(buf_, pos_) do { _Pragma("unroll") for (int ks = 0; ks < 4; ++ks) { \
            _Pragma("unroll") for (int mt = 0; mt < 2; ++mt) { const int tok = 16 * (n0 + 16 * mt + fr) + (pos_); \
                fa[buf_][ks][mt] = tok < SEQ ? *(const half8*)(arow[mt] + (size_t)(pos_) * DINP + 32 * ks) : zero8; } \
            _Pragma("unroll") for (int nt = 0; nt < 2; ++nt) fb[buf_][ks][nt] = *(const half8*)(brow[nt] + (pos_) * 128 + 32 * ks); } } while (0)
#define CP_MMA(buf_) do { _Pragma("unroll") for (int ks = 0; ks < 4; ++ks) _Pragma("unroll") for (int mt = 0; mt < 2; ++mt) _Pragma("unroll") for (int nt = 0; nt < 2; ++nt) \
            acc[mt][nt] = __builtin_amdgcn_mfma_f32_16x16x32_f16(fa[buf_][ks][mt], fb[buf_][ks][nt], acc[mt][nt], 0, 0, 0); } while (0)
        CP_LOAD(0, 0);
#pragma unroll 1
        for (int pos = 0; pos < 32; pos += 2) {
            CP_LOAD(1, pos + 1);
            CP_MMA(0);
            if (pos + 2 < 32) CP_LOAD(0, pos + 2);
            CP_MMA(1);
        }
#undef CP_LOAD
#undef CP_MMA
#pragma unroll
        for (int nt = 0; nt < 2; ++nt) { const int col = 32 * w + 16 * nt + fr; float bias = 0.f;
            for (int q = 0; q < 32; ++q) bias += b1p[q * 256 + col];
#pragma unroll
            for (int mt = 0; mt < 2; ++mt)
#pragma unroll
                for (int j = 0; j < 4; ++j) hid[(16 * mt + 4 * fq + j) * 264 + col] = (h16)gelu_tanh(acc[mt][nt][j] + bias); }
        __syncthreads();
        f32x4 acc2[2]; acc2[0] = (f32x4){0.f, 0.f, 0.f, 0.f}; acc2[1] = acc2[0];
#pragma unroll
        for (int ks = 0; ks < 8; ++ks) {
            const half8 bb = *(const half8*)(W2t + (size_t)(16 * w + fr) * 256 + 32 * ks + 8 * fq);
#pragma unroll
            for (int mt = 0; mt < 2; ++mt) { const half8 a = *(const LAS half8*)(hid + (16 * mt + fr) * 264 + 32 * ks + 8 * fq);
                acc2[mt] = __builtin_amdgcn_mfma_f32_16x16x32_f16(a, bb, acc2[mt], 0, 0, 0); }
        }
#pragma unroll
        for (int mt = 0; mt < 2; ++mt)
#pragma unroll
            for (int j = 0; j < 4; ++j) OUT[(size_t)(n0 + 16 * mt + 4 * fq + j) * 128 + 16 * w + fr] = (h16)acc2[mt][j];
        __syncthreads();
    }
}

__device__ __forceinline__ void dot4(const h16* __restrict__ kp, const LAS float* qf, float (&s)[4]) {
    s[0] = s[1] = s[2] = s[3] = 0.f;
#pragma unroll 4
    for (int c = 0; c < 16; ++c) { const half8 kk = *(const half8*)(kp + 8 * c);
#pragma unroll
        for (int j = 0; j < 8; ++j) { const float kf = (float)kk[j];
            s[0] += qf[8 * c + j] * kf; s[1] += qf[128 + 8 * c + j] * kf; s[2] += qf[256 + 8 * c + j] * kf; s[3] += qf[384 + 8 * c + j] * kf; } }
}
__device__ __forceinline__ void attn_simple(const Ptrs& P, LAS unsigned char* lds, int G, int bid) {
    const int lane = threadIdx.x & 63, wave = threadIdx.x >> 6;
    const h16* U = (const h16*)(P.ws + WS_U); float* Y = (float*)(P.ws + WS_YACC);
    LAS float* qf = (LAS float*)lds + wave * 1280;
    LAS float* pbar = qf + 512;
    LAS float* impv = pbar + 512;
    const float scale = 0.08838834764831845f;
    for (int wu = bid * 8 + wave; wu < NB * 2 * SEQ; wu += G * 8) {
        const int b = wu >> 14, g = (wu >> 13) & 1, t = wu & (SEQ - 1);
        const size_t row = (size_t)b * SEQ + t; const h16* urow = U + row * DINP;
#pragma unroll
        for (int hh = 0; hh < 4; ++hh) { const half2v q2 = *(const half2v*)(urow + OFF_Q + (4 * g + hh) * 128 + 2 * lane); qf[hh * 128 + 2 * lane] = (float)q2.x; qf[hh * 128 + 2 * lane + 1] = (float)q2.y; }
        float gt[4][3];
#pragma unroll
        for (int hh = 0; hh < 4; ++hh)
#pragma unroll
            for (int br = 0; br < 3; ++br) { const float x = (float)urow[OFF_GL + (4 * g + hh) * 3 + br]; gt[hh][br] = 1.f / (1.f + __expf(-x)); }
        f32x2 y[4];
#pragma unroll
        for (int hh = 0; hh < 4; ++hh) y[hh] = (f32x2){0.f, 0.f};
        const int nvalid = t >= 31 ? ((t - 31) >> 4) + 1 : 0;
        const h16* KC = (const h16*)(P.ws + WS_KCMP) + (size_t)(b * 2 + g) * 512 * 128;
        const h16* VC = (const h16*)(P.ws + WS_VCMP) + (size_t)(b * 2 + g) * 512 * 128;
        {
            float p[8][4];
#pragma unroll
            for (int c = 0; c < 8; ++c) { const int n = 64 * c + lane; float s[4] = {0.f, 0.f, 0.f, 0.f};
                if (64 * c < nvalid) dot4(KC + (size_t)n * 128, qf, s);
#pragma unroll
                for (int hh = 0; hh < 4; ++hh) p[c][hh] = n < nvalid ? s[hh] * scale : -3.0e38f; }
#pragma unroll
            for (int hh = 0; hh < 4; ++hh) { float m = -3.0e38f;
#pragma unroll
                for (int c = 0; c < 8; ++c) m = fmaxf(m, p[c][hh]);
                m = wave_max(m); float l = 0.f;
#pragma unroll
                for (int c = 0; c < 8; ++c) { const int n = 64 * c + lane; const float e = n < nvalid ? __expf(p[c][hh] - m) : 0.f; p[c][hh] = e; l += e; }
                l = wave_sum(l); const float il = l > 0.f ? 1.f / l : 0.f;
#pragma unroll
                for (int c = 0; c < 8; ++c) p[c][hh] *= il; }
#pragma unroll
            for (int c = 0; c < 8; ++c) pbar[64 * c + lane] = (p[c][0] + p[c][1]) + (p[c][2] + p[c][3]);
            f32x2 o[4];
#pragma unroll
            for (int hh = 0; hh < 4; ++hh) o[hh] = (f32x2){0.f, 0.f};
#pragma unroll
            for (int c = 0; c < 8; ++c) {
                if (64 * c < nvalid) { const int je = (nvalid - 64 * c) < 64 ? (nvalid - 64 * c) : 64;
                    for (int j = 0; j < je; ++j) { const half2v v2 = *(const half2v*)(VC + (size_t)(64 * c + j) * 128 + 2 * lane); const f32x2 vf = {(float)v2.x, (float)v2.y};
#pragma unroll
                        for (int hh = 0; hh < 4; ++hh) o[hh] += bcast_lane(p[c][hh], j) * vf; } } }
#pragma unroll
            for (int hh = 0; hh < 4; ++hh) y[hh] += gt[hh][0] * o[hh];
        }
        unsigned long long sel_lo, sel_hi;
        {
            const int cur = t >> 6;
            float sc2[2];
#pragma unroll
            for (int q = 0; q < 2; ++q) { const int j = lane + 64 * q; float im = 0.f;
#pragma unroll
                for (int d = -1; d <= 3; ++d) { const int n = 4 * j + d; if (n >= 0 && n < 512) im += pbar[n]; }
                const bool valid = 64 * j <= t; const bool forced = (j == 0) || (j == cur) || (j == cur - 1);
                sc2[q] = valid ? im + (forced ? 1.0e4f : 0.f) : -1.f; impv[j] = sc2[q]; }
            int rk0 = 0, rk1 = 0;
            for (int j = 0; j < 128; ++j) { const float v = impv[j];
                rk0 += (v > sc2[0] || (v == sc2[0] && j < lane)) ? 1 : 0;
                rk1 += (v > sc2[1] || (v == sc2[1] && j < lane + 64)) ? 1 : 0; }
            sel_lo = __ballot(rk0 < 16 && 64 * lane <= t);
            sel_hi = __ballot(rk1 < 16 && 64 * (lane + 64) <= t);
        }
#pragma unroll 1
        for (int br = 1; br < 3; ++br) {
            const h16* KB = U + (size_t)b * SEQ * DINP + (br == 1 ? OFF_KS : OFF_KW) + g * 128;
            const h16* VB = U + (size_t)b * SEQ * DINP + (br == 1 ? OFF_VS : OFF_VW) + g * 128;
            float m[4], l[4]; f32x2 o[4];
#pragma unroll
            for (int hh = 0; hh < 4; ++hh) { m[hh] = -1.0e30f; l[hh] = 0.f; o[hh] = (f32x2){0.f, 0.f}; }
            const int nchunk = br == 1 ? 128 : 8; const int wstart = t - 511;
#pragma unroll 1
            for (int ci = 0; ci < nchunk; ++ci) {
                int p0;
                if (br == 1) { const bool on = ci < 64 ? ((sel_lo >> ci) & 1ull) : ((sel_hi >> (ci - 64)) & 1ull); if (!on) continue; p0 = 64 * ci; }
                else { p0 = wstart + 64 * ci; if (p0 + 63 < 0) continue; }
                const int pos = p0 + lane; const bool valid = pos >= 0 && pos <= t;
                float s[4] = {0.f, 0.f, 0.f, 0.f};
                if (valid) dot4(KB + (size_t)pos * DINP, qf, s);
                float pr[4];
#pragma unroll
                for (int hh = 0; hh < 4; ++hh) { const float sv = valid ? s[hh] * scale : -3.0e38f; const float mb = wave_max(sv); const float mn = fmaxf(m[hh], mb);
                    const float al = __expf(m[hh] - mn); const float e = valid ? __expf(sv - mn) : 0.f; pr[hh] = e;
                    l[hh] = l[hh] * al + wave_sum(e); o[hh] *= al; m[hh] = mn; }
                const int j0 = p0 < 0 ? -p0 : 0; const int je = (t - p0) < 63 ? (t - p0) : 63;
                for (int j = j0; j <= je; ++j) { const half2v v2 = *(const half2v*)(VB + (size_t)(p0 + j) * DINP + 2 * lane); const f32x2 vf = {(float)v2.x, (float)v2.y};
#pragma unroll
                    for (int hh = 0; hh < 4; ++hh) o[hh] += bcast_lane(pr[hh], j) * vf; }
            }
#pragma unroll
            for (int hh = 0; hh < 4; ++hh) y[hh] += (gt[hh][br] / l[hh]) * o[hh];
        }
#pragma unroll
        for (int hh = 0; hh < 4; ++hh) *(f32x2*)(Y + row * 1024 + (4 * g + hh) * 128 + 2 * lane) = y[hh];
    }
}


typedef short s16x4 __attribute__((ext_vector_type(4)));
typedef short s16x8 __attribute__((ext_vector_type(8)));
template <bool a0, bool a1> __device__ __forceinline__ void af_qk(const LAS unsigned char* kbuf, const unsigned (&kl)[4], const half8 (&qf)[2][4], f32x4 (&s)[2][4]) {
    const LAS unsigned char* ka[4];
    { int _ln; asm volatile("v_mov_b32 %0, %1" : "=v"(_ln) : "v"(kl[0]));
      const int fr_ = _ln & 15, e_ = (_ln >> 4) ^ fr_;
#pragma unroll
      for (int ks = 0; ks < 4; ++ks) ka[ks] = kbuf + fr_ * 256 + ((e_ ^ (4 * ks)) << 4); }
    half8 kf[2][4];
#pragma unroll
    for (int ks = 0; ks < 4; ++ks) kf[0][ks] = *(const LAS half8*)(ka[ks]);
#pragma unroll
    for (int kt = 0; kt < 4; ++kt) {
        if (kt < 3) {
#pragma unroll
            for (int ks = 0; ks < 4; ++ks) kf[(kt + 1) & 1][ks] = *(const LAS half8*)(ka[ks] + (kt + 1) * 4096); }
        s[0][kt] = (f32x4){0.f, 0.f, 0.f, 0.f}; s[1][kt] = (f32x4){0.f, 0.f, 0.f, 0.f};
#pragma unroll
        for (int ks = 0; ks < 4; ++ks) {
            if (a0) s[0][kt] = __builtin_amdgcn_mfma_f32_16x16x32_f16(kf[kt & 1][ks], qf[0][ks], s[0][kt], 0, 0, 0);
            if (a1) s[1][kt] = __builtin_amdgcn_mfma_f32_16x16x32_f16(kf[kt & 1][ks], qf[1][ks], s[1][kt], 0, 0, 0); }
        __builtin_amdgcn_sched_barrier(0);
    }
}
template <bool a0, bool a1> __device__ __forceinline__ void af_pv(const LAS unsigned char* vbuf, unsigned vl0, int z, const half8 (&pf)[2][2], f32x4 (&o)[2][8]) {
    typedef short v4i16_t __attribute__((ext_vector_type(4)));
    const LAS unsigned char* rb = vbuf + vl0;
    s16x4 vr[2][4];
#define AF_VLOAD(buf_, dt_) do { const LAS unsigned char* _ad = rb + (((dt_) ^ z) << 5); \
        vr[buf_][0] = __builtin_amdgcn_ds_read_tr16_b64_v4i16((LAS v4i16_t*)_ad); vr[buf_][1] = __builtin_amdgcn_ds_read_tr16_b64_v4i16((LAS v4i16_t*)(_ad + 4096)); \
        vr[buf_][2] = __builtin_amdgcn_ds_read_tr16_b64_v4i16((LAS v4i16_t*)(_ad + 8192)); vr[buf_][3] = __builtin_amdgcn_ds_read_tr16_b64_v4i16((LAS v4i16_t*)(_ad + 12288)); } while (0)
    AF_VLOAD(0, 0);
#pragma unroll
    for (int dt = 0; dt < 8; ++dt) {
        if (dt < 7) AF_VLOAD((dt + 1) & 1, dt + 1);
#pragma unroll
        for (int kp = 0; kp < 2; ++kp) {
            const s16x4 lo = vr[dt & 1][2 * kp], hi = vr[dt & 1][2 * kp + 1];
            s16x8 v8; v8[0] = lo[0]; v8[1] = lo[1]; v8[2] = lo[2]; v8[3] = lo[3]; v8[4] = hi[0]; v8[5] = hi[1]; v8[6] = hi[2]; v8[7] = hi[3];
            const half8 vf = __builtin_bit_cast(half8, v8);
            if (a0) o[0][dt] = __builtin_amdgcn_mfma_f32_16x16x32_f16(vf, pf[0][kp], o[0][dt], 0, 0, 0);
            if (a1) o[1][dt] = __builtin_amdgcn_mfma_f32_16x16x32_f16(vf, pf[1][kp], o[1][dt], 0, 0, 0);
        }
        __builtin_amdgcn_sched_barrier(0);
    }
#undef AF_VLOAD
}
__device__ __forceinline__ void af_maskraw(f32x4 (&s)[4], int mbase, int mstep, int fq, int hi, int lo) {
#pragma unroll
    for (int kt = 0; kt < 4; ++kt)
#pragma unroll
        for (int jj = 0; jj < 4; ++jj) { const int met = mbase + mstep * (16 * kt + 4 * fq + jj); s[kt][jj] = (met <= hi && met > lo) ? s[kt][jj] : -3.0e38f; }
}
__device__ __forceinline__ float af_colmax(const f32x4 (&s)[4]) {
    float v = -1.0e30f;
#pragma unroll
    for (int kt = 0; kt < 4; ++kt) v = fmaxf(v, fmaxf(fmaxf(s[kt][0], s[kt][1]), fmaxf(s[kt][2], s[kt][3])));
    v = fmaxf(v, __shfl_xor(v, 16)); v = fmaxf(v, __shfl_xor(v, 32)); return v;
}
__device__ __forceinline__ void af_pack(const f32x4 (&s)[4], half8 (&pf)[2]) {
#pragma unroll
    for (int kp = 0; kp < 2; ++kp) { half8 h;
#pragma unroll
        for (int jj = 0; jj < 4; ++jj) { h[jj] = (h16)s[2 * kp][jj]; h[4 + jj] = (h16)s[2 * kp + 1][jj]; }
        pf[kp] = h; }
}
__device__ __forceinline__ float af_rawmax(const f32x4 (&s)[4]) {
    float v = fmaxf(fmaxf(s[0][0], s[0][1]), fmaxf(s[0][2], s[0][3]));
#pragma unroll
    for (int kt = 1; kt < 4; ++kt) v = fmaxf(v, fmaxf(fmaxf(s[kt][0], s[kt][1]), fmaxf(s[kt][2], s[kt][3])));
    v = fmaxf(v, __shfl_xor(v, 16)); v = fmaxf(v, __shfl_xor(v, 32)); return v;
}
__device__ __forceinline__ void af_online_fast(f32x4 (&s)[4], bool colsel, float& m, float& l, f32x4 (&o)[8], half8 (&pf)[2], float SC) {
    const float mloc = colsel ? af_rawmax(s) * SC : -1.0e30f;
    const float mn = fmaxf(m, mloc); const float al = __builtin_amdgcn_exp2f(m - mn); m = mn;
    const float bias = colsel ? -mn : -1.0e30f; float ps = 0.f;
#pragma unroll
    for (int kt = 0; kt < 4; ++kt)
#pragma unroll
        for (int jj = 0; jj < 4; ++jj) { const float p = __builtin_amdgcn_exp2f(__builtin_fmaf(s[kt][jj], SC, bias)); s[kt][jj] = p; ps += p; }
    l = l * al + ps;
    if (__ballot(al != 1.f) != 0ull) {
#pragma unroll
        for (int dt = 0; dt < 8; ++dt) o[dt] *= al; }
    af_pack(s, pf);
}
__device__ __forceinline__ float af_write(float* Y, size_t row, int colbase, const f32x4 (&o)[8], float sc, bool accumulate) {
    float ss = 0.f;
#pragma unroll
    for (int dt = 0; dt < 8; ++dt) { float* p = Y + row * 1024 + colbase + 16 * dt; f32x4 v = o[dt] * sc; if (accumulate) v += *(const f32x4*)p; *(f32x4*)p = v;
        ss += (v[0] * v[0] + v[1] * v[1]) + (v[2] * v[2] + v[3] * v[3]); }
    return ss;
}
__device__ __forceinline__ float af_sigmoid(float x) { return 1.f / (1.f + __expf(-x)); }

template <bool A0, bool A1>
__device__ __forceinline__ void af_tile_online(const LAS unsigned char* stage, const unsigned (&kl)[4], unsigned vl0, int vz, const half8 (&qf)[2][4], f32x4 (&s)[2][4],
                                               float (&m)[2], float (&l)[2], f32x4 (&o)[2][8], bool needmask, int mbase, int fq, const int (&hi)[2], const int (&lo)[2], float SC) {
    af_qk<A0, A1>(stage, kl, qf, s);
    half8 pf[2][2];
    if (A0) { if (needmask) af_maskraw(s[0], mbase, 1, fq, hi[0], lo[0]); af_online_fast(s[0], hi[0] >= 0, m[0], l[0], o[0], pf[0], SC); } else { pf[0][0] = qf[0][0]; pf[0][1] = qf[0][0]; }
    if (A1) { if (needmask) af_maskraw(s[1], mbase, 1, fq, hi[1], lo[1]); af_online_fast(s[1], hi[1] >= 0, m[1], l[1], o[1], pf[1], SC); } else { pf[1][0] = qf[1][0]; pf[1][1] = qf[1][0]; }
    af_pv<A0, A1>(stage + 16384, vl0, vz, pf, o);
}
#define AF_ISSUE(st_, kb_, vb_, gs_, r0_, needv_) do { int _ln; asm volatile("v_mov_b32 %0, %1" : "=v"(_ln) : "v"(lane)); \
      _Pragma("unroll") for (int _c = 0; _c < 2; ++_c) { const int _row = 8 * w + 4 * _c + (_ln >> 4); \
      const h16* _kp = (kb_) + (size_t)((r0_) + _row) * (gs_) + (((_ln & 15) ^ (_row & 15)) << 3); \
      __builtin_amdgcn_global_load_lds((const unsigned*)_kp, (LAS unsigned*)(lds + (st_) * 32768 + (2 * w + _c) * 1024), 16, 0, 0); \
      if (needv_) { const h16* _vp = (vb_) + (size_t)((r0_) + _row) * (gs_) + (((_ln & 15) ^ (2 * (_row & 7))) << 3); \
      __builtin_amdgcn_global_load_lds((const unsigned*)_vp, (LAS unsigned*)(lds + (st_) * 32768 + 16384 + (2 * w + _c) * 1024), 16, 0, 0); } } } while (0)
#define AF_WAITV(n) asm volatile("s_waitcnt vmcnt(" #n ")" ::: "memory")
#define AF_BAR() do { __builtin_amdgcn_s_barrier(); asm volatile("" ::: "memory"); } while (0)

__device__ __forceinline__ void attn_fast(const Ptrs& P, LAS unsigned char* lds, int G, int bid) {
    const int tid = threadIdx.x, lane = tid & 63, w = __builtin_amdgcn_readfirstlane(tid >> 6), fr = lane & 15, fq = lane >> 4, qi = fr >> 2, hh = fr & 3;
    LAS float* IMP = (LAS float*)(lds + 98304) + w * (8 * 132);
    LAS unsigned* SELM = (LAS unsigned*)(lds + 132096);
    const h16* U = (const h16*)(P.ws + WS_U); float* Y = (float*)(P.ws + WS_YACC);
    const float SC = 0.08838834764831845f * 1.4426950408889634f;
    const int NEGBIG = -(1 << 30);
    unsigned kl[4]; kl[0] = (unsigned)lane; kl[1] = kl[2] = kl[3] = 0u;
    const int vz = (4 * fq + (fr >> 2)) & 7;
    const unsigned vl0 = (unsigned)((4 * fq + (fr >> 2)) * 256 + 8 * (fr & 1) + 16 * ((fr >> 1) & 1));
    const int nunits = (512 + G - 1) / G;
#pragma unroll 1
    for (int ui = 0; ui < nunits; ++ui) {
        int b, qb;
        if (G == 256) { const int idx = (bid & 1) * 32 + (bid >> 3); b = (bid & 7) >> 1; qb = ui == 0 ? 127 - idx : idx; }
        else { const int u = ui * G + bid; if (u >= 512) break;
               b = u >> 7; qb = (((u & 1) ^ ((u >> 8) & 1)) != 0) ? 127 - ((u >> 1) & 63) : ((u >> 1) & 63); }
#pragma unroll 1
        for (int g = 0; g < 2; ++g) {
            const int bg = 2 * b + g;
            int tq[2]; tq[0] = 64 * qb + 8 * w + qi; tq[1] = tq[0] + 4;
            const h16* Ub = U + (size_t)b * SEQ * DINP;
            half8 qf[2][4];
#pragma unroll
            for (int ct = 0; ct < 2; ++ct)
#pragma unroll
                for (int ks = 0; ks < 4; ++ks) qf[ct][ks] = *(const half8*)(Ub + (size_t)tq[ct] * DINP + OFF_Q + (4 * g + hh) * 128 + 32 * ks + 8 * fq);
            for (int i = lane; i < 8 * 132; i += 64) IMP[i] = 0.f;
            f32x4 s[2][4];
            const h16* KC = (const h16*)(P.ws + WS_KCMP) + (size_t)bg * 512 * 128;
            const h16* VC = (const h16*)(P.ws + WS_VCMP) + (size_t)bg * 512 * 128;
            const int ntc = ((4 * qb + 2) >> 6) + 1;
            float m[2], l[2];
            m[0] = m[1] = -1.0e30f; l[0] = l[1] = 0.f;
            AF_ISSUE(0, KC, VC, 128, 0, false);
            if (ntc > 1) AF_ISSUE(1, KC, VC, 128, 64, false);
#pragma unroll 1
            for (int T = 0; T < ntc; ++T) {
                if (T + 1 < ntc) AF_WAITV(2); else AF_WAITV(0);
                AF_BAR();
                if (T + 2 < ntc) AF_ISSUE((T + 2) % 3, KC, VC, 128, 64 * (T + 2), false);
                af_qk<true, true>(lds + (T % 3) * 32768, kl, qf, s);
#pragma unroll
                for (int ct = 0; ct < 2; ++ct) {
                    if (1024 * T + 1039 > 64 * qb) af_maskraw(s[ct], 1024 * T + 31, 16, fq, tq[ct], NEGBIG);
                    const float mn = fmaxf(m[ct], af_rawmax(s[ct]) * SC); const float al = __builtin_amdgcn_exp2f(m[ct] - mn); m[ct] = mn; float ps = 0.f;
#pragma unroll
                    for (int kt = 0; kt < 4; ++kt)
#pragma unroll
                        for (int jj = 0; jj < 4; ++jj) ps += __builtin_amdgcn_exp2f(__builtin_fmaf(s[ct][kt][jj], SC, -mn));
                    l[ct] = l[ct] * al + ps; }
            }
            float il[2];
#pragma unroll
            for (int ct = 0; ct < 2; ++ct) { float lt = l[ct]; lt += __shfl_xor(lt, 16); lt += __shfl_xor(lt, 32); il[ct] = lt > 0.f ? 1.f / lt : 0.f; }
            f32x4 o[2][8];
#pragma unroll
            for (int ct = 0; ct < 2; ++ct)
#pragma unroll
                for (int dt = 0; dt < 8; ++dt) o[ct][dt] = (f32x4){0.f, 0.f, 0.f, 0.f};
            AF_BAR();
            AF_ISSUE(0, KC, VC, 128, 0, true);
            if (ntc > 1) AF_ISSUE(1, KC, VC, 128, 64, true);
#pragma unroll 1
            for (int T = 0; T < ntc; ++T) {
                if (T + 1 < ntc) AF_WAITV(4); else AF_WAITV(0);
                AF_BAR();
                if (T + 2 < ntc) AF_ISSUE((T + 2) % 3, KC, VC, 128, 64 * (T + 2), true);
                af_qk<true, true>(lds + (T % 3) * 32768, kl, qf, s);
                half8 pf[2][2];
#pragma unroll
                for (int ct = 0; ct < 2; ++ct) {
                    if (1024 * T + 1039 > 64 * qb) af_maskraw(s[ct], 1024 * T + 31, 16, fq, tq[ct], NEGBIG);
#pragma unroll
                    for (int kt = 0; kt < 4; ++kt) {
#pragma unroll
                        for (int jj = 0; jj < 4; ++jj) s[ct][kt][jj] = __builtin_amdgcn_exp2f(__builtin_fmaf(s[ct][kt][jj], SC, -m[ct])) * il[ct];
                        float s4 = (s[ct][kt][0] + s[ct][kt][1]) + (s[ct][kt][2] + s[ct][kt][3]), s3 = s[ct][kt][3];
                        s4 += __shfl_xor(s4, 1); s4 += __shfl_xor(s4, 2); s3 += __shfl_xor(s3, 1); s3 += __shfl_xor(s3, 2);
                        if (hh == 0) { LAS float* ip = IMP + (4 * ct + qi) * 132 + 16 * T + 4 * kt + fq;
                            __hip_atomic_fetch_add(ip, s4, __ATOMIC_RELAXED, __HIP_MEMORY_SCOPE_WORKGROUP);
                            __hip_atomic_fetch_add(ip + 1, s3, __ATOMIC_RELAXED, __HIP_MEMORY_SCOPE_WORKGROUP); }
                    }
                    af_pack(s[ct], pf[ct]); }
                af_pv<true, true>(lds + (T % 3) * 32768 + 16384, vl0, vz, pf, o);
            }
#pragma unroll
            for (int ct = 0; ct < 2; ++ct) { int _ln; asm volatile("v_mov_b32 %0, %1" : "=v"(_ln) : "v"(lane));
                const int fr_ = _ln & 15, fq_ = _ln >> 4, hh_ = fr_ & 3;
                const size_t row = (size_t)b * SEQ + 64 * qb + 8 * w + 4 * ct + (fr_ >> 2);
                const float g0 = af_sigmoid((float)U[row * DINP + OFF_GL + (4 * g + hh_) * 3 + 0]);
                af_write(Y, row, (4 * g + hh_) * 128 + 4 * fq_, o[ct], g0, false); }
            __syncthreads();
#pragma unroll 1
            for (int ql = 0; ql < 8; ++ql) {
                LAS float* rowp = IMP + ql * 132;
                float sc0, sc1;
                { const int j = lane; const bool valid = j <= qb, forced = (j == 0) || (j == qb) || (j == qb - 1); const float v = rowp[j]; sc0 = valid ? v + (forced ? 1.0e4f : 0.f) : -1.f; rowp[j] = sc0; }
                { const int j = lane + 64; const bool valid = j <= qb, forced = (j == 0) || (j == qb) || (j == qb - 1); const float v = rowp[j]; sc1 = valid ? v + (forced ? 1.0e4f : 0.f) : -1.f; rowp[j] = sc1; }
                int r0 = 0, r1 = 0;
                for (int j4 = 0; j4 <= qb; j4 += 4) { const f32x4 v4 = *(const LAS f32x4*)(rowp + j4);
#pragma unroll
                    for (int e = 0; e < 4; ++e) { const int j = j4 + e; const float v = v4[e];
                        r0 += (v > sc0 || (v == sc0 && j < lane)) ? 1 : 0; r1 += (v > sc1 || (v == sc1 && j < lane + 64)) ? 1 : 0; } }
                const unsigned long long blo = __ballot(r0 < 16 && lane <= qb), bhi = __ballot(r1 < 16 && lane + 64 <= qb);
                if (lane == 0) { LAS unsigned* sp = SELM + (8 * w + ql) * 4; sp[0] = (unsigned)blo; sp[1] = (unsigned)(blo >> 32); sp[2] = (unsigned)bhi; sp[3] = (unsigned)(bhi >> 32); }
            }
            __syncthreads();
#pragma unroll 1
            for (int br = 1; br < 3; ++br) {
                const h16* KB = Ub + (br == 1 ? OFF_KS : OFF_KW) + g * 128;
                const h16* VB = Ub + (br == 1 ? OFF_VS : OFF_VW) + g * 128;
                const int j_lo = br == 1 ? 0 : (qb >= 8 ? qb - 8 : 0);
                const int nt = qb - j_lo + 1;
                m[0] = m[1] = -1.0e30f; l[0] = l[1] = 0.f;
#pragma unroll
                for (int ct = 0; ct < 2; ++ct)
#pragma unroll
                    for (int dt = 0; dt < 8; ++dt) o[ct][dt] = (f32x4){0.f, 0.f, 0.f, 0.f};
                AF_ISSUE(0, KB, VB, DINP, 64 * j_lo, true);
                if (nt > 1) AF_ISSUE(1, KB, VB, DINP, 64 * (j_lo + 1), true);
                if (nt > 2) AF_ISSUE(2, KB, VB, DINP, 64 * (j_lo + 2), true);
#pragma unroll 1
                for (int i = 0; i < nt; ++i) {
                    const int j = j_lo + i;
                    if (i + 2 < nt) AF_WAITV(8); else if (i + 1 < nt) AF_WAITV(4); else AF_WAITV(0);
                    AF_BAR();
                    if (i + 3 < nt) AF_ISSUE((i + 3) & 3, KB, VB, DINP, 64 * (j + 3), true);
                    int hi[2], lo[2]; bool act[2];
                    const bool needmask = (j == qb) || (br == 2 && 64 * j <= 64 * qb + 63 - 512);
#pragma unroll
                    for (int ct = 0; ct < 2; ++ct) {
                        if (br == 1) { const unsigned wd = SELM[(8 * w + 4 * ct + qi) * 4 + (j >> 5)]; const bool bit = (wd >> (j & 31)) & 1u;
                            act[ct] = __ballot(bit) != 0ull; hi[ct] = bit ? tq[ct] : -1; lo[ct] = NEGBIG; }
                        else { act[ct] = true; hi[ct] = tq[ct]; lo[ct] = tq[ct] - 512; }
                    }
                    const LAS unsigned char* stg = lds + (i & 3) * 32768;
                    if (act[0] && act[1]) af_tile_online<true, true>(stg, kl, vl0, vz, qf, s, m, l, o, needmask, 64 * j, fq, hi, lo, SC);
                    else if (act[0])      af_tile_online<true, false>(stg, kl, vl0, vz, qf, s, m, l, o, needmask, 64 * j, fq, hi, lo, SC);
                    else if (act[1])      af_tile_online<false, true>(stg, kl, vl0, vz, qf, s, m, l, o, needmask, 64 * j, fq, hi, lo, SC);
                }
#pragma unroll
                for (int ct = 0; ct < 2; ++ct) { int _ln; asm volatile("v_mov_b32 %0, %1" : "=v"(_ln) : "v"(lane));
                    const int fr_ = _ln & 15, fq_ = _ln >> 4, hh_ = fr_ & 3;
                    const size_t row = (size_t)b * SEQ + 64 * qb + 8 * w + 4 * ct + (fr_ >> 2);
                    float lt = l[ct]; lt += __shfl_xor(lt, 16); lt += __shfl_xor(lt, 32);
                    const float gg = af_sigmoid((float)U[row * DINP + OFF_GL + (4 * g + hh_) * 3 + br]);
                    (void)af_write(Y, row, (4 * g + hh_) * 128 + 4 * fq_, o[ct], lt > 0.f ? gg / lt : 0.f, true); }
                AF_BAR();
            }
        }
        {
            h16* MIX = (h16*)(P.ws + WS_H); const float* gw = P.in[15];
            int _ln; asm volatile("v_mov_b32 %0, %1" : "=v"(_ln) : "v"(lane));
            const int fr_ = _ln & 15, fq_ = _ln >> 4, hh_ = fr_ & 3;
#pragma unroll 1
            for (int ct = 0; ct < 2; ++ct) {
                const size_t row = (size_t)b * SEQ + 64 * qb + 8 * w + 4 * ct + (fr_ >> 2);
                float sv = 0.f;
#pragma unroll 1
                for (int g2 = 0; g2 < 2; ++g2)
#pragma unroll
                    for (int dt = 0; dt < 8; ++dt) { const f32x4 v = *(const f32x4*)(Y + row * 1024 + (4 * g2 + hh_) * 128 + 16 * dt + 4 * fq_);
                        sv += (v[0] * v[0] + v[1] * v[1]) + (v[2] * v[2] + v[3] * v[3]); }
                sv += __shfl_xor(sv, 1); sv += __shfl_xor(sv, 2); sv += __shfl_xor(sv, 16); sv += __shfl_xor(sv, 32);
                const float rstd = rsqrtf(sv * (1.f / 1024.f) + EPS);
#pragma unroll 1
                for (int g2 = 0; g2 < 2; ++g2)
#pragma unroll
                    for (int dt = 0; dt < 8; ++dt) { const int ch = (4 * g2 + hh_) * 128 + 16 * dt + 4 * fq_;
                        const f32x4 v = *(const f32x4*)(Y + row * 1024 + ch); const f32x4 gv = *(const f32x4*)(gw + ch); const f32x4 ov = v * rstd * gv;
                        u32x2 wv; wv.x = pg8::pk_h2(ov[0], ov[1]); wv.y = pg8::pk_h2(ov[2], ov[3]);
                        *(u32x2*)(MIX + row * DM + 1024 + ch) = wv; }
            }
        }
    }
}

__device__ __forceinline__ void attn_norm_rows(const Ptrs& P, int G, int bid) {
    const int lane = threadIdx.x & 63, wave = threadIdx.x >> 6;
    const float* Y = (const float*)(P.ws + WS_YACC); h16* MIX = (h16*)(P.ws + WS_H); const float* gw = P.in[15];
    for (int r = bid * 8 + wave; r < NT; r += G * 8) {
        f32x4 v[4]; float ss = 0.f;
#pragma unroll
        for (int i = 0; i < 4; ++i) { v[i] = *(const f32x4*)(Y + (size_t)r * 1024 + 4 * (lane + 64 * i)); ss += v[i][0] * v[i][0] + v[i][1] * v[i][1] + v[i][2] * v[i][2] + v[i][3] * v[i][3]; }
        ss = wave_sum(ss); const float rstd = rsqrtf(ss * (1.f / 1024.f) + EPS);
#pragma unroll
        for (int i = 0; i < 4; ++i) { const int c = 4 * (lane + 64 * i); const f32x4 g = *(const f32x4*)(gw + c); const f32x4 o = v[i] * rstd * g;
            u32x2 w; w.x = pg8::pk_h2(o[0], o[1]); w.y = pg8::pk_h2(o[2], o[3]);
            *(u32x2*)(MIX + (size_t)r * DM + 1024 + c) = w; }
    }
}


#define XB_TMO      128
#define XB_XCNT(j)  (256  + 64 * (j))
#define XB_XSUB(j)  (1280 + 64 * (j))
#define XB_XGEN(j)  (2304 + 64 * (j))
#define XB_TOP      3328
#define XB_TOPGEN   3392
#define XCD_BAR_WORDS 3456
#define XB_SPIN_CAP (1u << 18)
__device__ __forceinline__ unsigned xb_ld(unsigned* p)              { return __hip_atomic_load(p, __ATOMIC_RELAXED, __HIP_MEMORY_SCOPE_AGENT); }
__device__ __forceinline__ unsigned xb_add(unsigned* p, unsigned v) { return __hip_atomic_fetch_add(p, v, __ATOMIC_RELAXED, __HIP_MEMORY_SCOPE_AGENT); }
__device__ __forceinline__ unsigned xb_xcc_id() { return (unsigned)__builtin_amdgcn_s_getreg((3 << 11) | 20) & 0xFu; }
#define XB_SPIN(cond, bar) do { unsigned _sp = 0; while (cond) { __builtin_amdgcn_s_sleep(1); \
    if ((++_sp & 255u) == 0u) { if (xb_ld(&(bar)[XB_TMO])) break; if (_sp > XB_SPIN_CAP) { atomicAdd(&(bar)[XB_TMO], 1u); break; } } } } while (0)
struct XcdBarrier { unsigned* bar; unsigned x; volatile LAS unsigned* st; };
__device__ __forceinline__ XcdBarrier xcd_barrier_post(unsigned* bar, volatile LAS unsigned* st) {
    XcdBarrier b; b.bar = bar; b.x = xb_xcc_id(); b.st = st;
    if (threadIdx.x == 0) (void)xb_add(&bar[XB_XCNT(b.x)], 1u);
    return b;
}
__device__ __forceinline__ void xcd_barrier_complete(unsigned* bar, unsigned x, unsigned& nloc, unsigned& nx) {
    const unsigned G = gridDim.x * gridDim.y * gridDim.z;
    unsigned sum, cnt, mine, sp = 0u;
    for (;;) {
        sum = 0u; cnt = 0u; mine = 0u;
#pragma unroll
        for (unsigned j = 0; j < 16; ++j) { const unsigned c = xb_ld(&bar[XB_XCNT(j)]); sum += c; cnt += (c > 0u) ? 1u : 0u; mine = (j == x) ? c : mine; }
        if (sum == G) break;
        __builtin_amdgcn_s_sleep(1);
        if ((++sp & 255u) == 0u) { if (xb_ld(&bar[XB_TMO])) break; if (sp > XB_SPIN_CAP) { atomicAdd(&bar[XB_TMO], 1u); break; } }
    }
    nloc = mine > 0u ? mine : 1u; nx = cnt > 0u ? cnt : 1u;
}
__device__ __forceinline__ void xcd_barrier(const XcdBarrier& b) {
    asm volatile("s_waitcnt vmcnt(0)" ::: "memory");
    __syncthreads();
    if (threadIdx.x == 0) {
        unsigned* bar = b.bar;
        __builtin_amdgcn_s_waitcnt(0);
        unsigned nloc = b.st[0], nx = b.st[1];
        if (nloc == 0u) { xcd_barrier_complete(bar, b.x, nloc, nx); b.st[0] = nloc; b.st[1] = nx; }
        const unsigned old = xb_add(&bar[XB_XSUB(b.x)], 1u);
        const unsigned gen = old / nloc;
        if (old + 1u == (gen + 1u) * nloc) {
            __builtin_amdgcn_fence(__ATOMIC_RELEASE, "agent");
            asm volatile("s_waitcnt vmcnt(0)" ::: "memory");
            const unsigned og = xb_add(&bar[XB_TOP], 1u);
            const unsigned tg = og / nx;
            if (og + 1u == (tg + 1u) * nx) xb_add(&bar[XB_TOPGEN], 1u);
            else XB_SPIN(xb_ld(&bar[XB_TOPGEN]) == tg, bar);
            __builtin_amdgcn_fence(__ATOMIC_ACQUIRE, "agent");
            xb_add(&bar[XB_XGEN(b.x)], 1u);
            asm volatile("s_waitcnt vmcnt(0)" ::: "memory");
        } else {
            XB_SPIN(xb_ld(&bar[XB_XGEN(b.x)]) == gen, bar);
            __builtin_amdgcn_fence(__ATOMIC_ACQUIRE, "agent");
            asm volatile("s_waitcnt vmcnt(0)" ::: "memory");
        }
    }
    __syncthreads();
}

constexpr int NPHASE = 12;
struct Args { Ptrs p; int ph_lo, ph_hi; };

__global__ void __launch_bounds__(NTHR, 2) mega(Args args) {
    extern __shared__ __attribute__((aligned(16))) unsigned char lds_raw[];
    LAS unsigned char* lds = (LAS unsigned char*)lds_raw;
    const Ptrs& P = args.p;
    const int G = gridDim.x, bid = blockIdx.x;
    unsigned char* ws = P.ws;
    const float* mod = (const float*)(ws + WS_MOD);
    const int lo = args.ph_lo, hi = args.ph_hi;
    volatile LAS unsigned* MISC = (volatile LAS unsigned*)(lds + LDS_BYTES - 64);
    if (threadIdx.x < 16) MISC[threadIdx.x] = 0u;
    __syncthreads();
    XcdBarrier xbar; xbar.bar = (unsigned*)(ws + WS_BAR); xbar.x = 0; xbar.st = MISC;
    if (hi - lo > 1) xbar = xcd_barrier_post((unsigned*)(ws + WS_BAR), MISC);
#define PHASE_BEGIN(n) if (lo <= (n) && (n) < hi) {
#define PHASE_END(n) if ((n) + 1 < hi) { if (G != 256) cg::this_grid().sync(); else xcd_barrier(xbar); } }
    PHASE_BEGIN(0) p0_prologue(P, lds, G, bid); PHASE_END(0)
    PHASE_BEGIN(1) norm_mod_rows(P.in[0], P.in[4], mod, 0, 2048, (h16*)(ws + WS_H), G, bid); PHASE_END(1)
    PHASE_BEGIN(2) { pg8::Gemm g{(const h16*)(ws + WS_H), (const h16*)(ws + WS_WIN), NT, DINP, DM}; pg8::StaticOrder S; S.init(NT, DINP, G, bid);
                  pg8::EpiF16<0> E{(h16*)(ws + WS_U), DINP}; pg8::gemm_phase(lds, g, S, E); } PHASE_END(2)
    PHASE_BEGIN(3) post_u_rows(P, G, bid); PHASE_END(3)
    PHASE_BEGIN(4) compress_phase(P, lds, G, bid); PHASE_END(4)
#if FAST_ATTN
    PHASE_BEGIN(5) attn_fast(P, lds, G, bid); PHASE_END(5)
#else
    PHASE_BEGIN(5) PHASE_END(5)
#endif
    PHASE_BEGIN(7) { pg8::Gemm g{(const h16*)(ws + WS_H), (const h16*)(ws + WS_WOUT), NT, DM, DM}; pg8::StaticOrder S; S.init(NT, DM, G, bid);
                  pg8::EpiRes E{P.in[0], P.out, mod + 2 * 2048, 12288}; pg8::gemm_phase(lds, g, S, E); } PHASE_END(7)
    PHASE_BEGIN(8) norm_mod_rows(P.out, P.in[17], mod, 3 * 2048, 4 * 2048, (h16*)(ws + WS_H), G, bid); PHASE_END(8)
    PHASE_BEGIN(9) { pg8::Gemm g{(const h16*)(ws + WS_H), (const h16*)(ws + WS_W1), NT, DFF, DM}; pg8::StaticOrder S; S.init(NT, DFF, G, bid);
                  pg8::EpiF16<1> E{(h16*)(ws + WS_HID), DFF}; pg8::gemm_phase(lds, g, S, E); } PHASE_END(9)
    PHASE_BEGIN(10) { pg8::Gemm g{(const h16*)(ws + WS_HID), (const h16*)(ws + WS_W2), NT, DM, DFF}; pg8::StaticOrder S; S.init(NT, DM, G, bid);
                   pg8::EpiRes E{P.out, P.out, mod + 5 * 2048, 12288}; pg8::gemm_phase(lds, g, S, E); } PHASE_END(10)
    PHASE_BEGIN(11) final_norm_rows(P.out, P.in[20], G, bid); PHASE_END(11)
}

__global__ void __launch_bounds__(NTHR, 2) attn_simple_kernel(Args args) {
    extern __shared__ __attribute__((aligned(16))) unsigned char lds_raw[];
    attn_simple(args.p, (LAS unsigned char*)lds_raw, gridDim.x, blockIdx.x);
}

extern "C" void kernel_launch(void* const* d_in, const int* in_sizes, int n_in, void* d_out, int out_size, void* d_ws, size_t ws_size, hipStream_t stream) {
    static int grid = 0;
    if (grid == 0) {
        if (n_in != 21 || out_size != NT * DM || ws_size < WS_END) { fprintf(stderr, "kernel_launch: unexpected shapes (n_in %d out %d ws %zu need %zu)\n", n_in, out_size, ws_size, (size_t)WS_END); grid = -1; return; }
        int dev = 0, cus = 0, per_cu = 0;
        hipGetDevice(&dev); hipDeviceGetAttribute(&cus, hipDeviceAttributeMultiprocessorCount, dev);
        if (hipFuncSetAttribute((const void*)mega, hipFuncAttributeMaxDynamicSharedMemorySize, LDS_BYTES) != hipSuccess) { fprintf(stderr, "kernel_launch: hipFuncSetAttribute failed\n"); grid = -1; return; }
        if (hipOccupancyMaxActiveBlocksPerMultiprocessor(&per_cu, (const void*)mega, NTHR, LDS_BYTES) != hipSuccess || per_cu < 1) { fprintf(stderr, "kernel_launch: occupancy query says %d\n", per_cu); per_cu = 1; }
        (void)hipGetLastError();
        grid = cus * 1;
        fprintf(stderr, "kernel_launch: cus %d per_cu %d grid %d\n", cus, per_cu, grid);
    }
    if (grid < 0) return;
    if (hipMemsetAsync((char*)d_ws + WS_BAR, 0, WS_BAR_BYTES, stream) != hipSuccess) { fprintf(stderr, "kernel_launch: memset failed\n"); return; }
    Args a{};
    for (int i = 0; i < 21; ++i) a.p.in[i] = (const float*)d_in[i];
    a.p.out = (float*)d_out; a.p.ws = (unsigned char*)d_ws;
#if ONE_LAUNCH == 1
    a.ph_lo = 0; a.ph_hi = NPHASE;
    void* kargs[] = {&a};
    hipError_t e = hipLaunchCooperativeKernel((const void*)mega, dim3(grid), dim3(NTHR), kargs, LDS_BYTES, stream);
    if (e != hipSuccess) fprintf(stderr, "cooperative launch failed: %s (grid %d)\n", hipGetErrorString(e), grid);
#elif ONE_LAUNCH == 3
    {
        void* kargs[] = {&a};
        a.ph_lo = 0; a.ph_hi = 5;
        hipError_t e = hipLaunchCooperativeKernel((const void*)mega, dim3(grid), dim3(NTHR), kargs, LDS_BYTES, stream);
        if (e != hipSuccess) fprintf(stderr, "cooperative launch A failed: %s (grid %d)\n", hipGetErrorString(e), grid);
        hipLaunchKernelGGL(attn_simple_kernel, dim3(grid * 4), dim3(NTHR), 48 * 1024, stream, a);
        a.ph_lo = 6; a.ph_hi = NPHASE;
        e = hipLaunchCooperativeKernel((const void*)mega, dim3(grid), dim3(NTHR), kargs, LDS_BYTES, stream);
        if (e != hipSuccess) fprintf(stderr, "cooperative launch B failed: %s (grid %d)\n", hipGetErrorString(e), grid);
    }
#else
    for (int ph = 0; ph < NPHASE; ++ph) {
        a.ph_lo = ph; a.ph_hi = ph + 1;
        if (ph == 5) hipLaunchKernelGGL(attn_simple_kernel, dim3(grid * 4), dim3(NTHR), 48 * 1024, stream, a);
        else hipLaunchKernelGGL(mega, dim3(grid), dim3(NTHR), LDS_BYTES, stream, a);
    }
#endif
}
```

```cpp
#include <hip/hip_runtime.h>
#include <hip/hip_cooperative_groups.h>
#include <cstdint>
#include <cstdio>
namespace cg = cooperative_groups;

#ifndef ONE_LAUNCH
#define ONE_LAUNCH 1
#endif
#ifndef FAST_ATTN
#define FAST_ATTN 1
#endif

#define LAS __attribute__((address_space(3)))
typedef _Float16 h16;
typedef _Float16 half8 __attribute__((ext_vector_type(8)));
typedef _Float16 half4 __attribute__((ext_vector_type(4)));
typedef _Float16 half2v __attribute__((ext_vector_type(2)));
typedef float f32x4 __attribute__((ext_vector_type(4)));
typedef float f32x2 __attribute__((ext_vector_type(2)));
typedef unsigned u32x4 __attribute__((ext_vector_type(4)));
typedef unsigned u32x2 __attribute__((ext_vector_type(2)));

constexpr int NB = 4, SEQ = 8192, NT = NB * SEQ, DM = 2048, DIN = 5656, DINP = 5888, DFF = 8192;
constexpr int OFF_UB = 0, OFF_UC = 1024, OFF_UH = 2048, OFF_Q = 3072, OFF_KC = 4096, OFF_VC = 4352, OFF_KS = 4608, OFF_VS = 4864,
              OFF_KW = 5120, OFF_VW = 5376, OFF_GL = 5632;
constexpr float EPS = 1e-6f;
constexpr int NTHR = 512;
constexpr int LDS_BYTES = 136 * 1024;

constexpr size_t WS_BAR   = 0;
constexpr size_t WS_BAR_BYTES = 16384;
constexpr size_t WS_MOD   = 16384;
constexpr size_t WS_B1P   = WS_MOD + (size_t)4 * 12288 * 4;
constexpr size_t WS_WIN   = WS_B1P + (size_t)2 * 32 * 256 * 4;
constexpr size_t WS_WOUT  = WS_WIN + (size_t)DINP * DM * 2;
constexpr size_t WS_W1    = WS_WOUT + (size_t)DM * DM * 2;
constexpr size_t WS_W2    = WS_W1 + (size_t)DFF * DM * 2;
constexpr size_t WS_CW1K  = WS_W2 + (size_t)DFF * DM * 2;
constexpr size_t WS_CW1V  = WS_CW1K + (size_t)256 * 4096 * 2;
constexpr size_t WS_CW2K  = WS_CW1V + (size_t)256 * 4096 * 2;
constexpr size_t WS_CW2V  = WS_CW2K + (size_t)128 * 256 * 2;
constexpr size_t WS_KCMP  = WS_CW2V + (size_t)128 * 256 * 2;
constexpr size_t WS_VCMP  = WS_KCMP + (size_t)8 * 512 * 128 * 2;
constexpr size_t WS_H     = WS_VCMP + (size_t)8 * 512 * 128 * 2;
constexpr size_t WS_BIG   = WS_H + (size_t)NT * DM * 2;
constexpr size_t WS_U     = WS_BIG;
constexpr size_t WS_YACC  = WS_U + (size_t)NT * DINP * 2;
constexpr size_t WS_HID   = WS_BIG;
constexpr size_t WS_END   = WS_BIG + (size_t)NT * DFF * 2;
static_assert(WS_YACC + (size_t)NT * 1024 * 4 <= WS_END, "ws map");
static_assert(WS_END <= (size_t)1073741824, "ws map fits 4x largest tensor");
static_assert(WS_WIN % 256 == 0 && WS_H % 256 == 0 && WS_BIG % 256 == 0 && WS_YACC % 256 == 0, "alignment");

namespace pg8 {
constexpr int BM = 256, BK = 64, HALF = 128, HTB = HALF * BK * 2, STAGE_BYTES = 8 * HTB, NXCD = 8, WGM = 8;
__host__ __device__ __forceinline__ int lds_byte(int r, int c) { const int st = (r >> 4) * 2 + (c >> 5), rr = r & 15, cc = c & 31, ob = rr * 64 + cc * 2; return st * 1024 + (ob ^ (((ob >> 9) & 1) << 5)); }
__host__ __device__ __forceinline__ void stage_rc(int b, int& R, int& C) { const int st = b / 1024, sb = b % 1024, swz = sb ^ (((sb >> 9) & 1) << 5); R = (st >> 1) * 16 + swz / 64; C = (st & 1) * 32 + (swz % 64) / 2; }
__host__ __device__ __forceinline__ int perm32(int rho) { const int n = rho >> 4, i = rho & 15; return 8 * (i >> 2) + 4 * n + (i & 3); }

struct Unit { int pm, pn; };
struct Gemm { const h16* A; const h16* Bt; int M, N, K; };

struct StaticOrder {
    int nM, nN, nwg, G, c;
    __host__ __device__ void init(int M, int N, int G_, int c_) { nM = M / BM; nN = N / BM; nwg = nM * nN; G = G_; c = c_; }
    __host__ __device__ bool next(int i, Unit& u) const {
        const long L = (long)i * G + c; if (L >= nwg) return false;
        int wgid = (int)L; { const int q = nwg / NXCD, r = nwg % NXCD, xcd = wgid % NXCD, off = wgid / NXCD; wgid = (xcd < r ? xcd * (q + 1) : r * (q + 1) + (xcd - r) * q) + off; }
        const int nig = WGM * nN, gid = wgid / nig, fm = gid * WGM, gsz = (nM - fm) < WGM ? (nM - fm) : WGM;
        u.pm = fm + ((wgid % nig) % gsz); u.pn = (wgid % nig) / gsz; return true;
    }
    __device__ __forceinline__ void a_ready(const Unit&) const {}
    __device__ __forceinline__ void done(const Unit&) const {}
};

__device__ __forceinline__ unsigned pk_h2(float lo, float hi) { half2v v; v.x = (h16)lo; v.y = (h16)hi; return __builtin_bit_cast(unsigned, v); }
__device__ __forceinline__ unsigned pk_bf2(float lo, float hi) { unsigned r; asm("v_cvt_pk_bf16_f32 %0, %1, %2" : "=v"(r) : "v"(lo), "v"(hi)); return r; }
template <bool BF> __device__ __forceinline__ unsigned pk2(float lo, float hi) { return BF ? pk_bf2(lo, hi) : pk_h2(lo, hi); }
typedef short bfx8 __attribute__((ext_vector_type(8)));

template <int ACT, bool BF = false> struct EpiF16 {
    static constexpr bool PERM = true, AFTER_DRAIN = false;
    h16* O; int ldc;
    __device__ __forceinline__ void operator()(const f32x4 (&acc)[2][2][4][2], const Unit& u, int wr, int wc, int fr, int fq) const {
        const int row0 = u.pm * BM + wr * 64 + fr; const int col0 = u.pn * BM + wc * 32 + 8 * fq;
#pragma unroll
        for (int ai = 0; ai < 2; ++ai)
#pragma unroll
            for (int m = 0; m < 4; ++m) { h16* rowp = O + (size_t)(row0 + ai * HALF + m * 16) * ldc + col0;
#pragma unroll
                for (int bj = 0; bj < 2; ++bj) { f32x4 v0 = acc[ai][bj][m][0], v1 = acc[ai][bj][m][1];
                    if (ACT == 1) {
#pragma unroll
                        for (int j = 0; j < 4; ++j) { const float a = fmaxf(v0[j], 0.f), b = fmaxf(v1[j], 0.f); v0[j] = a * a; v1[j] = b * b; } }
                    u32x4 w; w.x = pk2<BF>(v0[0], v0[1]); w.y = pk2<BF>(v0[2], v0[3]); w.z = pk2<BF>(v1[0], v1[1]); w.w = pk2<BF>(v1[2], v1[3]);
                    *(u32x4*)(rowp + bj * HALF) = w; } }
    }
};
struct EpiRes {
    static constexpr bool PERM = false, AFTER_DRAIN = false;
    const float* base; float* out; const float* gate; int gate_ld;
    __device__ __forceinline__ void operator()(const f32x4 (&acc)[2][2][4][2], const Unit& u, int wr, int wc, int fr, int fq) const {
        const int row0 = u.pm * BM + wr * 64 + fr, col0 = u.pn * BM + wc * 32 + 4 * fq; const int b = (u.pm * BM) / SEQ;
        f32x4 gv[2][2];
#pragma unroll
        for (int bj = 0; bj < 2; ++bj)
#pragma unroll
            for (int n = 0; n < 2; ++n) gv[bj][n] = *(const f32x4*)(gate + (size_t)b * gate_ld + col0 + bj * HALF + n * 16);
#pragma unroll
        for (int ai = 0; ai < 2; ++ai)
#pragma unroll
            for (int m = 0; m < 4; ++m) { const size_t ro = (size_t)(row0 + ai * HALF + m * 16) * DM + col0;
#pragma unroll
                for (int bj = 0; bj < 2; ++bj)
#pragma unroll
                    for (int n = 0; n < 2; ++n) { const f32x4 bv = *(const f32x4*)(base + ro + bj * HALF + n * 16);
                        *(f32x4*)(out + ro + bj * HALF + n * 16) = bv + gv[bj][n] * acc[ai][bj][m][n]; } }
    }
};

template <bool BF16, class Epi, class Sched, bool ALIGN_EPI = true, bool SP2 = true>
__device__ __forceinline__ void gemm_phase(LAS unsigned char* lds, const Gemm g, const Sched& S, const Epi& E) {
    const int tid = threadIdx.x, wid = __builtin_amdgcn_readfirstlane(tid >> 6), lane = tid & 63, wr = wid >> 2, wc = wid & 3, fr = lane & 15, fq = lane >> 4;
    const int K = g.K, nt = K / BK;
    unsigned voffA[2], voffB[2];
#pragma unroll
    for (int i = 0; i < 2; ++i) { int R, C; stage_rc(tid * 16 + i * 8192, R, C); const int Rb = Epi::PERM ? ((R & ~31) + perm32(R & 31)) : R;
        voffA[i] = (unsigned)(R * K + C) * 2u; voffB[i] = (unsigned)(Rb * K + C) * 2u; }
    const size_t kstep = (size_t)(BK * 2);
    const size_t hstep = (size_t)HALF * K * 2;
    const size_t tstep = 2 * hstep;
    const unsigned ldsw = (unsigned)wid * 1024u;
    const int aoff = lds_byte(wr * 64 + fr, fq * 8), boff = lds_byte(wc * 32 + fr, fq * 8);
#define PG8_SA(b, h) (((b) * 2 + (h)) * HTB)
#define PG8_SB(b, h) ((4 + (b) * 2 + (h)) * HTB)
#define PG8_STAGE(bufoff, gbase, voff) do { _Pragma("unroll") for (int _i = 0; _i < 2; ++_i) \
        __builtin_amdgcn_global_load_lds((const unsigned*)((const char*)(gbase) + (voff)[_i]), (LAS unsigned*)(lds + (bufoff) + ldsw + _i * 8192), 16, 0, 0); } while (0)
#define PG8_LDA(dst, b, h) do { _Pragma("unroll") for (int m = 0; m < 4; ++m) _Pragma("unroll") for (int k = 0; k < 2; ++k) dst[m][k] = *(const LAS half8*)(lds + PG8_SA(b, h) + aoff + m * 2048 + k * 1024); } while (0)
#define PG8_LDB(dst, b, h) do { _Pragma("unroll") for (int n = 0; n < 2; ++n) _Pragma("unroll") for (int k = 0; k < 2; ++k) dst[n][k] = *(const LAS half8*)(lds + PG8_SB(b, h) + boff + n * 2048 + k * 1024); } while (0)
#define PG8_MMA(ai, bj, At, Bt) do { __builtin_amdgcn_s_setprio(1); _Pragma("unroll") for (int m = 0; m < 4; ++m) _Pragma("unroll") for (int n = 0; n < 2; ++n) _Pragma("unroll") for (int k = 0; k < 2; ++k) \
        acc[ai][bj][m][n] = BF16 ? __builtin_amdgcn_mfma_f32_16x16x32_bf16(__builtin_bit_cast(bfx8, Bt[n][k]), __builtin_bit_cast(bfx8, At[m][k]), acc[ai][bj][m][n], 0, 0, 0) \
                                 : __builtin_amdgcn_mfma_f32_16x16x32_f16(Bt[n][k], At[m][k], acc[ai][bj][m][n], 0, 0, 0); __builtin_amdgcn_s_setprio(0); } while (0)
#define PG8_WAIT_V(n) asm volatile("s_waitcnt vmcnt(" #n ")" ::: "memory")
#define PG8_WAIT_L(n) asm volatile("s_waitcnt lgkmcnt(" #n ")" ::: "memory")
#define PG8_BAR __builtin_amdgcn_s_barrier()
#define PG8_SCHED __builtin_amdgcn_sched_barrier(0)
    Unit cur, nxt; int ui = 0;
    if (!S.next(0, cur)) return;
    f32x4 acc[2][2][4][2];
#pragma unroll
    for (int a = 0; a < 2; ++a)
#pragma unroll
        for (int b = 0; b < 2; ++b)
#pragma unroll
            for (int m = 0; m < 4; ++m)
#pragma unroll
                for (int n = 0; n < 2; ++n) acc[a][b][m][n] = (f32x4){0.f, 0.f, 0.f, 0.f};
    half8 At[4][2], B0[2][2], B1[2][2];
    const char* cA = (const char*)g.A + (size_t)cur.pm * tstep; const char* cB = (const char*)g.Bt + (size_t)cur.pn * tstep;
    S.a_ready(cur);
    if constexpr (SP2) {
        PG8_STAGE(PG8_SB(0, 0), cB, voffB); PG8_STAGE(PG8_SB(0, 1), cB + hstep, voffB); PG8_STAGE(PG8_SA(0, 0), cA, voffA); PG8_STAGE(PG8_SA(0, 1), cA + hstep, voffA);
        if (wr == 1) PG8_BAR;
        PG8_WAIT_V(2); PG8_BAR;
        PG8_STAGE(PG8_SB(1, 0), cB + kstep, voffB); PG8_STAGE(PG8_SA(1, 0), cA + kstep, voffA); PG8_STAGE(PG8_SB(1, 1), cB + hstep + kstep, voffB);
        PG8_WAIT_V(6); PG8_BAR;
    } else {
        PG8_STAGE(PG8_SB(0, 0), cB, voffB); PG8_STAGE(PG8_SA(0, 0), cA, voffA); PG8_STAGE(PG8_SB(0, 1), cB + hstep, voffB); PG8_STAGE(PG8_SA(0, 1), cA + hstep, voffA);
        if (wr == 1) PG8_BAR;
        PG8_WAIT_V(4); PG8_BAR;
        PG8_STAGE(PG8_SB(1, 0), cB + kstep, voffB); PG8_STAGE(PG8_SA(1, 0), cA + kstep, voffA); PG8_STAGE(PG8_SB(1, 1), cB + hstep + kstep, voffB);
        PG8_WAIT_V(6); PG8_BAR;
    }
    for (;;) {
        const bool has_next = S.next(ui + 1, nxt);
        const char* nA = has_next ? (const char*)g.A + (size_t)nxt.pm * tstep : cA; const char* nB = has_next ? (const char*)g.Bt + (size_t)nxt.pn * tstep : cB;
        for (int t = 0; t < nt; t += 2) {
            const bool last = (t == nt - 2);
            const char* a1 = cA + (size_t)(t + 1) * kstep;
            const char* a2 = last ? nA : cA + (size_t)(t + 2) * kstep; const char* b2 = last ? nB : cB + (size_t)(t + 2) * kstep;
            const char* a3 = a2 + kstep; const char* b3 = b2 + kstep;
            if (last && has_next) S.a_ready(nxt);
            if constexpr (SP2) {
            PG8_LDB(B0, 0, 0); PG8_LDB(B1, 0, 1); PG8_SCHED; PG8_LDA(At, 0, 0); PG8_STAGE(PG8_SA(1, 1), a1 + hstep, voffA);
            PG8_WAIT_V(8); PG8_WAIT_L(0); PG8_BAR; PG8_MMA(0, 0, At, B0); PG8_MMA(0, 1, At, B1); PG8_BAR; PG8_SCHED;
            PG8_LDA(At, 0, 1); PG8_STAGE(PG8_SB(0, 0), b2, voffB); PG8_STAGE(PG8_SB(0, 1), b2 + hstep, voffB); PG8_STAGE(PG8_SA(0, 0), a2, voffA);
            PG8_WAIT_V(8); PG8_WAIT_L(0); PG8_BAR; PG8_MMA(1, 0, At, B0); PG8_MMA(1, 1, At, B1); PG8_BAR; PG8_SCHED;
            PG8_LDB(B0, 1, 0); PG8_LDB(B1, 1, 1); PG8_SCHED; PG8_LDA(At, 1, 0); PG8_STAGE(PG8_SA(0, 1), a2 + hstep, voffA);
            PG8_WAIT_V(8); PG8_WAIT_L(0); PG8_BAR; PG8_MMA(0, 0, At, B0); PG8_MMA(0, 1, At, B1); PG8_BAR; PG8_SCHED;
            PG8_LDA(At, 1, 1); PG8_STAGE(PG8_SB(1, 0), b3, voffB); PG8_STAGE(PG8_SB(1, 1), b3 + hstep, voffB); PG8_STAGE(PG8_SA(1, 0), a3, voffA);
            PG8_WAIT_V(8); PG8_WAIT_L(0); PG8_BAR; PG8_MMA(1, 0, At, B0); PG8_MMA(1, 1, At, B1); PG8_BAR; PG8_SCHED;
            } else {
            PG8_LDB(B0, 0, 0); PG8_SCHED; PG8_LDA(At, 0, 0); PG8_STAGE(PG8_SA(1, 1), a1 + hstep, voffA);
            PG8_WAIT_L(8); PG8_BAR; PG8_WAIT_L(0); PG8_MMA(0, 0, At, B0); PG8_BAR; PG8_SCHED;
            PG8_LDB(B1, 0, 1); PG8_STAGE(PG8_SB(0, 0), b2, voffB);
            PG8_BAR; PG8_WAIT_L(0); PG8_MMA(0, 1, At, B1); PG8_BAR;
            PG8_LDA(At, 0, 1); PG8_STAGE(PG8_SA(0, 0), a2, voffA);
            PG8_BAR; PG8_WAIT_L(0); PG8_MMA(1, 0, At, B0); PG8_BAR; PG8_SCHED;
            PG8_STAGE(PG8_SB(0, 1), b2 + hstep, voffB);
            PG8_WAIT_V(6); PG8_BAR; PG8_MMA(1, 1, At, B1); PG8_BAR;
            PG8_LDB(B0, 1, 0); PG8_SCHED; PG8_LDA(At, 1, 0); PG8_STAGE(PG8_SA(0, 1), a2 + hstep, voffA);
            PG8_WAIT_L(8); PG8_BAR; PG8_WAIT_L(0); PG8_MMA(0, 0, At, B0); PG8_BAR; PG8_SCHED;
            PG8_LDB(B1, 1, 1); PG8_STAGE(PG8_SB(1, 0), b3, voffB);
            PG8_BAR; PG8_WAIT_L(0); PG8_MMA(0, 1, At, B1); PG8_BAR;
            PG8_LDA(At, 1, 1); PG8_STAGE(PG8_SA(1, 0), a3, voffA);
            PG8_BAR; PG8_WAIT_L(0); PG8_MMA(1, 0, At, B0); PG8_BAR; PG8_SCHED;
            PG8_STAGE(PG8_SB(1, 1), b3 + hstep, voffB);
            PG8_WAIT_V(6); PG8_BAR; PG8_MMA(1, 1, At, B1); PG8_BAR;
            }
        }
        if constexpr (ALIGN_EPI) { if (wr == 0) PG8_BAR; }
        E(acc, cur, wr, wc, fr, fq); S.done(cur);
        if (!has_next) break;
#pragma unroll
        for (int a = 0; a < 2; ++a)
#pragma unroll
            for (int b = 0; b < 2; ++b)
#pragma unroll
                for (int m = 0; m < 4; ++m)
#pragma unroll
                    for (int n = 0; n < 2; ++n) acc[a][b][m][n] = (f32x4){0.f, 0.f, 0.f, 0.f};
        cur = nxt; cA = nA; cB = nB; ++ui;
        if constexpr (ALIGN_EPI) { if (wr == 1) PG8_BAR; }
    }
    PG8_WAIT_V(0);
    if constexpr (!ALIGN_EPI) { if (wr == 0) PG8_BAR; }
    PG8_BAR;
#undef PG8_SA
#undef PG8_SB
#undef PG8_STAGE
#undef PG8_LDA
#undef PG8_LDB
#undef PG8_MMA
#undef PG8_WAIT_V
#undef PG8_WAIT_L
#undef PG8_BAR
#undef PG8_SCHED
}
}

__device__ __forceinline__ float wave_sum(float v) {
#pragma unroll
    for (int o = 1; o < 64; o <<= 1) v += __shfl_xor(v, o);
    return v;
}
__device__ __forceinline__ float wave_max(float v) {
#pragma unroll
    for (int o = 1; o < 64; o <<= 1) v = fmaxf(v, __shfl_xor(v, o));
    return v;
}
__device__ __forceinline__ float bcast_lane(float v, int j) { return __builtin_bit_cast(float, __builtin_amdgcn_readlane(__builtin_bit_cast(int, v), j)); }

struct Ptrs {
    const float* in[21]; float* out; unsigned char* ws;
};

constexpr int P0_ADA = 192, P0_B1 = 64;
constexpr int P0_TWIN = 32 * 23, P0_TWOUT = 32 * 8, P0_TW1 = 32 * 32, P0_TW2 = 128 * 8, P0_TC1 = 64 * 1, P0_TC2 = 4 * 1;
constexpr int P0_OFF_B1 = P0_ADA, P0_OFF_TWIN = P0_OFF_B1 + P0_B1, P0_OFF_TWOUT = P0_OFF_TWIN + P0_TWIN, P0_OFF_TW1 = P0_OFF_TWOUT + P0_TWOUT,
              P0_OFF_TW2 = P0_OFF_TW1 + P0_TW1, P0_OFF_TC1K = P0_OFF_TW2 + P0_TW2, P0_OFF_TC1V = P0_OFF_TC1K + P0_TC1, P0_OFF_TC2K = P0_OFF_TC1V + P0_TC1,
              P0_OFF_TC2V = P0_OFF_TC2K + P0_TC2, P0_ITEMS = P0_OFF_TC2V + P0_TC2;

__device__ __forceinline__ void transpose_tile(const float* __restrict__ W, int K, int N, int Nout, h16* __restrict__ Wt, int item, LAS float* scr, int tid, bool bf = false) {
    const int nkt = K / 64; const int kt = item % nkt, ntl = item / nkt;
    { const int c4 = tid & 63, r = tid >> 6; f32x4 v[8];
#pragma unroll
      for (int i = 0; i < 8; ++i) { const int k = kt * 64 + r + 8 * i, n = ntl * 256 + 4 * c4;
          v[i] = (f32x4){0.f, 0.f, 0.f, 0.f}; if (n < N) v[i] = *(const f32x4*)(W + (size_t)k * N + n); }
#pragma unroll
      for (int i = 0; i < 8; ++i) *(LAS f32x4*)(scr + (r + 8 * i) * 260 + 4 * c4) = v[i]; }
    __syncthreads();
    { const int n = tid >> 1, hf = tid & 1;
      if (ntl * 256 + n < Nout) {
#pragma unroll
          for (int q = 0; q < 4; ++q) { float f[8];
#pragma unroll
              for (int j = 0; j < 8; ++j) f[j] = scr[(32 * hf + 8 * q + j) * 260 + n];
              u32x4 o;
              if (bf) { o.x = pg8::pk_bf2(f[0], f[1]); o.y = pg8::pk_bf2(f[2], f[3]); o.z = pg8::pk_bf2(f[4], f[5]); o.w = pg8::pk_bf2(f[6], f[7]); }
              else    { o.x = pg8::pk_h2(f[0], f[1]);  o.y = pg8::pk_h2(f[2], f[3]);  o.z = pg8::pk_h2(f[4], f[5]);  o.w = pg8::pk_h2(f[6], f[7]); }
              *(u32x4*)(Wt + (size_t)(ntl * 256 + n) * K + kt * 64 + 32 * hf + 8 * q) = o; } } }
    __syncthreads();
}

__device__ __forceinline__ void p0_prologue(const Ptrs& P, LAS unsigned char* lds, int G, int bid) {
    const int tid = threadIdx.x;
    LAS float* scr = (LAS float*)lds;
    unsigned char* ws = P.ws;
    for (int it = bid; it < P0_ITEMS; it += G) {
        if (it < P0_ADA) {
            LAS float* sc = scr;
            LAS float* red = scr + 8192;
            const float* c = P.in[1];
            for (int i = tid; i < 8192; i += NTHR) { const float v = c[i]; sc[i] = v / (1.f + __expf(-v)); }
            __syncthreads();
            const int cl = tid & 15, kg = tid >> 4;
            f32x4 a0 = {0, 0, 0, 0}, a1 = a0, a2 = a0, a3 = a0;
            const float* W = P.in[2] + 64 * it + 4 * cl;
#pragma unroll 4
            for (int k = kg; k < 2048; k += 32) { const f32x4 w = *(const f32x4*)(W + (size_t)k * 12288);
                a0 += sc[k] * w; a1 += sc[2048 + k] * w; a2 += sc[4096 + k] * w; a3 += sc[6144 + k] * w; }
#pragma unroll
            for (int j = 0; j < 4; ++j) { red[(kg * 4 + 0) * 64 + 4 * cl + j] = a0[j]; red[(kg * 4 + 1) * 64 + 4 * cl + j] = a1[j];
                red[(kg * 4 + 2) * 64 + 4 * cl + j] = a2[j]; red[(kg * 4 + 3) * 64 + 4 * cl + j] = a3[j]; }
            __syncthreads();
            if (tid < 256) { const int b = tid >> 6, col = tid & 63; float s = 0.f;
                for (int q = 0; q < 32; ++q) s += red[(q * 4 + b) * 64 + col];
                ((float*)(ws + WS_MOD))[b * 12288 + 64 * it + col] = s + P.in[3][64 * it + col]; }
            __syncthreads();
        } else if (it < P0_OFF_TWIN) {
            const int q = it - P0_OFF_B1, kv = q >> 5, part = q & 31;
            const float* pe = P.in[8 + kv]; const float* W1 = P.in[kv ? 12 : 10];
            const int col = tid & 255, kh = tid >> 8; float s = 0.f;
            for (int k = 128 * part + 64 * kh; k < 128 * part + 64 * kh + 64; ++k) s += pe[k] * W1[(size_t)k * 256 + col];
            scr[tid] = s; __syncthreads();
            if (tid < 256) ((float*)(ws + WS_B1P))[(kv * 32 + part) * 256 + tid] = scr[tid] + scr[tid + 256];
            __syncthreads();
        } else if (it < P0_OFF_TWOUT) transpose_tile(P.in[5], DM, DIN, DINP, (h16*)(ws + WS_WIN), it - P0_OFF_TWIN, scr, tid);
        else if (it < P0_OFF_TW1)     transpose_tile(P.in[16], DM, DM, DM, (h16*)(ws + WS_WOUT), it - P0_OFF_TWOUT, scr, tid, true);
        else if (it < P0_OFF_TW2)     transpose_tile(P.in[18], DM, DFF, DFF, (h16*)(ws + WS_W1), it - P0_OFF_TW1, scr, tid, true);
        else if (it < P0_OFF_TC1K)    transpose_tile(P.in[19], DFF, DM, DM, (h16*)(ws + WS_W2), it - P0_OFF_TW2, scr, tid, true);
        else if (it < P0_OFF_TC1V)    transpose_tile(P.in[10], 4096, 256, 256, (h16*)(ws + WS_CW1K), it - P0_OFF_TC1K, scr, tid);
        else if (it < P0_OFF_TC2K)    transpose_tile(P.in[12], 4096, 256, 256, (h16*)(ws + WS_CW1V), it - P0_OFF_TC1V, scr, tid);
        else if (it < P0_OFF_TC2V)    transpose_tile(P.in[11], 256, 128, 128, (h16*)(ws + WS_CW2K), it - P0_OFF_TC2K, scr, tid);
        else                          transpose_tile(P.in[13], 256, 128, 128, (h16*)(ws + WS_CW2V), it - P0_OFF_TC2V, scr, tid);
    }
}

template <bool BF> __device__ __forceinline__ void norm_mod_rows(const float* __restrict__ X, const float* __restrict__ gw, const float* __restrict__ mod, int sh_off, int sc_off,
                                              h16* __restrict__ H, int G, int bid) {
    const int lane = threadIdx.x & 63, wave = threadIdx.x >> 6;
    for (int r = bid * 8 + wave; r < NT; r += G * 8) {
        const int b = r >> 13; const float* xr = X + (size_t)r * DM; f32x4 v[8]; float ss = 0.f;
#pragma unroll
        for (int i = 0; i < 8; ++i) { v[i] = *(const f32x4*)(xr + 4 * (lane + 64 * i)); ss += v[i][0] * v[i][0] + v[i][1] * v[i][1] + v[i][2] * v[i][2] + v[i][3] * v[i][3]; }
        ss = wave_sum(ss); const float rstd = rsqrtf(ss * (1.f / DM) + EPS);
        const float* mb = mod + (size_t)b * 12288;
#pragma unroll
        for (int i = 0; i < 8; ++i) { const int c = 4 * (lane + 64 * i);
            const f32x4 g = *(const f32x4*)(gw + c), sh = *(const f32x4*)(mb + sh_off + c), sc = *(const f32x4*)(mb + sc_off + c);
            const f32x4 o = (v[i] * rstd) * g * (1.f + sc) + sh;
            u32x2 w; w.x = pg8::pk2<BF>(o[0], o[1]); w.y = pg8::pk2<BF>(o[2], o[3]);
            *(u32x2*)(H + (size_t)r * DM + c) = w; }
    }
}
__device__ __forceinline__ void final_norm_rows(float* __restrict__ X, const float* __restrict__ gw, int G, int bid) {
    const int lane = threadIdx.x & 63, wave = threadIdx.x >> 6;
    for (int r = bid * 8 + wave; r < NT; r += G * 8) {
        float* xr = X + (size_t)r * DM; f32x4 v[8]; float ss = 0.f;
#pragma unroll
        for (int i = 0; i < 8; ++i) { v[i] = *(const f32x4*)(xr + 4 * (lane + 64 * i)); ss += v[i][0] * v[i][0] + v[i][1] * v[i][1] + v[i][2] * v[i][2] + v[i][3] * v[i][3]; }
        ss = wave_sum(ss); const float rstd = rsqrtf(ss * (1.f / DM) + EPS);
#pragma unroll
        for (int i = 0; i < 8; ++i) { const int c = 4 * (lane + 64 * i); const f32x4 g = *(const f32x4*)(gw + c); *(f32x4*)(xr + c) = (v[i] * rstd) * g; }
    }
}

__device__ __forceinline__ void post_u_rows(const Ptrs& P, int G, int bid) {
    const int lane = threadIdx.x & 63, wave = threadIdx.x >> 6;
    h16* U = (h16*)(P.ws + WS_U); h16* MIX = (h16*)(P.ws + WS_H);
    const float* cw = P.in[6]; const float* cb = P.in[7]; const float* gcv = P.in[14];
    const int hsel = lane >> 3, c8 = lane & 7;
    float inv[8];
#pragma unroll
    for (int e = 0; e < 8; ++e) inv[e] = (float)exp2(-(double)(8 * c8 + e) * (13.287712379549449 / 64.0));
    for (int r = bid * 8 + wave; r < NT; r += G * 8) {
        const int pos = r & (SEQ - 1); h16* u = U + (size_t)r * DINP;
        float cs[8], sn[8];
#pragma unroll
        for (int e = 0; e < 8; ++e) { const float ang = (float)pos * inv[e];
            double rev = (double)ang * 0.15915494309189535; rev -= __builtin_rint(rev);
            const float rf = (float)rev; cs[e] = __builtin_amdgcn_cosf(rf); sn[e] = __builtin_amdgcn_sinf(rf); }
#pragma unroll
        for (int rd = 0; rd < 2; ++rd) {
            const int base = rd == 0 ? OFF_Q + 128 * hsel : (hsel < 2 ? OFF_KC + 128 * hsel : (hsel < 4 ? OFF_KS + 128 * (hsel - 2) : OFF_KW + 128 * (hsel - 4)));
            if (rd == 0 || hsel < 6) {
                const half8 x1 = *(const half8*)(u + base + 8 * c8), x2 = *(const half8*)(u + base + 64 + 8 * c8); half8 o1, o2;
#pragma unroll
                for (int e = 0; e < 8; ++e) { const float a = (float)x1[e], bq = (float)x2[e]; o1[e] = (h16)(a * cs[e] - bq * sn[e]); o2[e] = (h16)(bq * cs[e] + a * sn[e]); }
                *(half8*)(u + base + 8 * c8) = o1; *(half8*)(u + base + 64 + 8 * c8) = o2; }
        }
        float y[16]; float ss = 0.f;
#pragma unroll
        for (int hf = 0; hf < 2; ++hf) {
            const int ch = 512 * hf + 8 * lane;
            const half8 ub = *(const half8*)(u + OFF_UB + ch), c0 = *(const half8*)(u + OFF_UC + ch), h0 = *(const half8*)(u + OFF_UH + ch);
            half8 c1 = c0 * (h16)0, h1 = c1, c2 = c1, h2 = c1;
            if (pos >= 1) { c1 = *(const half8*)(u - DINP + OFF_UC + ch); h1 = *(const half8*)(u - DINP + OFF_UH + ch); }
            if (pos >= 2) { c2 = *(const half8*)(u - 2 * DINP + OFF_UC + ch); h2 = *(const half8*)(u - 2 * DINP + OFF_UH + ch); }
#pragma unroll
            for (int j = 0; j < 8; ++j) {
                const float v0 = (float)c0[j] * (float)h0[j], v1 = (float)c1[j] * (float)h1[j], v2 = (float)c2[j] * (float)h2[j];
                const float z = cb[ch + j] + cw[ch + j] * v2 + cw[1024 + ch + j] * v1 + cw[2048 + ch + j] * v0;
                const float yy = (float)ub[j] * z; y[8 * hf + j] = yy; ss += yy * yy; }
        }
        ss = wave_sum(ss); const float rstd = rsqrtf(ss * (1.f / 1024.f) + EPS);
#pragma unroll
        for (int hf = 0; hf < 2; ++hf) { const int ch = 512 * hf + 8 * lane; float f[8];
#pragma unroll
            for (int j = 0; j < 8; ++j) f[j] = y[8 * hf + j] * rstd * gcv[ch + j];
            u32x4 o; o.x = pg8::pk_bf2(f[0], f[1]); o.y = pg8::pk_bf2(f[2], f[3]); o.z = pg8::pk_bf2(f[4], f[5]); o.w = pg8::pk_bf2(f[6], f[7]);
            *(u32x4*)(MIX + (size_t)r * DM + ch) = o; }
    }
}

__device__ __forceinline__ float gelu_tanh(float x) {
    const float z = 0.7978845608028654f * (x + 0.044715f * x * x * x);
    const float e = __expf(2.f * z);
    const float th = 1.f - 2.f / (e + 1.f);
    return 0.5f * x * (1.f + th);
}
__device__ __forceinline__ void compress_phase(const Ptrs& P, LAS unsigned char* lds, int G, int bid) {
    const int tid = threadIdx.x, lane = tid & 63, w = tid >> 6, fr = lane & 15, fq = lane >> 4;
    const h16* U = (const h16*)(P.ws + WS_U);
    LAS h16* hid = (LAS h16*)lds;
    for (int unit = bid; unit < 256; unit += G) {
        const int kv = unit >> 7, bg = (unit >> 4) & 7, nb = unit & 15, b = bg >> 1, g = bg & 1, n0 = nb * 32;
        const h16* W1t = (const h16*)(P.ws + (kv ? WS_CW1V : WS_CW1K));
        const h16* W2t = (const h16*)(P.ws + (kv ? WS_CW2V : WS_CW2K));
        const float* b1p = (const float*)(P.ws + WS_B1P) + kv * 32 * 256;
        h16* OUT = (h16*)(P.ws + (kv ? WS_VCMP : WS_KCMP)) + (size_t)bg * 512 * 128;
        const int coff = (kv ? OFF_VC : OFF_KC) + g * 128;
        f32x4 acc[2][2];
#pragma unroll
        for (int i = 0; i < 2; ++i)
#pragma unroll
            for (int j = 0; j < 2; ++j) acc[i][j] = (f32x4){0.f, 0.f, 0.f, 0.f};
        half8 fa[2][4][2], fb[2][4][2];
        half8 zero8;
#pragma unroll
        for (int j = 0; j < 8; ++j) zero8[j] = (h16)0.f;
        const h16* arow[2]; bool aok0[2];
#pragma unroll
        for (int mt = 0; mt < 2; ++mt) arow[mt] = U + (size_t)(b * SEQ + 16 * (n0 + 16 * mt + fr)) * DINP + coff + 8 * fq;
        const h16* brow[2];
#pragma unroll
        for (int nt = 0; nt < 2; ++nt) brow[nt] = W1t + (size_t)(32 * w + 16 * nt + fr) * 4096 + 8 * fq;
        (void)aok0;
#define CP_LOAD(buf_, pos_) do { _Pragma("unroll") for (int ks = 0; ks < 4; ++ks) { \
            _Pragma("unroll") for (int mt = 0; mt < 2; ++mt) { const int tok = 16 * (n0 + 16 * mt + fr) + (pos_); \
                fa[buf_][ks][mt] = tok < SEQ ? *(const half8*)(arow[mt] + (size_t)(pos_) * DINP + 32 * ks) : zero8; } \
            _Pragma("unroll") for (int nt = 0; nt < 2; ++nt) fb[buf_][ks][nt] = *(const half8*)(brow[nt] + (pos_) * 128 + 32 * ks); } } while (0)
#define CP_MMA(buf_) do { _Pragma("unroll") for (int ks = 0; ks < 4; ++ks) _Pragma("unroll") for (int mt = 0; mt < 2; ++mt) _Pragma("unroll") for (int nt = 0; nt < 2; ++nt) \
            acc[mt][nt] = __builtin_amdgcn_mfma_f32_16x16x32_f16(fa[buf_][ks][mt], fb[buf_][ks][nt], acc[mt][nt], 0, 0, 0); } while (0)
        CP_LOAD(0, 0);
#pragma unroll 1
        for (int pos = 0; pos < 32; pos += 2) {
            CP_LOAD(1, pos + 1);
            CP_MMA(0);
            if (pos + 2 < 32) CP_LOAD(0, pos + 2);
            CP_MMA(1);
        }
#undef CP_LOAD
#undef CP_MMA
#pragma unroll
        for (int nt = 0; nt < 2; ++nt) { const int col = 32 * w + 16 * nt + fr; float bias = 0.f;
            for (int q = 0; q < 32; ++q) bias += b1p[q * 256 + col];
#pragma unroll
            for (int mt = 0; mt < 2; ++mt)
#pragma unroll
                for (int j = 0; j < 4; ++j) hid[(16 * mt + 4 * fq + j) * 264 + col] = (h16)gelu_tanh(acc[mt][nt][j] + bias); }
        __syncthreads();
        f32x4 acc2[2]; acc2[0] = (f32x4){0.f, 0.f, 0.f, 0.f}; acc2[1] = acc2[0];
#pragma unroll
        for (int ks = 0; ks < 8; ++ks) {
            const half8 bb = *(const half8*)(W2t + (size_t)(16 * w + fr) * 256 + 32 * ks + 8 * fq);
#pragma unroll
            for (int mt = 0; mt < 2; ++mt) { const half8 a = *(const LAS half8*)(hid + (16 * mt + fr) * 264 + 32 * ks + 8 * fq);
                acc2[mt] = __builtin_amdgcn_mfma_f32_16x16x32_f16(a, bb, acc2[mt], 0, 0, 0); }
        }
#pragma unroll
        for (int mt = 0; mt < 2; ++mt)
#pragma unroll
            for (int j = 0; j < 4; ++j) OUT[(size_t)(n0 + 16 * mt + 4 * fq + j) * 128 + 16 * w + fr] = (h16)acc2[mt][j];
        __syncthreads();
    }
}

__device__ __forceinline__ void dot4(const h16* __restrict__ kp, const LAS float* qf, float (&s)[4]) {
    s[0] = s[1] = s[2] = s[3] = 0.f;
#pragma unroll 4
    for (int c = 0; c < 16; ++c) { const half8 kk = *(const half8*)(kp + 8 * c);
#pragma unroll
        for (int j = 0; j < 8; ++j) { const float kf = (float)kk[j];
            s[0] += qf[8 * c + j] * kf; s[1] += qf[128 + 8 * c + j] * kf; s[2] += qf[256 + 8 * c + j] * kf; s[3] += qf[384 + 8 * c + j] * kf; } }
}
__device__ __forceinline__ void attn_simple(const Ptrs& P, LAS unsigned char* lds, int G, int bid) {
    const int lane = threadIdx.x & 63, wave = threadIdx.x >> 6;
    const h16* U = (const h16*)(P.ws + WS_U); float* Y = (float*)(P.ws + WS_YACC);
    LAS float* qf = (LAS float*)lds + wave * 1280;
    LAS float* pbar = qf + 512;
    LAS float* impv = pbar + 512;
    const float scale = 0.08838834764831845f;
    for (int wu = bid * 8 + wave; wu < NB * 2 * SEQ; wu += G * 8) {
        const int b = wu >> 14, g = (wu >> 13) & 1, t = wu & (SEQ - 1);
        const size_t row = (size_t)b * SEQ + t; const h16* urow = U + row * DINP;
#pragma unroll
        for (int hh = 0; hh < 4; ++hh) { const half2v q2 = *(const half2v*)(urow + OFF_Q + (4 * g + hh) * 128 + 2 * lane); qf[hh * 128 + 2 * lane] = (float)q2.x; qf[hh * 128 + 2 * lane + 1] = (float)q2.y; }
        float gt[4][3];
#pragma unroll
        for (int hh = 0; hh < 4; ++hh)
#pragma unroll
            for (int br = 0; br < 3; ++br) { const float x = (float)urow[OFF_GL + (4 * g + hh) * 3 + br]; gt[hh][br] = 1.f / (1.f + __expf(-x)); }
        f32x2 y[4];
#pragma unroll
        for (int hh = 0; hh < 4; ++hh) y[hh] = (f32x2){0.f, 0.f};
        const int nvalid = t >= 31 ? ((t - 31) >> 4) + 1 : 0;
        const h16* KC = (const h16*)(P.ws + WS_KCMP) + (size_t)(b * 2 + g) * 512 * 128;
        const h16* VC = (const h16*)(P.ws + WS_VCMP) + (size_t)(b * 2 + g) * 512 * 128;
        {
            float p[8][4];
#pragma unroll
            for (int c = 0; c < 8; ++c) { const int n = 64 * c + lane; float s[4] = {0.f, 0.f, 0.f, 0.f};
                if (64 * c < nvalid) dot4(KC + (size_t)n * 128, qf, s);
#pragma unroll
                for (int hh = 0; hh < 4; ++hh) p[c][hh] = n < nvalid ? s[hh] * scale : -3.0e38f; }
#pragma unroll
            for (int hh = 0; hh < 4; ++hh) { float m = -3.0e38f;
#pragma unroll
                for (int c = 0; c < 8; ++c) m = fmaxf(m, p[c][hh]);
                m = wave_max(m); float l = 0.f;
#pragma unroll
                for (int c = 0; c < 8; ++c) { const int n = 64 * c + lane; const float e = n < nvalid ? __expf(p[c][hh] - m) : 0.f; p[c][hh] = e; l += e; }
                l = wave_sum(l); const float il = l > 0.f ? 1.f / l : 0.f;
#pragma unroll
                for (int c = 0; c < 8; ++c) p[c][hh] *= il; }
#pragma unroll
            for (int c = 0; c < 8; ++c) pbar[64 * c + lane] = (p[c][0] + p[c][1]) + (p[c][2] + p[c][3]);
            f32x2 o[4];
#pragma unroll
            for (int hh = 0; hh < 4; ++hh) o[hh] = (f32x2){0.f, 0.f};
#pragma unroll
            for (int c = 0; c < 8; ++c) {
                if (64 * c < nvalid) { const int je = (nvalid - 64 * c) < 64 ? (nvalid - 64 * c) : 64;
                    for (int j = 0; j < je; ++j) { const half2v v2 = *(const half2v*)(VC + (size_t)(64 * c + j) * 128 + 2 * lane); const f32x2 vf = {(float)v2.x, (float)v2.y};
#pragma unroll
                        for (int hh = 0; hh < 4; ++hh) o[hh] += bcast_lane(p[c][hh], j) * vf; } } }
#pragma unroll
            for (int hh = 0; hh < 4; ++hh) y[hh] += gt[hh][0] * o[hh];
        }
        unsigned long long sel_lo, sel_hi;
        {
            const int cur = t >> 6;
            float sc2[2];
#pragma unroll
            for (int q = 0; q < 2; ++q) { const int j = lane + 64 * q; float im = 0.f;
#pragma unroll
                for (int d = -1; d <= 3; ++d) { const int n = 4 * j + d; if (n >= 0 && n < 512) im += pbar[n]; }
                const bool valid = 64 * j <= t; const bool forced = (j == 0) || (j == cur) || (j == cur - 1);
                sc2[q] = valid ? im + (forced ? 1.0e4f : 0.f) : -1.f; impv[j] = sc2[q]; }
            int rk0 = 0, rk1 = 0;
            for (int j = 0; j < 128; ++j) { const float v = impv[j];
                rk0 += (v > sc2[0] || (v == sc2[0] && j < lane)) ? 1 : 0;
                rk1 += (v > sc2[1] || (v == sc2[1] && j < lane + 64)) ? 1 : 0; }
            sel_lo = __ballot(rk0 < 16 && 64 * lane <= t);
            sel_hi = __ballot(rk1 < 16 && 64 * (lane + 64) <= t);
        }
#pragma unroll 1
        for (int br = 1; br < 3; ++br) {
            const h16* KB = U + (size_t)b * SEQ * DINP + (br == 1 ? OFF_KS : OFF_KW) + g * 128;
            const h16* VB = U + (size_t)b * SEQ * DINP + (br == 1 ? OFF_VS : OFF_VW) + g * 128;
            float m[4], l[4]; f32x2 o[4];
#pragma unroll
            for (int hh = 0; hh < 4; ++hh) { m[hh] = -1.0e30f; l[hh] = 0.f; o[hh] = (f32x2){0.f, 0.f}; }
            const int nchunk = br == 1 ? 128 : 8; const int wstart = t - 511;
#pragma unroll 1
            for (int ci = 0; ci < nchunk; ++ci) {
                int p0;
                if (br == 1) { const bool on = ci < 64 ? ((sel_lo >> ci) & 1ull) : ((sel_hi >> (ci - 64)) & 1ull); if (!on) continue; p0 = 64 * ci; }
                else { p0 = wstart + 64 * ci; if (p0 + 63 < 0) continue; }
                const int pos = p0 + lane; const bool valid = pos >= 0 && pos <= t;
                float s[4] = {0.f, 0.f, 0.f, 0.f};
                if (valid) dot4(KB + (size_t)pos * DINP, qf, s);
                float pr[4];
#pragma unroll
                for (int hh = 0; hh < 4; ++hh) { const float sv = valid ? s[hh] * scale : -3.0e38f; const float mb = wave_max(sv); const float mn = fmaxf(m[hh], mb);
                    const float al = __expf(m[hh] - mn); const float e = valid ? __expf(sv - mn) : 0.f; pr[hh] = e;
                    l[hh] = l[hh] * al + wave_sum(e); o[hh] *= al; m[hh] = mn; }
                const int j0 = p0 < 0 ? -p0 : 0; const int je = (t - p0) < 63 ? (t - p0) : 63;
                for (int j = j0; j <= je; ++j) { const half2v v2 = *(const half2v*)(VB + (size_t)(p0 + j) * DINP + 2 * lane); const f32x2 vf = {(float)v2.x, (float)v2.y};
#pragma unroll
                    for (int hh = 0; hh < 4; ++hh) o[hh] += bcast_lane(pr[hh], j) * vf; }
            }
#pragma unroll
            for (int hh = 0; hh < 4; ++hh) y[hh] += (gt[hh][br] / l[hh]) * o[hh];
        }
#pragma unroll
        for (int hh = 0; hh < 4; ++hh) *(f32x2*)(Y + row * 1024 + (4 * g + hh) * 128 + 2 * lane) = y[hh];
    }
}


typedef short s16x4 __attribute__((ext_vector_type(4)));
typedef short s16x8 __attribute__((ext_vector_type(8)));
template <bool a0, bool a1> __device__ __forceinline__ void af_qk(const LAS unsigned char* kbuf, const unsigned (&kl)[4], const half8 (&qf)[2][4], f32x4 (&s)[2][4]) {
    const LAS unsigned char* ka[4];
    { int _ln; asm volatile("v_mov_b32 %0, %1" : "=v"(_ln) : "v"(kl[0]));
      const int fr_ = _ln & 15, e_ = (_ln >> 4) ^ fr_;
#pragma unroll
      for (int ks = 0; ks < 4; ++ks) ka[ks] = kbuf + fr_ * 256 + ((e_ ^ (4 * ks)) << 4); }
    half8 kf[2][4];
#pragma unroll
    for (int ks = 0; ks < 4; ++ks) kf[0][ks] = *(const LAS half8*)(ka[ks]);
#pragma unroll
    for (int kt = 0; kt < 4; ++kt) {
        if (kt < 3) {
#pragma unroll
            for (int ks = 0; ks < 4; ++ks) kf[(kt + 1) & 1][ks] = *(const LAS half8*)(ka[ks] + (kt + 1) * 4096); }
        s[0][kt] = (f32x4){0.f, 0.f, 0.f, 0.f}; s[1][kt] = (f32x4){0.f, 0.f, 0.f, 0.f};
#pragma unroll
        for (int ks = 0; ks < 4; ++ks) {
            if (a0) s[0][kt] = __builtin_amdgcn_mfma_f32_16x16x32_f16(kf[kt & 1][ks], qf[0][ks], s[0][kt], 0, 0, 0);
            if (a1) s[1][kt] = __builtin_amdgcn_mfma_f32_16x16x32_f16(kf[kt & 1][ks], qf[1][ks], s[1][kt], 0, 0, 0); }
        __builtin_amdgcn_sched_barrier(0);
    }
}
template <bool a0, bool a1> __device__ __forceinline__ void af_pv(const LAS unsigned char* vbuf, unsigned vl0, int z, const half8 (&pf)[2][2], f32x4 (&o)[2][8]) {
    const unsigned rb = (unsigned)(__UINTPTR_TYPE__)(vbuf + vl0);
    s16x4 vr[2][8];
#define AF_VLOAD(buf_, dt_) asm volatile("ds_read_b64_tr_b16 %0, %8\n\tds_read_b64_tr_b16 %1, %8 offset:4096\n\tds_read_b64_tr_b16 %2, %8 offset:8192\n\tds_read_b64_tr_b16 %3, %8 offset:12288\n\t" \
        "ds_read_b64_tr_b16 %4, %9\n\tds_read_b64_tr_b16 %5, %9 offset:4096\n\tds_read_b64_tr_b16 %6, %9 offset:8192\n\tds_read_b64_tr_b16 %7, %9 offset:12288" \
        : "=&v"(vr[buf_][0]), "=&v"(vr[buf_][1]), "=&v"(vr[buf_][2]), "=&v"(vr[buf_][3]), "=&v"(vr[buf_][4]), "=&v"(vr[buf_][5]), "=&v"(vr[buf_][6]), "=&v"(vr[buf_][7]) \
        : "v"(rb + ((unsigned)((dt_) ^ z) << 5)), "v"(rb + ((unsigned)(((dt_) + 1) ^ z) << 5)) : "memory")
#define AF_VWAIT(buf_, n_) asm volatile("s_waitcnt lgkmcnt(" #n_ ")" : "+v"(vr[buf_][0]), "+v"(vr[buf_][1]), "+v"(vr[buf_][2]), "+v"(vr[buf_][3]), "+v"(vr[buf_][4]), "+v"(vr[buf_][5]), "+v"(vr[buf_][6]), "+v"(vr[buf_][7]) :: "memory")
#define AF_VMMA(buf_, dt0_) do { _Pragma("unroll") for (int dd = 0; dd < 2; ++dd) _Pragma("unroll") for (int kp = 0; kp < 2; ++kp) { \
            const s16x4 lo = vr[buf_][4 * dd + 2 * kp], hi = vr[buf_][4 * dd + 2 * kp + 1]; \
            s16x8 v8; v8[0] = lo[0]; v8[1] = lo[1]; v8[2] = lo[2]; v8[3] = lo[3]; v8[4] = hi[0]; v8[5] = hi[1]; v8[6] = hi[2]; v8[7] = hi[3]; \
            const half8 vf = __builtin_bit_cast(half8, v8); \
            if (a0) o[0][(dt0_) + dd] = __builtin_amdgcn_mfma_f32_16x16x32_f16(vf, pf[0][kp], o[0][(dt0_) + dd], 0, 0, 0); \
            if (a1) o[1][(dt0_) + dd] = __builtin_amdgcn_mfma_f32_16x16x32_f16(vf, pf[1][kp], o[1][(dt0_) + dd], 0, 0, 0); } \
        __builtin_amdgcn_sched_barrier(0); } while (0)
    AF_VLOAD(0, 0); AF_VLOAD(1, 2);
    AF_VWAIT(0, 8); AF_VMMA(0, 0); AF_VLOAD(0, 4);
    AF_VWAIT(1, 8); AF_VMMA(1, 2); AF_VLOAD(1, 6);
    AF_VWAIT(0, 8); AF_VMMA(0, 4);
    AF_VWAIT(1, 0); AF_VMMA(1, 6);
#undef AF_VMMA
#undef AF_VLOAD
#undef AF_VWAIT
}
__device__ __forceinline__ void af_maskraw(f32x4 (&s)[4], int mbase, int mstep, int fq, int hi, int lo) {
#pragma unroll
    for (int kt = 0; kt < 4; ++kt)
#pragma unroll
        for (int jj = 0; jj < 4; ++jj) { const int met = mbase + mstep * (16 * kt + 4 * fq + jj); s[kt][jj] = (met <= hi && met > lo) ? s[kt][jj] : -3.0e38f; }
}
__device__ __forceinline__ float af_colmax(const f32x4 (&s)[4]) {
    float v = -1.0e30f;
#pragma unroll
    for (int kt = 0; kt < 4; ++kt) v = fmaxf(v, fmaxf(fmaxf(s[kt][0], s[kt][1]), fmaxf(s[kt][2], s[kt][3])));
    v = fmaxf(v, __shfl_xor(v, 16)); v = fmaxf(v, __shfl_xor(v, 32)); return v;
}
__device__ __forceinline__ void af_pack(const f32x4 (&s)[4], half8 (&pf)[2]) {
#pragma unroll
    for (int kp = 0; kp < 2; ++kp) { half8 h;
#pragma unroll
        for (int jj = 0; jj < 4; ++jj) { h[jj] = (h16)s[2 * kp][jj]; h[4 + jj] = (h16)s[2 * kp + 1][jj]; }
        pf[kp] = h; }
}
__device__ __forceinline__ float af_rawmax(const f32x4 (&s)[4]) {
    float v = fmaxf(fmaxf(s[0][0], s[0][1]), fmaxf(s[0][2], s[0][3]));
#pragma unroll
    for (int kt = 1; kt < 4; ++kt) v = fmaxf(v, fmaxf(fmaxf(s[kt][0], s[kt][1]), fmaxf(s[kt][2], s[kt][3])));
    v = fmaxf(v, __shfl_xor(v, 16)); v = fmaxf(v, __shfl_xor(v, 32)); return v;
}
__device__ __forceinline__ void af_online_fast(f32x4 (&s)[4], bool colsel, float& m, float& l, f32x4 (&o)[8], half8 (&pf)[2], float SC) {
    float lm = fmaxf(fmaxf(s[0][0], s[0][1]), fmaxf(s[0][2], s[0][3]));
#pragma unroll
    for (int kt = 1; kt < 4; ++kt) lm = fmaxf(lm, fmaxf(fmaxf(s[kt][0], s[kt][1]), fmaxf(s[kt][2], s[kt][3])));
    if (__ballot(colsel && (lm * SC > m + 8.f)) != 0ull) {
        float v = lm; v = fmaxf(v, __shfl_xor(v, 16)); v = fmaxf(v, __shfl_xor(v, 32));
        const float mloc = colsel ? v * SC : -1.0e30f;
        const float mn = fmaxf(m, mloc); const float al = __builtin_amdgcn_exp2f(m - mn); m = mn;
        l *= al;
#pragma unroll
        for (int dt = 0; dt < 8; ++dt) o[dt] *= al;
    }
    const float bias = colsel ? -m : -1.0e30f; float ps = 0.f;
#pragma unroll
    for (int kt = 0; kt < 4; ++kt)
#pragma unroll
        for (int jj = 0; jj < 4; ++jj) { const float p = __builtin_amdgcn_exp2f(__builtin_fmaf(s[kt][jj], SC, bias)); s[kt][jj] = p; ps += p; }
    l += ps;
    af_pack(s, pf);
}
__device__ __forceinline__ float af_write(float* Y, size_t row, int colbase, const f32x4 (&o)[8], float sc, bool accumulate) {
    float ss = 0.f;
#pragma unroll
    for (int dt = 0; dt < 8; ++dt) { float* p = Y + row * 1024 + colbase + 16 * dt; f32x4 v = o[dt] * sc; if (accumulate) v += *(const f32x4*)p; *(f32x4*)p = v;
        ss += (v[0] * v[0] + v[1] * v[1]) + (v[2] * v[2] + v[3] * v[3]); }
    return ss;
}
__device__ __forceinline__ float af_sigmoid(float x) { return 1.f / (1.f + __expf(-x)); }

template <bool A0, bool A1>
__device__ __forceinline__ void af_tile_online(const LAS unsigned char* stage, const unsigned (&kl)[4], unsigned vl0, int vz, const half8 (&qf)[2][4], f32x4 (&s)[2][4],
                                               float (&m)[2], float (&l)[2], f32x4 (&o)[2][8], bool needmask, int mbase, int fq, const int (&hi)[2], const int (&lo)[2], float SC) {
    af_qk<A0, A1>(stage, kl, qf, s);
    half8 pf[2][2];
    if (A0) { if (needmask) af_maskraw(s[0], mbase, 1, fq, hi[0], lo[0]); af_online_fast(s[0], hi[0] >= 0, m[0], l[0], o[0], pf[0], SC); } else { pf[0][0] = qf[0][0]; pf[0][1] = qf[0][0]; }
    if (A1) { if (needmask) af_maskraw(s[1], mbase, 1, fq, hi[1], lo[1]); af_online_fast(s[1], hi[1] >= 0, m[1], l[1], o[1], pf[1], SC); } else { pf[1][0] = qf[1][0]; pf[1][1] = qf[1][0]; }
    af_pv<A0, A1>(stage + 16384, vl0, vz, pf, o);
}
#define AF_ISSUE(st_, kb_, vb_, gs_, r0_, needv_) do { int _ln; asm volatile("v_mov_b32 %0, %1" : "=v"(_ln) : "v"(lane)); \
      _Pragma("unroll") for (int _c = 0; _c < 2; ++_c) { const int _row = 8 * w + 4 * _c + (_ln >> 4); \
      const h16* _kp = (kb_) + (size_t)((r0_) + _row) * (gs_) + (((_ln & 15) ^ (_row & 15)) << 3); \
      __builtin_amdgcn_global_load_lds((const unsigned*)_kp, (LAS unsigned*)(lds + (st_) * 32768 + (2 * w + _c) * 1024), 16, 0, 0); \
      if (needv_) { const h16* _vp = (vb_) + (size_t)((r0_) + _row) * (gs_) + (((_ln & 15) ^ (2 * (_row & 7))) << 3); \
      __builtin_amdgcn_global_load_lds((const unsigned*)_vp, (LAS unsigned*)(lds + (st_) * 32768 + 16384 + (2 * w + _c) * 1024), 16, 0, 0); } } } while (0)
#define AF_WAITV(n) asm volatile("s_waitcnt vmcnt(" #n ")" ::: "memory")
#define AF_BAR() do { __builtin_amdgcn_s_barrier(); asm volatile("" ::: "memory"); } while (0)

__device__ __forceinline__ void attn_fast(const Ptrs& P, LAS unsigned char* lds, int G, int bid) {
    const int tid = threadIdx.x, lane = tid & 63, w = __builtin_amdgcn_readfirstlane(tid >> 6), fr = lane & 15, fq = lane >> 4, qi = fr >> 2, hh = fr & 3;
    LAS float* IMP = (LAS float*)(lds + 98304) + w * (8 * 132);
    LAS unsigned* SELM = (LAS unsigned*)(lds + 132096);
    const h16* U = (const h16*)(P.ws + WS_U); float* Y = (float*)(P.ws + WS_YACC);
    const float SC = 0.08838834764831845f * 1.4426950408889634f;
    const int NEGBIG = -(1 << 30);
    unsigned kl[4]; kl[0] = (unsigned)lane; kl[1] = kl[2] = kl[3] = 0u;
    const int vz = (4 * fq + (fr >> 2)) & 7;
    const unsigned vl0 = (unsigned)((4 * fq + (fr >> 2)) * 256 + 8 * (fr & 1) + 16 * ((fr >> 1) & 1));
    const int nunits = (512 + G - 1) / G;
#pragma unroll 1
    for (int ui = 0; ui < nunits; ++ui) {
        int b, qb;
        if (G == 256) { const int idx = (bid & 1) * 32 + (bid >> 3); b = (bid & 7) >> 1; qb = ui == 0 ? 127 - idx : idx; }
        else { const int u = ui * G + bid; if (u >= 512) break;
               b = u >> 7; qb = (((u & 1) ^ ((u >> 8) & 1)) != 0) ? 127 - ((u >> 1) & 63) : ((u >> 1) & 63); }
#pragma unroll 1
        for (int g = 0; g < 2; ++g) {
            const int bg = 2 * b + g;
            int tq[2]; tq[0] = 64 * qb + 8 * w + qi; tq[1] = tq[0] + 4;
            const h16* Ub = U + (size_t)b * SEQ * DINP;
            half8 qf[2][4];
#pragma unroll
            for (int ct = 0; ct < 2; ++ct)
#pragma unroll
                for (int ks = 0; ks < 4; ++ks) qf[ct][ks] = *(const half8*)(Ub + (size_t)tq[ct] * DINP + OFF_Q + (4 * g + hh) * 128 + 32 * ks + 8 * fq);
            for (int i = lane; i < 8 * 132; i += 64) IMP[i] = 0.f;
            f32x4 s[2][4];
            const h16* KC = (const h16*)(P.ws + WS_KCMP) + (size_t)bg * 512 * 128;
            const h16* VC = (const h16*)(P.ws + WS_VCMP) + (size_t)bg * 512 * 128;
            const int ntc = ((4 * qb + 2) >> 6) + 1;
            float m[2], l[2];
            m[0] = m[1] = -1.0e30f; l[0] = l[1] = 0.f;
            AF_ISSUE(0, KC, VC, 128, 0, false);
            if (ntc > 1) AF_ISSUE(1, KC, VC, 128, 64, false);
#pragma unroll 1
            for (int T = 0; T < ntc; ++T) {
                if (T + 1 < ntc) AF_WAITV(2); else AF_WAITV(0);
                AF_BAR();
                if (T + 2 < ntc) AF_ISSUE((T + 2) % 3, KC, VC, 128, 64 * (T + 2), false);
                af_qk<true, true>(lds + (T % 3) * 32768, kl, qf, s);
#pragma unroll
                for (int ct = 0; ct < 2; ++ct) {
                    if (1024 * T + 1039 > 64 * qb) af_maskraw(s[ct], 1024 * T + 31, 16, fq, tq[ct], NEGBIG);
                    const float mn = fmaxf(m[ct], af_rawmax(s[ct]) * SC); const float al = __builtin_amdgcn_exp2f(m[ct] - mn); m[ct] = mn; float ps = 0.f;
#pragma unroll
                    for (int kt = 0; kt < 4; ++kt)
#pragma unroll
                        for (int jj = 0; jj < 4; ++jj) ps += __builtin_amdgcn_exp2f(__builtin_fmaf(s[ct][kt][jj], SC, -mn));
                    l[ct] = l[ct] * al + ps; }
            }
            float il[2];
#pragma unroll
            for (int ct = 0; ct < 2; ++ct) { float lt = l[ct]; lt += __shfl_xor(lt, 16); lt += __shfl_xor(lt, 32); il[ct] = lt > 0.f ? 1.f / lt : 0.f; }
            f32x4 o[2][8];
#pragma unroll
            for (int ct = 0; ct < 2; ++ct)
#pragma unroll
                for (int dt = 0; dt < 8; ++dt) o[ct][dt] = (f32x4){0.f, 0.f, 0.f, 0.f};
            AF_BAR();
            AF_ISSUE(0, KC, VC, 128, 0, true);
            if (ntc > 1) AF_ISSUE(1, KC, VC, 128, 64, true);
#pragma unroll 1
            for (int T = 0; T < ntc; ++T) {
                if (T + 1 < ntc) AF_WAITV(4); else AF_WAITV(0);
                AF_BAR();
                if (T + 2 < ntc) AF_ISSUE((T + 2) % 3, KC, VC, 128, 64 * (T + 2), true);
                af_qk<true, true>(lds + (T % 3) * 32768, kl, qf, s);
                half8 pf[2][2];
#pragma unroll
                for (int ct = 0; ct < 2; ++ct) {
                    if (1024 * T + 1039 > 64 * qb) af_maskraw(s[ct], 1024 * T + 31, 16, fq, tq[ct], NEGBIG);
#pragma unroll
                    for (int kt = 0; kt < 4; ++kt) {
#pragma unroll
                        for (int jj = 0; jj < 4; ++jj) s[ct][kt][jj] = __builtin_amdgcn_exp2f(__builtin_fmaf(s[ct][kt][jj], SC, -m[ct])) * il[ct];
                        float s4 = (s[ct][kt][0] + s[ct][kt][1]) + (s[ct][kt][2] + s[ct][kt][3]), s3 = s[ct][kt][3];
                        s4 += __shfl_xor(s4, 1); s4 += __shfl_xor(s4, 2); s3 += __shfl_xor(s3, 1); s3 += __shfl_xor(s3, 2);
                        if (hh == 0) { LAS float* ip = IMP + (4 * ct + qi) * 132 + 16 * T + 4 * kt + fq;
                            __hip_atomic_fetch_add(ip, s4, __ATOMIC_RELAXED, __HIP_MEMORY_SCOPE_WORKGROUP);
                            __hip_atomic_fetch_add(ip + 1, s3, __ATOMIC_RELAXED, __HIP_MEMORY_SCOPE_WORKGROUP); }
                    }
                    af_pack(s[ct], pf[ct]); }
                af_pv<true, true>(lds + (T % 3) * 32768 + 16384, vl0, vz, pf, o);
            }
#pragma unroll
            for (int ct = 0; ct < 2; ++ct) { int _ln; asm volatile("v_mov_b32 %0, %1" : "=v"(_ln) : "v"(lane));
                const int fr_ = _ln & 15, fq_ = _ln >> 4, hh_ = fr_ & 3;
                const size_t row = (size_t)b * SEQ + 64 * qb + 8 * w + 4 * ct + (fr_ >> 2);
                const float g0 = af_sigmoid((float)U[row * DINP + OFF_GL + (4 * g + hh_) * 3 + 0]);
                af_write(Y, row, (4 * g + hh_) * 128 + 4 * fq_, o[ct], g0, false); }
            __syncthreads();
#pragma unroll 1
            for (int ql = 0; ql < 8; ++ql) {
                LAS float* rowp = IMP + ql * 132;
                float sc0, sc1;
                { const int j = lane; const bool valid = j <= qb, forced = (j == 0) || (j == qb) || (j == qb - 1); const float v = rowp[j]; sc0 = valid ? v + (forced ? 1.0e4f : 0.f) : -1.f; rowp[j] = sc0; }
                { const int j = lane + 64; const bool valid = j <= qb, forced = (j == 0) || (j == qb) || (j == qb - 1); const float v = rowp[j]; sc1 = valid ? v + (forced ? 1.0e4f : 0.f) : -1.f; rowp[j] = sc1; }
                int r0 = 0, r1 = 0;
                for (int j4 = 0; j4 <= qb; j4 += 4) { const f32x4 v4 = *(const LAS f32x4*)(rowp + j4);
#pragma unroll
                    for (int e = 0; e < 4; ++e) { const int j = j4 + e; const float v = v4[e];
                        r0 += (v > sc0 || (v == sc0 && j < lane)) ? 1 : 0; r1 += (v > sc1 || (v == sc1 && j < lane + 64)) ? 1 : 0; } }
                const unsigned long long blo = __ballot(r0 < 16 && lane <= qb), bhi = __ballot(r1 < 16 && lane + 64 <= qb);
                if (lane == 0) { LAS unsigned* sp = SELM + (8 * w + ql) * 4; sp[0] = (unsigned)blo; sp[1] = (unsigned)(blo >> 32); sp[2] = (unsigned)bhi; sp[3] = (unsigned)(bhi >> 32); }
            }
            __syncthreads();
#pragma unroll 1
            for (int br = 1; br < 3; ++br) {
                const h16* KB = Ub + (br == 1 ? OFF_KS : OFF_KW) + g * 128;
                const h16* VB = Ub + (br == 1 ? OFF_VS : OFF_VW) + g * 128;
                const int j_lo = br == 1 ? 0 : (qb >= 8 ? qb - 8 : 0);
                const int nt = qb - j_lo + 1;
                m[0] = m[1] = -1.0e30f; l[0] = l[1] = 0.f;
#pragma unroll
                for (int ct = 0; ct < 2; ++ct)
#pragma unroll
                    for (int dt = 0; dt < 8; ++dt) o[ct][dt] = (f32x4){0.f, 0.f, 0.f, 0.f};
                AF_ISSUE(0, KB, VB, DINP, 64 * j_lo, true);
                if (nt > 1) AF_ISSUE(1, KB, VB, DINP, 64 * (j_lo + 1), true);
                if (nt > 2) AF_ISSUE(2, KB, VB, DINP, 64 * (j_lo + 2), true);
#pragma unroll 1
                for (int i = 0; i < nt; ++i) {
                    const int j = j_lo + i;
                    if (i + 2 < nt) AF_WAITV(8); else if (i + 1 < nt) AF_WAITV(4); else AF_WAITV(0);
                    AF_BAR();
                    if (i + 3 < nt) AF_ISSUE((i + 3) & 3, KB, VB, DINP, 64 * (j + 3), true);
                    int hi[2], lo[2]; bool act[2];
                    const bool needmask = (j == qb) || (br == 2 && 64 * j <= 64 * qb + 63 - 512);
#pragma unroll
                    for (int ct = 0; ct < 2; ++ct) {
                        if (br == 1) { const unsigned wd = SELM[(8 * w + 4 * ct + qi) * 4 + (j >> 5)]; const bool bit = (wd >> (j & 31)) & 1u;
                            act[ct] = __ballot(bit) != 0ull; hi[ct] = bit ? tq[ct] : -1; lo[ct] = NEGBIG; }
                        else { act[ct] = true; hi[ct] = tq[ct]; lo[ct] = tq[ct] - 512; }
                    }
                    const LAS unsigned char* stg = lds + (i & 3) * 32768;
                    if (act[0] && act[1]) af_tile_online<true, true>(stg, kl, vl0, vz, qf, s, m, l, o, needmask, 64 * j, fq, hi, lo, SC);
                    else if (act[0])      af_tile_online<true, false>(stg, kl, vl0, vz, qf, s, m, l, o, needmask, 64 * j, fq, hi, lo, SC);
                    else if (act[1])      af_tile_online<false, true>(stg, kl, vl0, vz, qf, s, m, l, o, needmask, 64 * j, fq, hi, lo, SC);
                }
#pragma unroll
                for (int ct = 0; ct < 2; ++ct) { int _ln; asm volatile("v_mov_b32 %0, %1" : "=v"(_ln) : "v"(lane));
                    const int fr_ = _ln & 15, fq_ = _ln >> 4, hh_ = fr_ & 3;
                    const size_t row = (size_t)b * SEQ + 64 * qb + 8 * w + 4 * ct + (fr_ >> 2);
                    float lt = l[ct]; lt += __shfl_xor(lt, 16); lt += __shfl_xor(lt, 32);
                    const float gg = af_sigmoid((float)U[row * DINP + OFF_GL + (4 * g + hh_) * 3 + br]);
                    (void)af_write(Y, row, (4 * g + hh_) * 128 + 4 * fq_, o[ct], lt > 0.f ? gg / lt : 0.f, true); }
                AF_BAR();
            }
        }
        {
            h16* MIX = (h16*)(P.ws + WS_H); const float* gw = P.in[15];
            int _ln; asm volatile("v_mov_b32 %0, %1" : "=v"(_ln) : "v"(lane));
            const int fr_ = _ln & 15, fq_ = _ln >> 4, hh_ = fr_ & 3;
#pragma unroll 1
            for (int ct = 0; ct < 2; ++ct) {
                const size_t row = (size_t)b * SEQ + 64 * qb + 8 * w + 4 * ct + (fr_ >> 2);
                float sv = 0.f;
#pragma unroll 1
                for (int g2 = 0; g2 < 2; ++g2)
#pragma unroll
                    for (int dt = 0; dt < 8; ++dt) { const f32x4 v = *(const f32x4*)(Y + row * 1024 + (4 * g2 + hh_) * 128 + 16 * dt + 4 * fq_);
                        sv += (v[0] * v[0] + v[1] * v[1]) + (v[2] * v[2] + v[3] * v[3]); }
                sv += __shfl_xor(sv, 1); sv += __shfl_xor(sv, 2); sv += __shfl_xor(sv, 16); sv += __shfl_xor(sv, 32);
                const float rstd = rsqrtf(sv * (1.f / 1024.f) + EPS);
#pragma unroll 1
                for (int g2 = 0; g2 < 2; ++g2)
#pragma unroll
                    for (int dt = 0; dt < 8; ++dt) { const int ch = (4 * g2 + hh_) * 128 + 16 * dt + 4 * fq_;
                        const f32x4 v = *(const f32x4*)(Y + row * 1024 + ch); const f32x4 gv = *(const f32x4*)(gw + ch); const f32x4 ov = v * rstd * gv;
                        u32x2 wv; wv.x = pg8::pk_bf2(ov[0], ov[1]); wv.y = pg8::pk_bf2(ov[2], ov[3]);
                        *(u32x2*)(MIX + row * DM + 1024 + ch) = wv; }
            }
        }
    }
}

__device__ __forceinline__ void attn_norm_rows(const Ptrs& P, int G, int bid) {
    const int lane = threadIdx.x & 63, wave = threadIdx.x >> 6;
    const float* Y = (const float*)(P.ws + WS_YACC); h16* MIX = (h16*)(P.ws + WS_H); const float* gw = P.in[15];
    for (int r = bid * 8 + wave; r < NT; r += G * 8) {
        f32x4 v[4]; float ss = 0.f;
#pragma unroll
        for (int i = 0; i < 4; ++i) { v[i] = *(const f32x4*)(Y + (size_t)r * 1024 + 4 * (lane + 64 * i)); ss += v[i][0] * v[i][0] + v[i][1] * v[i][1] + v[i][2] * v[i][2] + v[i][3] * v[i][3]; }
        ss = wave_sum(ss); const float rstd = rsqrtf(ss * (1.f / 1024.f) + EPS);
#pragma unroll
        for (int i = 0; i < 4; ++i) { const int c = 4 * (lane + 64 * i); const f32x4 g = *(const f32x4*)(gw + c); const f32x4 o = v[i] * rstd * g;
            u32x2 w; w.x = pg8::pk_h2(o[0], o[1]); w.y = pg8::pk_h2(o[2], o[3]);
            *(u32x2*)(MIX + (size_t)r * DM + 1024 + c) = w; }
    }
}


#define XB_TMO      128
#define XB_XCNT(j)  (256  + 64 * (j))
#define XB_XSUB(j)  (1280 + 64 * (j))
#define XB_XGEN(j)  (2304 + 64 * (j))
#define XB_TOP      3328
#define XB_TOPGEN   3392
#define XCD_BAR_WORDS 3456
#define XB_SPIN_CAP (1u << 18)
__device__ __forceinline__ unsigned xb_ld(unsigned* p)              { return __hip_atomic_load(p, __ATOMIC_RELAXED, __HIP_MEMORY_SCOPE_AGENT); }
__device__ __forceinline__ unsigned xb_add(unsigned* p, unsigned v) { return __hip_atomic_fetch_add(p, v, __ATOMIC_RELAXED, __HIP_MEMORY_SCOPE_AGENT); }
__device__ __forceinline__ unsigned xb_xcc_id() { return (unsigned)__builtin_amdgcn_s_getreg((3 << 11) | 20) & 0xFu; }
#define XB_SPIN(cond, bar) do { unsigned _sp = 0; while (cond) { __builtin_amdgcn_s_sleep(1); \
    if ((++_sp & 255u) == 0u) { if (xb_ld(&(bar)[XB_TMO])) break; if (_sp > XB_SPIN_CAP) { atomicAdd(&(bar)[XB_TMO], 1u); break; } } } } while (0)
struct XcdBarrier { unsigned* bar; unsigned x; volatile LAS unsigned* st; };
__device__ __forceinline__ XcdBarrier xcd_barrier_post(unsigned* bar, volatile LAS unsigned* st) {
    XcdBarrier b; b.bar = bar; b.x = xb_xcc_id(); b.st = st;
    if (threadIdx.x == 0) (void)xb_add(&bar[XB_XCNT(b.x)], 1u);
    return b;
}
__device__ __forceinline__ void xcd_barrier_complete(unsigned* bar, unsigned x, unsigned& nloc, unsigned& nx) {
    const unsigned G = gridDim.x * gridDim.y * gridDim.z;
    unsigned sum, cnt, mine, sp = 0u;
    for (;;) {
        sum = 0u; cnt = 0u; mine = 0u;
#pragma unroll
        for (unsigned j = 0; j < 16; ++j) { const unsigned c = xb_ld(&bar[XB_XCNT(j)]); sum += c; cnt += (c > 0u) ? 1u : 0u; mine = (j == x) ? c : mine; }
        if (sum == G) break;
        __builtin_amdgcn_s_sleep(1);
        if ((++sp & 255u) == 0u) { if (xb_ld(&bar[XB_TMO])) break; if (sp > XB_SPIN_CAP) { atomicAdd(&bar[XB_TMO], 1u); break; } }
    }
    nloc = mine > 0u ? mine : 1u; nx = cnt > 0u ? cnt : 1u;
}
__device__ __forceinline__ void xcd_barrier(const XcdBarrier& b) {
    asm volatile("s_waitcnt vmcnt(0)" ::: "memory");
    __syncthreads();
    if (threadIdx.x == 0) {
        unsigned* bar = b.bar;
        __builtin_amdgcn_s_waitcnt(0);
        unsigned nloc = b.st[0], nx = b.st[1];
        if (nloc == 0u) { xcd_barrier_complete(bar, b.x, nloc, nx); b.st[0] = nloc; b.st[1] = nx; }
        const unsigned old = xb_add(&bar[XB_XSUB(b.x)], 1u);
        const unsigned gen = old / nloc;
        if (old + 1u == (gen + 1u) * nloc) {
            __builtin_amdgcn_fence(__ATOMIC_RELEASE, "agent");
            asm volatile("s_waitcnt vmcnt(0)" ::: "memory");
            const unsigned og = xb_add(&bar[XB_TOP], 1u);
            const unsigned tg = og / nx;
            if (og + 1u == (tg + 1u) * nx) xb_add(&bar[XB_TOPGEN], 1u);
            else XB_SPIN(xb_ld(&bar[XB_TOPGEN]) == tg, bar);
            __builtin_amdgcn_fence(__ATOMIC_ACQUIRE, "agent");
            xb_add(&bar[XB_XGEN(b.x)], 1u);
            asm volatile("s_waitcnt vmcnt(0)" ::: "memory");
        } else {
            XB_SPIN(xb_ld(&bar[XB_XGEN(b.x)]) == gen, bar);
            __builtin_amdgcn_fence(__ATOMIC_ACQUIRE, "agent");
            asm volatile("s_waitcnt vmcnt(0)" ::: "memory");
        }
    }
    __syncthreads();
}

constexpr int NPHASE = 12;
struct Args { Ptrs p; int ph_lo, ph_hi; };

__global__ void __launch_bounds__(NTHR, 2) mega(Args args) {
    extern __shared__ __attribute__((aligned(16))) unsigned char lds_raw[];
    LAS unsigned char* lds = (LAS unsigned char*)lds_raw;
    const Ptrs& P = args.p;
    const int G = gridDim.x, bid = blockIdx.x;
    unsigned char* ws = P.ws;
    const float* mod = (const float*)(ws + WS_MOD);
    const int lo = args.ph_lo, hi = args.ph_hi;
    volatile LAS unsigned* MISC = (volatile LAS unsigned*)(lds + LDS_BYTES - 64);
    if (threadIdx.x < 16) MISC[threadIdx.x] = 0u;
    __syncthreads();
    XcdBarrier xbar; xbar.bar = (unsigned*)(ws + WS_BAR); xbar.x = 0; xbar.st = MISC;
    if (hi - lo > 1) xbar = xcd_barrier_post((unsigned*)(ws + WS_BAR), MISC);
#define PHASE_BEGIN(n) if (lo <= (n) && (n) < hi) {
#define PHASE_END(n) if ((n) + 1 < hi) { if (G != 256) cg::this_grid().sync(); else xcd_barrier(xbar); } }
    PHASE_BEGIN(0) p0_prologue(P, lds, G, bid); PHASE_END(0)
    PHASE_BEGIN(1) norm_mod_rows<false>(P.in[0], P.in[4], mod, 0, 2048, (h16*)(ws + WS_H), G, bid); PHASE_END(1)
    PHASE_BEGIN(2) { pg8::Gemm g{(const h16*)(ws + WS_H), (const h16*)(ws + WS_WIN), NT, DINP, DM}; pg8::StaticOrder S; S.init(NT, DINP, G, bid);
                  pg8::EpiF16<0> E{(h16*)(ws + WS_U), DINP}; pg8::gemm_phase<false>(lds, g, S, E); } PHASE_END(2)
    PHASE_BEGIN(3) post_u_rows(P, G, bid); PHASE_END(3)
    PHASE_BEGIN(4) compress_phase(P, lds, G, bid); PHASE_END(4)
#if FAST_ATTN
    PHASE_BEGIN(5) attn_fast(P, lds, G, bid); PHASE_END(5)
#else
    PHASE_BEGIN(5) PHASE_END(5)
#endif
    PHASE_BEGIN(7) { pg8::Gemm g{(const h16*)(ws + WS_H), (const h16*)(ws + WS_WOUT), NT, DM, DM}; pg8::StaticOrder S; S.init(NT, DM, G, bid);
                  pg8::EpiRes E{P.in[0], P.out, mod + 2 * 2048, 12288}; pg8::gemm_phase<true>(lds, g, S, E); } PHASE_END(7)
    PHASE_BEGIN(8) norm_mod_rows<true>(P.out, P.in[17], mod, 3 * 2048, 4 * 2048, (h16*)(ws + WS_H), G, bid); PHASE_END(8)
    PHASE_BEGIN(9) { pg8::Gemm g{(const h16*)(ws + WS_H), (const h16*)(ws + WS_W1), NT, DFF, DM}; pg8::StaticOrder S; S.init(NT, DFF, G, bid);
                  pg8::EpiF16<1, true> E{(h16*)(ws + WS_HID), DFF}; pg8::gemm_phase<true>(lds, g, S, E); } PHASE_END(9)
    PHASE_BEGIN(10) { pg8::Gemm g{(const h16*)(ws + WS_HID), (const h16*)(ws + WS_W2), NT, DM, DFF}; pg8::StaticOrder S; S.init(NT, DM, G, bid);
                   pg8::EpiRes E{P.out, P.out, mod + 5 * 2048, 12288}; pg8::gemm_phase<true>(lds, g, S, E); } PHASE_END(10)
    PHASE_BEGIN(11) final_norm_rows(P.out, P.in[20], G, bid); PHASE_END(11)
}

__global__ void __launch_bounds__(NTHR, 2) attn_simple_kernel(Args args) {
    extern __shared__ __attribute__((aligned(16))) unsigned char lds_raw[];
    attn_simple(args.p, (LAS unsigned char*)lds_raw, gridDim.x, blockIdx.x);
}

extern "C" void kernel_launch(void* const* d_in, const int* in_sizes, int n_in, void* d_out, int out_size, void* d_ws, size_t ws_size, hipStream_t stream) {
    static int grid = 0;
    if (grid == 0) {
        if (n_in != 21 || out_size != NT * DM || ws_size < WS_END) { fprintf(stderr, "kernel_launch: unexpected shapes (n_in %d out %d ws %zu need %zu)\n", n_in, out_size, ws_size, (size_t)WS_END); grid = -1; return; }
        int dev = 0, cus = 0, per_cu = 0;
        hipGetDevice(&dev); hipDeviceGetAttribute(&cus, hipDeviceAttributeMultiprocessorCount, dev);
        if (hipFuncSetAttribute((const void*)mega, hipFuncAttributeMaxDynamicSharedMemorySize, LDS_BYTES) != hipSuccess) { fprintf(stderr, "kernel_launch: hipFuncSetAttribute failed\n"); grid = -1; return; }
        if (hipOccupancyMaxActiveBlocksPerMultiprocessor(&per_cu, (const void*)mega, NTHR, LDS_BYTES) != hipSuccess || per_cu < 1) { fprintf(stderr, "kernel_launch: occupancy query says %d\n", per_cu); per_cu = 1; }
        (void)hipGetLastError();
        grid = cus * 1;
        fprintf(stderr, "kernel_launch: cus %d per_cu %d grid %d\n", cus, per_cu, grid);
    }
    if (grid < 0) return;
    if (hipMemsetAsync((char*)d_ws + WS_BAR, 0, WS_BAR_BYTES, stream) != hipSuccess) { fprintf(stderr, "kernel_launch: memset failed\n"); return; }
    Args a{};
    for (int i = 0; i < 21; ++i) a.p.in[i] = (const float*)d_in[i];
    a.p.out = (float*)d_out; a.p.ws = (unsigned char*)d_ws;
#if ONE_LAUNCH == 1
    a.ph_lo = 0; a.ph_hi = NPHASE;
    void* kargs[] = {&a};
    hipError_t e = hipLaunchCooperativeKernel((const void*)mega, dim3(grid), dim3(NTHR), kargs, LDS_BYTES, stream);
    if (e != hipSuccess) fprintf(stderr, "cooperative launch failed: %s (grid %d)\n", hipGetErrorString(e), grid);
#elif ONE_LAUNCH == 3
    {
        void* kargs[] = {&a};
        a.ph_lo = 0; a.ph_hi = 5;
        hipError_t e = hipLaunchCooperativeKernel((const void*)mega, dim3(grid), dim3(NTHR), kargs, LDS_BYTES, stream);
        if (e != hipSuccess) fprintf(stderr, "cooperative launch A failed: %s (grid %d)\n", hipGetErrorString(e), grid);
        hipLaunchKernelGGL(attn_simple_kernel, dim3(grid * 4), dim3(NTHR), 48 * 1024, stream, a);
        a.ph_lo = 6; a.ph_hi = NPHASE;
        e = hipLaunchCooperativeKernel((const void*)mega, dim3(grid), dim3(NTHR), kargs, LDS_BYTES, stream);
        if (e != hipSuccess) fprintf(stderr, "cooperative launch B failed: %s (grid %d)\n", hipGetErrorString(e), grid);
    }
#else
    for (int ph = 0; ph < NPHASE; ++ph) {
        a.ph_lo = ph; a.ph_hi = ph + 1;
        if (ph == 5) hipLaunchKernelGGL(attn_simple_kernel, dim3(grid * 4), dim3(NTHR), 48 * 1024, stream, a);
        else hipLaunchKernelGGL(mega, dim3(grid), dim3(NTHR), LDS_BYTES, stream, a);
    }
#endif
}
```

```cpp
#include <hip/hip_runtime.h>
#include <hip/hip_cooperative_groups.h>
#include <cstdint>
#include <cstdio>
namespace cg = cooperative_groups;


#define LAS __attribute__((address_space(3)))
typedef _Float16 h16;
typedef _Float16 half8 __attribute__((ext_vector_type(8)));
typedef _Float16 half4 __attribute__((ext_vector_type(4)));
typedef _Float16 half2v __attribute__((ext_vector_type(2)));
typedef float f32x4 __attribute__((ext_vector_type(4)));
typedef float f32x2 __attribute__((ext_vector_type(2)));
typedef unsigned u32x4 __attribute__((ext_vector_type(4)));
typedef unsigned u32x2 __attribute__((ext_vector_type(2)));

constexpr int NB = 4, SEQ = 8192, NT = NB * SEQ, DM = 2048, DIN = 5656, DINP = 5888, DFF = 8192;
constexpr int OFF_UB = 0, OFF_UC = 1024, OFF_UH = 2048, OFF_Q = 3072, OFF_KC = 4096, OFF_VC = 4352, OFF_KS = 4608, OFF_VS = 4864,
              OFF_KW = 5120, OFF_VW = 5376, OFF_GL = 5632;
constexpr float EPS = 1e-6f;
constexpr int NTHR = 512;
constexpr int LDS_BYTES = 136 * 1024;

constexpr size_t WS_BAR   = 0;
constexpr size_t WS_BAR_BYTES = 16384;
constexpr size_t WS_MOD   = 16384;
constexpr size_t WS_B1P   = WS_MOD + (size_t)4 * 12288 * 4;
constexpr size_t WS_WIN   = WS_B1P + (size_t)2 * 32 * 256 * 4;
constexpr size_t WS_WOUT  = WS_WIN + (size_t)DINP * DM * 2;
constexpr size_t WS_W1    = WS_WOUT + (size_t)DM * DM * 2;
constexpr size_t WS_W2    = WS_W1 + (size_t)DFF * DM * 2;
constexpr size_t WS_CW1K  = WS_W2 + (size_t)DFF * DM * 2;
constexpr size_t WS_CW1V  = WS_CW1K + (size_t)256 * 4096 * 2;
constexpr size_t WS_CW2K  = WS_CW1V + (size_t)256 * 4096 * 2;
constexpr size_t WS_CW2V  = WS_CW2K + (size_t)128 * 256 * 2;
constexpr size_t WS_KCMP  = WS_CW2V + (size_t)128 * 256 * 2;
constexpr size_t WS_VCMP  = WS_KCMP + (size_t)8 * 512 * 128 * 2;
constexpr size_t WS_H     = WS_VCMP + (size_t)8 * 512 * 128 * 2;
constexpr size_t WS_BIG   = WS_H + (size_t)NT * DM * 2;
constexpr size_t WS_U     = WS_BIG;
constexpr size_t WS_YACC  = WS_U + (size_t)NT * DINP * 2;
constexpr size_t WS_HID   = WS_BIG;
constexpr size_t WS_END   = WS_BIG + (size_t)NT * DFF * 2;
static_assert(WS_YACC + (size_t)NT * 1024 * 4 <= WS_END, "ws map");
static_assert(WS_END <= (size_t)1073741824, "ws map fits 4x largest tensor");
static_assert(WS_WIN % 256 == 0 && WS_H % 256 == 0 && WS_BIG % 256 == 0 && WS_YACC % 256 == 0, "alignment");

namespace pg8 {
constexpr int BM = 256, BK = 64, HALF = 128, HTB = HALF * BK * 2, STAGE_BYTES = 8 * HTB, NXCD = 8, WGM = 8;
__host__ __device__ __forceinline__ int lds_byte(int r, int c) { const int st = (r >> 4) * 2 + (c >> 5), rr = r & 15, cc = c & 31, ob = rr * 64 + cc * 2; return st * 1024 + (ob ^ (((ob >> 9) & 1) << 5)); }
__host__ __device__ __forceinline__ void stage_rc(int b, int& R, int& C) { const int st = b / 1024, sb = b % 1024, swz = sb ^ (((sb >> 9) & 1) << 5); R = (st >> 1) * 16 + swz / 64; C = (st & 1) * 32 + (swz % 64) / 2; }
__host__ __device__ __forceinline__ int perm32(int rho) { const int n = rho >> 4, i = rho & 15; return 8 * (i >> 2) + 4 * n + (i & 3); }

struct Unit { int pm, pn; };
struct Gemm { const h16* A; const h16* Bt; int M, N, K; };

struct StaticOrder {
    int nM, nN, nwg, G, c;
    __host__ __device__ void init(int M, int N, int G_, int c_) { nM = M / BM; nN = N / BM; nwg = nM * nN; G = G_; c = c_; }
    __host__ __device__ bool next(int i, Unit& u) const {
        const long L = (long)i * G + c; if (L >= nwg) return false;
        int wgid = (int)L; { const int q = nwg / NXCD, r = nwg % NXCD, xcd = wgid % NXCD, off = wgid / NXCD; wgid = (xcd < r ? xcd * (q + 1) : r * (q + 1) + (xcd - r) * q) + off; }
        const int nig = WGM * nN, gid = wgid / nig, fm = gid * WGM, gsz = (nM - fm) < WGM ? (nM - fm) : WGM;
        u.pm = fm + ((wgid % nig) % gsz); u.pn = (wgid % nig) / gsz; return true;
    }
    __device__ __forceinline__ void a_ready(const Unit&) const {}
    __device__ __forceinline__ void done(const Unit&) const {}
};

__device__ __forceinline__ unsigned pk_h2(float lo, float hi) { half2v v; v.x = (h16)lo; v.y = (h16)hi; return __builtin_bit_cast(unsigned, v); }
__device__ __forceinline__ unsigned pk_bf2(float lo, float hi) { unsigned r; asm("v_cvt_pk_bf16_f32 %0, %1, %2" : "=v"(r) : "v"(lo), "v"(hi)); return r; }
template <bool BF> __device__ __forceinline__ unsigned pk2(float lo, float hi) { return BF ? pk_bf2(lo, hi) : pk_h2(lo, hi); }
typedef short bfx8 __attribute__((ext_vector_type(8)));

template <int ACT, bool BF = false> struct EpiF16 {
    static constexpr bool PERM = true, AFTER_DRAIN = false;
    h16* O; int ldc;
    __device__ __forceinline__ void operator()(const f32x4 (&acc)[2][2][4][2], const Unit& u, int wr, int wc, int fr, int fq) const {
        const int row0 = u.pm * BM + wr * 64 + fr; const int col0 = u.pn * BM + wc * 32 + 8 * fq;
#pragma unroll
        for (int ai = 0; ai < 2; ++ai)
#pragma unroll
            for (int m = 0; m < 4; ++m) { h16* rowp = O + (size_t)(row0 + ai * HALF + m * 16) * ldc + col0;
#pragma unroll
                for (int bj = 0; bj < 2; ++bj) { f32x4 v0 = acc[ai][bj][m][0], v1 = acc[ai][bj][m][1];
                    if (ACT == 1) {
#pragma unroll
                        for (int j = 0; j < 4; ++j) { const float a = fmaxf(v0[j], 0.f), b = fmaxf(v1[j], 0.f); v0[j] = a * a; v1[j] = b * b; } }
                    u32x4 w; w.x = pk2<BF>(v0[0], v0[1]); w.y = pk2<BF>(v0[2], v0[3]); w.z = pk2<BF>(v1[0], v1[1]); w.w = pk2<BF>(v1[2], v1[3]);
                    *(u32x4*)(rowp + bj * HALF) = w; } }
    }
};
struct EpiRes {
    static constexpr bool PERM = false, AFTER_DRAIN = false;
    const float* base; float* out; const float* gate; int gate_ld;
    __device__ __forceinline__ void operator()(const f32x4 (&acc)[2][2][4][2], const Unit& u, int wr, int wc, int fr, int fq) const {
        const int row0 = u.pm * BM + wr * 64 + fr, col0 = u.pn * BM + wc * 32 + 4 * fq; const int b = (u.pm * BM) / SEQ;
        f32x4 gv[2][2];
#pragma unroll
        for (int bj = 0; bj < 2; ++bj)
#pragma unroll
            for (int n = 0; n < 2; ++n) gv[bj][n] = *(const f32x4*)(gate + (size_t)b * gate_ld + col0 + bj * HALF + n * 16);
#pragma unroll
        for (int ai = 0; ai < 2; ++ai)
#pragma unroll
            for (int m = 0; m < 4; ++m) { const size_t ro = (size_t)(row0 + ai * HALF + m * 16) * DM + col0;
#pragma unroll
                for (int bj = 0; bj < 2; ++bj)
#pragma unroll
                    for (int n = 0; n < 2; ++n) { const f32x4 bv = *(const f32x4*)(base + ro + bj * HALF + n * 16);
                        *(f32x4*)(out + ro + bj * HALF + n * 16) = bv + gv[bj][n] * acc[ai][bj][m][n]; } }
    }
};

template <bool BF16, class Epi, class Sched, bool ALIGN_EPI = true, bool SP2 = true>
__device__ __forceinline__ void gemm_phase(LAS unsigned char* lds, const Gemm g, const Sched& S, const Epi& E) {
    const int tid = threadIdx.x, wid = __builtin_amdgcn_readfirstlane(tid >> 6), lane = tid & 63, wr = wid >> 2, wc = wid & 3, fr = lane & 15, fq = lane >> 4;
    const int K = g.K, nt = K / BK;
    unsigned voffA[2], voffB[2];
#pragma unroll
    for (int i = 0; i < 2; ++i) { int R, C; stage_rc(tid * 16 + i * 8192, R, C); const int Rb = Epi::PERM ? ((R & ~31) + perm32(R & 31)) : R;
        voffA[i] = (unsigned)(R * K + C) * 2u; voffB[i] = (unsigned)(Rb * K + C) * 2u; }
    const size_t kstep = (size_t)(BK * 2);
    const size_t hstep = (size_t)HALF * K * 2;
    const size_t tstep = 2 * hstep;
    const unsigned ldsw = (unsigned)wid * 1024u;
    const int aoff = lds_byte(wr * 64 + fr, fq * 8), boff = lds_byte(wc * 32 + fr, fq * 8);
#define PG8_SA(b, h) (((b) * 2 + (h)) * HTB)
#define PG8_SB(b, h) ((4 + (b) * 2 + (h)) * HTB)
#define PG8_STAGE(bufoff, gbase, voff) do { _Pragma("unroll") for (int _i = 0; _i < 2; ++_i) \
        __builtin_amdgcn_global_load_lds((const unsigned*)((const char*)(gbase) + (voff)[_i]), (LAS unsigned*)(lds + (bufoff) + ldsw + _i * 8192), 16, 0, 0); } while (0)
#define PG8_LDA(dst, b, h) do { _Pragma("unroll") for (int m = 0; m < 4; ++m) _Pragma("unroll") for (int k = 0; k < 2; ++k) dst[m][k] = *(const LAS half8*)(lds + PG8_SA(b, h) + aoff + m * 2048 + k * 1024); } while (0)
#define PG8_LDB(dst, b, h) do { _Pragma("unroll") for (int n = 0; n < 2; ++n) _Pragma("unroll") for (int k = 0; k < 2; ++k) dst[n][k] = *(const LAS half8*)(lds + PG8_SB(b, h) + boff + n * 2048 + k * 1024); } while (0)
#define PG8_MMA(ai, bj, At, Bt) do { __builtin_amdgcn_s_setprio(1); _Pragma("unroll") for (int m = 0; m < 4; ++m) _Pragma("unroll") for (int n = 0; n < 2; ++n) _Pragma("unroll") for (int k = 0; k < 2; ++k) \
        acc[ai][bj][m][n] = BF16 ? __builtin_amdgcn_mfma_f32_16x16x32_bf16(__builtin_bit_cast(bfx8, Bt[n][k]), __builtin_bit_cast(bfx8, At[m][k]), acc[ai][bj][m][n], 0, 0, 0) \
                                 : __builtin_amdgcn_mfma_f32_16x16x32_f16(Bt[n][k], At[m][k], acc[ai][bj][m][n], 0, 0, 0); __builtin_amdgcn_s_setprio(0); } while (0)
#define PG8_WAIT_V(n) asm volatile("s_waitcnt vmcnt(" #n ")" ::: "memory")
#define PG8_WAIT_L(n) asm volatile("s_waitcnt lgkmcnt(" #n ")" ::: "memory")
#define PG8_BAR __builtin_amdgcn_s_barrier()
#define PG8_SCHED __builtin_amdgcn_sched_barrier(0)
    Unit cur, nxt; int ui = 0;
    if (!S.next(0, cur)) return;
    f32x4 acc[2][2][4][2];
#pragma unroll
    for (int a = 0; a < 2; ++a)
#pragma unroll
        for (int b = 0; b < 2; ++b)
#pragma unroll
            for (int m = 0; m < 4; ++m)
#pragma unroll
                for (int n = 0; n < 2; ++n) acc[a][b][m][n] = (f32x4){0.f, 0.f, 0.f, 0.f};
    half8 At[4][2], B0[2][2], B1[2][2];
    const char* cA = (const char*)g.A + (size_t)cur.pm * tstep; const char* cB = (const char*)g.Bt + (size_t)cur.pn * tstep;
    S.a_ready(cur);
    if constexpr (SP2) {
        PG8_STAGE(PG8_SB(0, 0), cB, voffB); PG8_STAGE(PG8_SB(0, 1), cB + hstep, voffB); PG8_STAGE(PG8_SA(0, 0), cA, voffA); PG8_STAGE(PG8_SA(0, 1), cA + hstep, voffA);
        if (wr == 1) PG8_BAR;
        PG8_WAIT_V(2); PG8_BAR;
        PG8_STAGE(PG8_SB(1, 0), cB + kstep, voffB); PG8_STAGE(PG8_SA(1, 0), cA + kstep, voffA); PG8_STAGE(PG8_SB(1, 1), cB + hstep + kstep, voffB);
        PG8_WAIT_V(6); PG8_BAR;
    } else {
        PG8_STAGE(PG8_SB(0, 0), cB, voffB); PG8_STAGE(PG8_SA(0, 0), cA, voffA); PG8_STAGE(PG8_SB(0, 1), cB + hstep, voffB); PG8_STAGE(PG8_SA(0, 1), cA + hstep, voffA);
        if (wr == 1) PG8_BAR;
        PG8_WAIT_V(4); PG8_BAR;
        PG8_STAGE(PG8_SB(1, 0), cB + kstep, voffB); PG8_STAGE(PG8_SA(1, 0), cA + kstep, voffA); PG8_STAGE(PG8_SB(1, 1), cB + hstep + kstep, voffB);
        PG8_WAIT_V(6); PG8_BAR;
    }
    for (;;) {
        const bool has_next = S.next(ui + 1, nxt);
        const char* nA = has_next ? (const char*)g.A + (size_t)nxt.pm * tstep : cA; const char* nB = has_next ? (const char*)g.Bt + (size_t)nxt.pn * tstep : cB;
        for (int t = 0; t < nt; t += 2) {
            const bool last = (t == nt - 2);
            const char* a1 = cA + (size_t)(t + 1) * kstep;
            const char* a2 = last ? nA : cA + (size_t)(t + 2) * kstep; const char* b2 = last ? nB : cB + (size_t)(t + 2) * kstep;
            const char* a3 = a2 + kstep; const char* b3 = b2 + kstep;
            if (last && has_next) S.a_ready(nxt);
            if constexpr (SP2) {
            PG8_LDB(B0, 0, 0); PG8_LDB(B1, 0, 1); PG8_SCHED; PG8_LDA(At, 0, 0); PG8_STAGE(PG8_SA(1, 1), a1 + hstep, voffA);
            PG8_WAIT_V(8); PG8_WAIT_L(0); PG8_BAR; PG8_MMA(0, 0, At, B0); PG8_MMA(0, 1, At, B1); PG8_BAR; PG8_SCHED;
            PG8_LDA(At, 0, 1); PG8_STAGE(PG8_SB(0, 0), b2, voffB); PG8_STAGE(PG8_SB(0, 1), b2 + hstep, voffB); PG8_STAGE(PG8_SA(0, 0), a2, voffA);
            PG8_WAIT_V(8); PG8_WAIT_L(0); PG8_BAR; PG8_MMA(1, 0, At, B0); PG8_MMA(1, 1, At, B1); PG8_BAR; PG8_SCHED;
            PG8_LDB(B0, 1, 0); PG8_LDB(B1, 1, 1); PG8_SCHED; PG8_LDA(At, 1, 0); PG8_STAGE(PG8_SA(0, 1), a2 + hstep, voffA);
            PG8_WAIT_V(8); PG8_WAIT_L(0); PG8_BAR; PG8_MMA(0, 0, At, B0); PG8_MMA(0, 1, At, B1); PG8_BAR; PG8_SCHED;
            PG8_LDA(At, 1, 1); PG8_STAGE(PG8_SB(1, 0), b3, voffB); PG8_STAGE(PG8_SB(1, 1), b3 + hstep, voffB); PG8_STAGE(PG8_SA(1, 0), a3, voffA);
            PG8_WAIT_V(8); PG8_WAIT_L(0); PG8_BAR; PG8_MMA(1, 0, At, B0); PG8_MMA(1, 1, At, B1); PG8_BAR; PG8_SCHED;
            } else {
            PG8_LDB(B0, 0, 0); PG8_SCHED; PG8_LDA(At, 0, 0); PG8_STAGE(PG8_SA(1, 1), a1 + hstep, voffA);
            PG8_WAIT_L(8); PG8_BAR; PG8_WAIT_L(0); PG8_MMA(0, 0, At, B0); PG8_BAR; PG8_SCHED;
            PG8_LDB(B1, 0, 1); PG8_STAGE(PG8_SB(0, 0), b2, voffB);
            PG8_BAR; PG8_WAIT_L(0); PG8_MMA(0, 1, At, B1); PG8_BAR;
            PG8_LDA(At, 0, 1); PG8_STAGE(PG8_SA(0, 0), a2, voffA);
            PG8_BAR; PG8_WAIT_L(0); PG8_MMA(1, 0, At, B0); PG8_BAR; PG8_SCHED;
            PG8_STAGE(PG8_SB(0, 1), b2 + hstep, voffB);
            PG8_WAIT_V(6); PG8_BAR; PG8_MMA(1, 1, At, B1); PG8_BAR;
            PG8_LDB(B0, 1, 0); PG8_SCHED; PG8_LDA(At, 1, 0); PG8_STAGE(PG8_SA(0, 1), a2 + hstep, voffA);
            PG8_WAIT_L(8); PG8_BAR; PG8_WAIT_L(0); PG8_MMA(0, 0, At, B0); PG8_BAR; PG8_SCHED;
            PG8_LDB(B1, 1, 1); PG8_STAGE(PG8_SB(1, 0), b3, voffB);
            PG8_BAR; PG8_WAIT_L(0); PG8_MMA(0, 1, At, B1); PG8_BAR;
            PG8_LDA(At, 1, 1); PG8_STAGE(PG8_SA(1, 0), a3, voffA);
            PG8_BAR; PG8_WAIT_L(0); PG8_MMA(1, 0, At, B0); PG8_BAR; PG8_SCHED;
            PG8_STAGE(PG8_SB(1, 1), b3 + hstep, voffB);
            PG8_WAIT_V(6); PG8_BAR; PG8_MMA(1, 1, At, B1); PG8_BAR;
            }
        }
        if constexpr (ALIGN_EPI) { if (wr == 0) PG8_BAR; }
        E(acc, cur, wr, wc, fr, fq); S.done(cur);
        if (!has_next) break;
#pragma unroll
        for (int a = 0; a < 2; ++a)
#pragma unroll
            for (int b = 0; b < 2; ++b)
#pragma unroll
                for (int m = 0; m < 4; ++m)
#pragma unroll
                    for (int n = 0; n < 2; ++n) acc[a][b][m][n] = (f32x4){0.f, 0.f, 0.f, 0.f};
        cur = nxt; cA = nA; cB = nB; ++ui;
        if constexpr (ALIGN_EPI) { if (wr == 1) PG8_BAR; }
    }
    PG8_WAIT_V(0);
    if constexpr (!ALIGN_EPI) { if (wr == 0) PG8_BAR; }
    PG8_BAR;
#undef PG8_SA
#undef PG8_SB
#undef PG8_STAGE
#undef PG8_LDA
#undef PG8_LDB
#undef PG8_MMA
#undef PG8_WAIT_V
#undef PG8_WAIT_L
#undef PG8_BAR
#undef PG8_SCHED
}
}

__device__ __forceinline__ float wave_sum(float v) {
#pragma unroll
    for (int o = 1; o < 64; o <<= 1) v += __shfl_xor(v, o);
    return v;
}
__device__ __forceinline__ float wave_max(float v) {
#pragma unroll
    for (int o = 1; o < 64; o <<= 1) v = fmaxf(v, __shfl_xor(v, o));
    return v;
}
__device__ __forceinline__ float bcast_lane(float v, int j) { return __builtin_bit_cast(float, __builtin_amdgcn_readlane(__builtin_bit_cast(int, v), j)); }

struct Ptrs {
    const float* in[21]; float* out; unsigned char* ws;
};

constexpr int P0_ADA = 192, P0_B1 = 64;
constexpr int P0_TWIN = 32 * 23, P0_TWOUT = 32 * 8, P0_TW1 = 32 * 32, P0_TW2 = 128 * 8, P0_TC1 = 64 * 1, P0_TC2 = 4 * 1;
constexpr int P0_OFF_B1 = P0_ADA, P0_OFF_TWIN = P0_OFF_B1 + P0_B1, P0_OFF_TWOUT = P0_OFF_TWIN + P0_TWIN, P0_OFF_TW1 = P0_OFF_TWOUT + P0_TWOUT,
              P0_OFF_TW2 = P0_OFF_TW1 + P0_TW1, P0_OFF_TC1K = P0_OFF_TW2 + P0_TW2, P0_OFF_TC1V = P0_OFF_TC1K + P0_TC1, P0_OFF_TC2K = P0_OFF_TC1V + P0_TC1,
              P0_OFF_TC2V = P0_OFF_TC2K + P0_TC2, P0_ITEMS = P0_OFF_TC2V + P0_TC2;

__device__ __forceinline__ void transpose_tile(const float* __restrict__ W, int K, int N, int Nout, h16* __restrict__ Wt, int item, LAS float* scr, int tid, bool bf = false) {
    const int nkt = K / 64; const int kt = item % nkt, ntl = item / nkt;
    { const int c4 = tid & 63, r = tid >> 6; f32x4 v[8];
#pragma unroll
      for (int i = 0; i < 8; ++i) { const int k = kt * 64 + r + 8 * i, n = ntl * 256 + 4 * c4;
          v[i] = (f32x4){0.f, 0.f, 0.f, 0.f}; if (n < N) v[i] = *(const f32x4*)(W + (size_t)k * N + n); }
#pragma unroll
      for (int i = 0; i < 8; ++i) *(LAS f32x4*)(scr + (r + 8 * i) * 260 + 4 * c4) = v[i]; }
    __syncthreads();
    { const int n = tid >> 1, hf = tid & 1;
      if (ntl * 256 + n < Nout) {
#pragma unroll
          for (int q = 0; q < 4; ++q) { float f[8];
#pragma unroll
              for (int j = 0; j < 8; ++j) f[j] = scr[(32 * hf + 8 * q + j) * 260 + n];
              u32x4 o;
              if (bf) { o.x = pg8::pk_bf2(f[0], f[1]); o.y = pg8::pk_bf2(f[2], f[3]); o.z = pg8::pk_bf2(f[4], f[5]); o.w = pg8::pk_bf2(f[6], f[7]); }
              else    { o.x = pg8::pk_h2(f[0], f[1]);  o.y = pg8::pk_h2(f[2], f[3]);  o.z = pg8::pk_h2(f[4], f[5]);  o.w = pg8::pk_h2(f[6], f[7]); }
              *(u32x4*)(Wt + (size_t)(ntl * 256 + n) * K + kt * 64 + 32 * hf + 8 * q) = o; } } }
    __syncthreads();
}

__device__ __forceinline__ void p0_prologue(const Ptrs& P, LAS unsigned char* lds, int G, int bid) {
    const int tid = threadIdx.x;
    LAS float* scr = (LAS float*)lds;
    unsigned char* ws = P.ws;
    for (int it = bid; it < P0_ITEMS; it += G) {
        if (it < P0_ADA) {
            LAS float* sc = scr;
            LAS float* red = scr + 8192;
            const float* c = P.in[1];
            for (int i = tid; i < 8192; i += NTHR) { const float v = c[i]; sc[i] = v / (1.f + __expf(-v)); }
            __syncthreads();
            const int cl = tid & 15, kg = tid >> 4;
            f32x4 a0 = {0, 0, 0, 0}, a1 = a0, a2 = a0, a3 = a0;
            const float* W = P.in[2] + 64 * it + 4 * cl;
#pragma unroll 4
            for (int k = kg; k < 2048; k += 32) { const f32x4 w = *(const f32x4*)(W + (size_t)k * 12288);
                a0 += sc[k] * w; a1 += sc[2048 + k] * w; a2 += sc[4096 + k] * w; a3 += sc[6144 + k] * w; }
#pragma unroll
            for (int j = 0; j < 4; ++j) { red[(kg * 4 + 0) * 64 + 4 * cl + j] = a0[j]; red[(kg * 4 + 1) * 64 + 4 * cl + j] = a1[j];
                red[(kg * 4 + 2) * 64 + 4 * cl + j] = a2[j]; red[(kg * 4 + 3) * 64 + 4 * cl + j] = a3[j]; }
            __syncthreads();
            if (tid < 256) { const int b = tid >> 6, col = tid & 63; float s = 0.f;
                for (int q = 0; q < 32; ++q) s += red[(q * 4 + b) * 64 + col];
                ((float*)(ws + WS_MOD))[b * 12288 + 64 * it + col] = s + P.in[3][64 * it + col]; }
            __syncthreads();
        } else if (it < P0_OFF_TWIN) {
            const int q = it - P0_OFF_B1, kv = q >> 5, part = q & 31;
            const float* pe = P.in[8 + kv]; const float* W1 = P.in[kv ? 12 : 10];
            const int col = tid & 255, kh = tid >> 8; float s = 0.f;
            for (int k = 128 * part + 64 * kh; k < 128 * part + 64 * kh + 64; ++k) s += pe[k] * W1[(size_t)k * 256 + col];
            scr[tid] = s; __syncthreads();
            if (tid < 256) ((float*)(ws + WS_B1P))[(kv * 32 + part) * 256 + tid] = scr[tid] + scr[tid + 256];
            __syncthreads();
        } else if (it < P0_OFF_TWOUT) transpose_tile(P.in[5], DM, DIN, DINP, (h16*)(ws + WS_WIN), it - P0_OFF_TWIN, scr, tid);
        else if (it < P0_OFF_TW1)     transpose_tile(P.in[16], DM, DM, DM, (h16*)(ws + WS_WOUT), it - P0_OFF_TWOUT, scr, tid, true);
        else if (it < P0_OFF_TW2)     transpose_tile(P.in[18], DM, DFF, DFF, (h16*)(ws + WS_W1), it - P0_OFF_TW1, scr, tid, true);
        else if (it < P0_OFF_TC1K)    transpose_tile(P.in[19], DFF, DM, DM, (h16*)(ws + WS_W2), it - P0_OFF_TW2, scr, tid, true);
        else if (it < P0_OFF_TC1V)    transpose_tile(P.in[10], 4096, 256, 256, (h16*)(ws + WS_CW1K), it - P0_OFF_TC1K, scr, tid);
        else if (it < P0_OFF_TC2K)    transpose_tile(P.in[12], 4096, 256, 256, (h16*)(ws + WS_CW1V), it - P0_OFF_TC1V, scr, tid);
        else if (it < P0_OFF_TC2V)    transpose_tile(P.in[11], 256, 128, 128, (h16*)(ws + WS_CW2K), it - P0_OFF_TC2K, scr, tid);
        else                          transpose_tile(P.in[13], 256, 128, 128, (h16*)(ws + WS_CW2V), it - P0_OFF_TC2V, scr, tid);
    }
}

template <bool BF> __device__ __forceinline__ void norm_mod_rows(const float* __restrict__ X, const float* __restrict__ gw, const float* __restrict__ mod, int sh_off, int sc_off,
                                              h16* __restrict__ H, int G, int bid) {
    const int lane = threadIdx.x & 63, wave = threadIdx.x >> 6;
    for (int r = bid * 8 + wave; r < NT; r += G * 8) {
        const int b = r >> 13; const float* xr = X + (size_t)r * DM; f32x4 v[8]; float ss = 0.f;
#pragma unroll
        for (int i = 0; i < 8; ++i) { v[i] = *(const f32x4*)(xr + 4 * (lane + 64 * i)); ss += v[i][0] * v[i][0] + v[i][1] * v[i][1] + v[i][2] * v[i][2] + v[i][3] * v[i][3]; }
        ss = wave_sum(ss); const float rstd = rsqrtf(ss * (1.f / DM) + EPS);
        const float* mb = mod + (size_t)b * 12288;
#pragma unroll
        for (int i = 0; i < 8; ++i) { const int c = 4 * (lane + 64 * i);
            const f32x4 g = *(const f32x4*)(gw + c), sh = *(const f32x4*)(mb + sh_off + c), sc = *(const f32x4*)(mb + sc_off + c);
            const f32x4 o = (v[i] * rstd) * g * (1.f + sc) + sh;
            u32x2 w; w.x = pg8::pk2<BF>(o[0], o[1]); w.y = pg8::pk2<BF>(o[2], o[3]);
            *(u32x2*)(H + (size_t)r * DM + c) = w; }
    }
}
__device__ __forceinline__ void final_norm_rows(float* __restrict__ X, const float* __restrict__ gw, int G, int bid) {
    const int lane = threadIdx.x & 63, wave = threadIdx.x >> 6;
    for (int r = bid * 8 + wave; r < NT; r += G * 8) {
        float* xr = X + (size_t)r * DM; f32x4 v[8]; float ss = 0.f;
#pragma unroll
        for (int i = 0; i < 8; ++i) { v[i] = *(const f32x4*)(xr + 4 * (lane + 64 * i)); ss += v[i][0] * v[i][0] + v[i][1] * v[i][1] + v[i][2] * v[i][2] + v[i][3] * v[i][3]; }
        ss = wave_sum(ss); const float rstd = rsqrtf(ss * (1.f / DM) + EPS);
#pragma unroll
        for (int i = 0; i < 8; ++i) { const int c = 4 * (lane + 64 * i); const f32x4 g = *(const f32x4*)(gw + c); *(f32x4*)(xr + c) = (v[i] * rstd) * g; }
    }
}

__device__ __forceinline__ void post_u_rows(const Ptrs& P, int G, int bid) {
    const int lane = threadIdx.x & 63, wave = threadIdx.x >> 6;
    h16* U = (h16*)(P.ws + WS_U); h16* MIX = (h16*)(P.ws + WS_H);
    const float* cw = P.in[6]; const float* cb = P.in[7]; const float* gcv = P.in[14];
    const int hsel = lane >> 3, c8 = lane & 7;
    float inv[8];
#pragma unroll
    for (int e = 0; e < 8; ++e) inv[e] = (float)exp2(-(double)(8 * c8 + e) * (13.287712379549449 / 64.0));
    float wcb[16], wc0[16], wc1[16], wc2[16], wg[16];
#pragma unroll
    for (int hf = 0; hf < 2; ++hf)
#pragma unroll
        for (int j = 0; j < 8; ++j) { const int ch = 512 * hf + 8 * lane + j; wcb[8 * hf + j] = cb[ch]; wc0[8 * hf + j] = cw[ch]; wc1[8 * hf + j] = cw[1024 + ch]; wc2[8 * hf + j] = cw[2048 + ch]; wg[8 * hf + j] = gcv[ch]; }
    for (int r = bid * 8 + wave; r < NT; r += G * 8) {
        const int pos = r & (SEQ - 1); h16* u = U + (size_t)r * DINP;
        float cs[8], sn[8];
#pragma unroll
        for (int e = 0; e < 8; ++e) { const float ang = (float)pos * inv[e];
            double rev = (double)ang * 0.15915494309189535; rev -= __builtin_rint(rev);
            const float rf = (float)rev; cs[e] = __builtin_amdgcn_cosf(rf); sn[e] = __builtin_amdgcn_sinf(rf); }
#pragma unroll
        for (int rd = 0; rd < 2; ++rd) {
            const int base = rd == 0 ? OFF_Q + 128 * hsel : (hsel < 2 ? OFF_KC + 128 * hsel : (hsel < 4 ? OFF_KS + 128 * (hsel - 2) : OFF_KW + 128 * (hsel - 4)));
            if (rd == 0 || hsel < 6) {
                const half8 x1 = *(const half8*)(u + base + 8 * c8), x2 = *(const half8*)(u + base + 64 + 8 * c8); half8 o1, o2;
#pragma unroll
                for (int e = 0; e < 8; ++e) { const float a = (float)x1[e], bq = (float)x2[e]; o1[e] = (h16)(a * cs[e] - bq * sn[e]); o2[e] = (h16)(bq * cs[e] + a * sn[e]); }
                *(half8*)(u + base + 8 * c8) = o1; *(half8*)(u + base + 64 + 8 * c8) = o2; }
        }
        float y[16]; float ss = 0.f;
#pragma unroll
        for (int hf = 0; hf < 2; ++hf) {
            const int ch = 512 * hf + 8 * lane;
            const half8 ub = *(const half8*)(u + OFF_UB + ch), c0 = *(const half8*)(u + OFF_UC + ch), h0 = *(const half8*)(u + OFF_UH + ch);
            half8 c1 = c0 * (h16)0, h1 = c1, c2 = c1, h2 = c1;
            if (pos >= 1) { c1 = *(const half8*)(u - DINP + OFF_UC + ch); h1 = *(const half8*)(u - DINP + OFF_UH + ch); }
            if (pos >= 2) { c2 = *(const half8*)(u - 2 * DINP + OFF_UC + ch); h2 = *(const half8*)(u - 2 * DINP + OFF_UH + ch); }
#pragma unroll
            for (int j = 0; j < 8; ++j) {
                const float v0 = (float)c0[j] * (float)h0[j], v1 = (float)c1[j] * (float)h1[j], v2 = (float)c2[j] * (float)h2[j];
                const float z = wcb[8 * hf + j] + wc0[8 * hf + j] * v2 + wc1[8 * hf + j] * v1 + wc2[8 * hf + j] * v0;
                const float yy = (float)ub[j] * z; y[8 * hf + j] = yy; ss += yy * yy; }
        }
        ss = wave_sum(ss); const float rstd = rsqrtf(ss * (1.f / 1024.f) + EPS);
#pragma unroll
        for (int hf = 0; hf < 2; ++hf) { const int ch = 512 * hf + 8 * lane; float f[8];
#pragma unroll
            for (int j = 0; j < 8; ++j) f[j] = y[8 * hf + j] * rstd * wg[8 * hf + j];
            u32x4 o; o.x = pg8::pk_bf2(f[0], f[1]); o.y = pg8::pk_bf2(f[2], f[3]); o.z = pg8::pk_bf2(f[4], f[5]); o.w = pg8::pk_bf2(f[6], f[7]);
            *(u32x4*)(MIX + (size_t)r * DM + ch) = o; }
    }
}

__device__ __forceinline__ float gelu_tanh(float x) {
    const float z = 0.7978845608028654f * (x + 0.044715f * x * x * x);
    const float e = __expf(2.f * z);
    const float th = 1.f - 2.f / (e + 1.f);
    return 0.5f * x * (1.f + th);
}
__device__ __forceinline__ void compress_phase(const Ptrs& P, LAS unsigned char* lds, int G, int bid) {
    const int tid = threadIdx.x, lane = tid & 63, w = tid >> 6, fr = lane & 15, fq = lane >> 4;
    const h16* U = (const h16*)(P.ws + WS_U);
    LAS h16* hid = (LAS h16*)lds;
    for (int unit = bid; unit < 256; unit += G) {
        const int kv = unit >> 7, bg = (unit >> 4) & 7, nb = unit & 15, b = bg >> 1, g = bg & 1, n0 = nb * 32;
        const h16* W1t = (const h16*)(P.ws + (kv ? WS_CW1V : WS_CW1K));
        const h16* W2t = (const h16*)(P.ws + (kv ? WS_CW2V : WS_CW2K));
        const float* b1p = (const float*)(P.ws + WS_B1P) + kv * 32 * 256;
        h16* OUT = (h16*)(P.ws + (kv ? WS_VCMP : WS_KCMP)) + (size_t)bg * 512 * 128;
        const int coff = (kv ? OFF_VC : OFF_KC) + g * 128;
        f32x4 acc[2][2];
#pragma unroll
        for (int i = 0; i < 2; ++i)
#pragma unroll
            for (int j = 0; j < 2; ++j) acc[i][j] = (f32x4){0.f, 0.f, 0.f, 0.f};
        half8 fa[2][4][2], fb[2][4][2];
        half8 zero8;
#pragma unroll
        for (int j = 0; j < 8; ++j) zero8[j] = (h16)0.f;
        const h16* arow[2]; bool aok0[2];
#pragma unroll
        for (int mt = 0; mt < 2; ++mt) arow[mt] = U + (size_t)(b * SEQ + 16 * (n0 + 16 * mt + fr)) * DINP + coff + 8 * fq;
        const h16* brow[2];
#pragma unroll
        for (int nt = 0; nt < 2; ++nt) brow[nt] = W1t + (size_t)(32 * w + 16 * nt + fr) * 4096 + 8 * fq;
        (void)aok0;
#define CP_LOAD(buf_, pos_) do { _Pragma("unroll") for (int ks = 0; ks < 4; ++ks) { \
            _Pragma("unroll") for (int mt = 0; mt < 2; ++mt) { const int tok = 16 * (n0 + 16 * mt + fr) + (pos_); \
                fa[buf_][ks][mt] = tok < SEQ ? *(const half8*)(arow[mt] + (size_t)(pos_) * DINP + 32 * ks) : zero8; } \
            _Pragma("unroll") for (int nt = 0; nt < 2; ++nt) fb[buf_][ks][nt] = *(const half8*)(brow[nt] + (pos_) * 128 + 32 * ks); } } while (0)
#define CP_MMA(buf_) do { _Pragma("unroll") for (int ks = 0; ks < 4; ++ks) _Pragma("unroll") for (int mt = 0; mt < 2; ++mt) _Pragma("unroll") for (int nt = 0; nt < 2; ++nt) \
            acc[mt][nt] = __builtin_amdgcn_mfma_f32_16x16x32_f16(fa[buf_][ks][mt], fb[buf_][ks][nt], acc[mt][nt], 0, 0, 0); } while (0)
        CP_LOAD(0, 0);
#pragma unroll 1
        for (int pos = 0; pos < 32; pos += 2) {
            CP_LOAD(1, pos + 1);
            CP_MMA(0);
            if (pos + 2 < 32) CP_LOAD(0, pos + 2);
            CP_MMA(1);
        }
#undef CP_LOAD
#undef CP_MMA
#pragma unroll
        for (int nt = 0; nt < 2; ++nt) { const int col = 32 * w + 16 * nt + fr; float bias = 0.f;
            for (int q = 0; q < 32; ++q) bias += b1p[q * 256 + col];
#pragma unroll
            for (int mt = 0; mt < 2; ++mt)
#pragma unroll
                for (int j = 0; j < 4; ++j) hid[(16 * mt + 4 * fq + j) * 264 + col] = (h16)gelu_tanh(acc[mt][nt][j] + bias); }
        __syncthreads();
        f32x4 acc2[2]; acc2[0] = (f32x4){0.f, 0.f, 0.f, 0.f}; acc2[1] = acc2[0];
#pragma unroll
        for (int ks = 0; ks < 8; ++ks) {
            const half8 bb = *(const half8*)(W2t + (size_t)(16 * w + fr) * 256 + 32 * ks + 8 * fq);
#pragma unroll
            for (int mt = 0; mt < 2; ++mt) { const half8 a = *(const LAS half8*)(hid + (16 * mt + fr) * 264 + 32 * ks + 8 * fq);
                acc2[mt] = __builtin_amdgcn_mfma_f32_16x16x32_f16(a, bb, acc2[mt], 0, 0, 0); }
        }
#pragma unroll
        for (int mt = 0; mt < 2; ++mt)
#pragma unroll
            for (int j = 0; j < 4; ++j) OUT[(size_t)(n0 + 16 * mt + 4 * fq + j) * 128 + 16 * w + fr] = (h16)acc2[mt][j];
        __syncthreads();
    }
}

typedef short s16x4 __attribute__((ext_vector_type(4)));
typedef short s16x8 __attribute__((ext_vector_type(8)));
template <bool a0, bool a1> __device__ __forceinline__ void af_qk(const LAS unsigned char* kbuf, const unsigned (&kl)[4], const half8 (&qf)[2][4], f32x4 (&s)[2][4]) {
    const LAS unsigned char* ka[4];
    { int _ln; asm volatile("v_mov_b32 %0, %1" : "=v"(_ln) : "v"(kl[0]));
      const int fr_ = _ln & 15, e_ = (_ln >> 4) ^ fr_;
#pragma unroll
      for (int ks = 0; ks < 4; ++ks) ka[ks] = kbuf + fr_ * 256 + ((e_ ^ (4 * ks)) << 4); }
    half8 kf[2][4];
#pragma unroll
    for (int ks = 0; ks < 4; ++ks) kf[0][ks] = *(const LAS half8*)(ka[ks]);
#pragma unroll
    for (int kt = 0; kt < 4; ++kt) {
        if (kt < 3) {
#pragma unroll
            for (int ks = 0; ks < 4; ++ks) kf[(kt + 1) & 1][ks] = *(const LAS half8*)(ka[ks] + (kt + 1) * 4096); }
        s[0][kt] = (f32x4){0.f, 0.f, 0.f, 0.f}; s[1][kt] = (f32x4){0.f, 0.f, 0.f, 0.f};
#pragma unroll
        for (int ks = 0; ks < 4; ++ks) {
            if (a0) s[0][kt] = __builtin_amdgcn_mfma_f32_16x16x32_f16(kf[kt & 1][ks], qf[0][ks], s[0][kt], 0, 0, 0);
            if (a1) s[1][kt] = __builtin_amdgcn_mfma_f32_16x16x32_f16(kf[kt & 1][ks], qf[1][ks], s[1][kt], 0, 0, 0); }
        __builtin_amdgcn_sched_barrier(0);
    }
}
template <bool a0, bool a1> __device__ __forceinline__ void af_pv(const LAS unsigned char* vbuf, unsigned vl0, int z, const half8 (&pf)[2][2], f32x4 (&o)[2][8]) {
    const unsigned rb = (unsigned)(__UINTPTR_TYPE__)(vbuf + vl0);
    s16x4 vr[2][8];
#define AF_VLOAD(buf_, dt_) asm volatile("ds_read_b64_tr_b16 %0, %8\n\tds_read_b64_tr_b16 %1, %8 offset:4096\n\tds_read_b64_tr_b16 %2, %8 offset:8192\n\tds_read_b64_tr_b16 %3, %8 offset:12288\n\t" \
        "ds_read_b64_tr_b16 %4, %9\n\tds_read_b64_tr_b16 %5, %9 offset:4096\n\tds_read_b64_tr_b16 %6, %9 offset:8192\n\tds_read_b64_tr_b16 %7, %9 offset:12288" \
        : "=&v"(vr[buf_][0]), "=&v"(vr[buf_][1]), "=&v"(vr[buf_][2]), "=&v"(vr[buf_][3]), "=&v"(vr[buf_][4]), "=&v"(vr[buf_][5]), "=&v"(vr[buf_][6]), "=&v"(vr[buf_][7]) \
        : "v"(rb + ((unsigned)((dt_) ^ z) << 5)), "v"(rb + ((unsigned)(((dt_) + 1) ^ z) << 5)) : "memory")
#define AF_VWAIT(buf_, n_) asm volatile("s_waitcnt lgkmcnt(" #n_ ")" : "+v"(vr[buf_][0]), "+v"(vr[buf_][1]), "+v"(vr[buf_][2]), "+v"(vr[buf_][3]), "+v"(vr[buf_][4]), "+v"(vr[buf_][5]), "+v"(vr[buf_][6]), "+v"(vr[buf_][7]) :: "memory")
#define AF_VMMA(buf_, dt0_) do { _Pragma("unroll") for (int dd = 0; dd < 2; ++dd) _Pragma("unroll") for (int kp = 0; kp < 2; ++kp) { \
            const s16x4 lo = vr[buf_][4 * dd + 2 * kp], hi = vr[buf_][4 * dd + 2 * kp + 1]; \
            s16x8 v8; v8[0] = lo[0]; v8[1] = lo[1]; v8[2] = lo[2]; v8[3] = lo[3]; v8[4] = hi[0]; v8[5] = hi[1]; v8[6] = hi[2]; v8[7] = hi[3]; \
            const half8 vf = __builtin_bit_cast(half8, v8); \
            if (a0) o[0][(dt0_) + dd] = __builtin_amdgcn_mfma_f32_16x16x32_f16(vf, pf[0][kp], o[0][(dt0_) + dd], 0, 0, 0); \
            if (a1) o[1][(dt0_) + dd] = __builtin_amdgcn_mfma_f32_16x16x32_f16(vf, pf[1][kp], o[1][(dt0_) + dd], 0, 0, 0); } \
        __builtin_amdgcn_sched_barrier(0); } while (0)
    AF_VLOAD(0, 0); AF_VLOAD(1, 2);
    AF_VWAIT(0, 8); AF_VMMA(0, 0); AF_VLOAD(0, 4);
    AF_VWAIT(1, 8); AF_VMMA(1, 2); AF_VLOAD(1, 6);
    AF_VWAIT(0, 8); AF_VMMA(0, 4);
    AF_VWAIT(1, 0); AF_VMMA(1, 6);
#undef AF_VMMA
#undef AF_VLOAD
#undef AF_VWAIT
}
__device__ __forceinline__ void af_maskraw(f32x4 (&s)[4], int mbase, int mstep, int fq, int hi, int lo) {
#pragma unroll
    for (int kt = 0; kt < 4; ++kt)
#pragma unroll
        for (int jj = 0; jj < 4; ++jj) { const int met = mbase + mstep * (16 * kt + 4 * fq + jj); s[kt][jj] = (met <= hi && met > lo) ? s[kt][jj] : -3.0e38f; }
}
__device__ __forceinline__ float af_colmax(const f32x4 (&s)[4]) {
    float v = -1.0e30f;
#pragma unroll
    for (int kt = 0; kt < 4; ++kt) v = fmaxf(v, fmaxf(fmaxf(s[kt][0], s[kt][1]), fmaxf(s[kt][2], s[kt][3])));
    v = fmaxf(v, __shfl_xor(v, 16)); v = fmaxf(v, __shfl_xor(v, 32)); return v;
}
__device__ __forceinline__ void af_pack(const f32x4 (&s)[4], half8 (&pf)[2]) {
#pragma unroll
    for (int kp = 0; kp < 2; ++kp) { half8 h;
#pragma unroll
        for (int jj = 0; jj < 4; ++jj) { h[jj] = (h16)s[2 * kp][jj]; h[4 + jj] = (h16)s[2 * kp + 1][jj]; }
        pf[kp] = h; }
}
__device__ __forceinline__ float af_rawmax(const f32x4 (&s)[4]) {
    float v = fmaxf(fmaxf(s[0][0], s[0][1]), fmaxf(s[0][2], s[0][3]));
#pragma unroll
    for (int kt = 1; kt < 4; ++kt) v = fmaxf(v, fmaxf(fmaxf(s[kt][0], s[kt][1]), fmaxf(s[kt][2], s[kt][3])));
    v = fmaxf(v, __shfl_xor(v, 16)); v = fmaxf(v, __shfl_xor(v, 32)); return v;
}
__device__ __forceinline__ void af_online_fast(f32x4 (&s)[4], bool colsel, float& m, float& l, f32x4 (&o)[8], half8 (&pf)[2], float SC) {
    float lm = fmaxf(fmaxf(s[0][0], s[0][1]), fmaxf(s[0][2], s[0][3]));
#pragma unroll
    for (int kt = 1; kt < 4; ++kt) lm = fmaxf(lm, fmaxf(fmaxf(s[kt][0], s[kt][1]), fmaxf(s[kt][2], s[kt][3])));
    if (__ballot(colsel && (lm * SC > m + 8.f)) != 0ull) {
        float v = lm; v = fmaxf(v, __shfl_xor(v, 16)); v = fmaxf(v, __shfl_xor(v, 32));
        const float mloc = colsel ? v * SC : -1.0e30f;
        const float mn = fmaxf(m, mloc); const float al = __builtin_amdgcn_exp2f(m - mn); m = mn;
        l *= al;
#pragma unroll
        for (int dt = 0; dt < 8; ++dt) o[dt] *= al;
    }
    const float bias = colsel ? -m : -1.0e30f; float ps = 0.f;
#pragma unroll
    for (int kt = 0; kt < 4; ++kt)
#pragma unroll
        for (int jj = 0; jj < 4; ++jj) { const float p = __builtin_amdgcn_exp2f(__builtin_fmaf(s[kt][jj], SC, bias)); s[kt][jj] = p; ps += p; }
    l += ps;
    af_pack(s, pf);
}
__device__ __forceinline__ float af_write(float* Y, size_t row, int colbase, const f32x4 (&o)[8], float sc, bool accumulate) {
    float ss = 0.f;
#pragma unroll
    for (int dt = 0; dt < 8; ++dt) { float* p = Y + row * 1024 + colbase + 16 * dt; f32x4 v = o[dt] * sc; if (accumulate) v += *(const f32x4*)p; *(f32x4*)p = v;
        ss += (v[0] * v[0] + v[1] * v[1]) + (v[2] * v[2] + v[3] * v[3]); }
    return ss;
}
__device__ __forceinline__ float af_sigmoid(float x) { return 1.f / (1.f + __expf(-x)); }

template <bool A0, bool A1>
__device__ __forceinline__ void af_tile_online(const LAS unsigned char* stage, const unsigned (&kl)[4], unsigned vl0, int vz, const half8 (&qf)[2][4], f32x4 (&s)[2][4],
                                               float (&m)[2], float (&l)[2], f32x4 (&o)[2][8], bool needmask, int mbase, int fq, const int (&hi)[2], const int (&lo)[2], float SC) {
    af_qk<A0, A1>(stage, kl, qf, s);
    half8 pf[2][2];
    if (A0) { if (needmask) af_maskraw(s[0], mbase, 1, fq, hi[0], lo[0]); af_online_fast(s[0], hi[0] >= 0, m[0], l[0], o[0], pf[0], SC); } else { pf[0][0] = qf[0][0]; pf[0][1] = qf[0][0]; }
    if (A1) { if (needmask) af_maskraw(s[1], mbase, 1, fq, hi[1], lo[1]); af_online_fast(s[1], hi[1] >= 0, m[1], l[1], o[1], pf[1], SC); } else { pf[1][0] = qf[1][0]; pf[1][1] = qf[1][0]; }
    af_pv<A0, A1>(stage + 16384, vl0, vz, pf, o);
}
#define AF_ISSUE(st_, kb_, vb_, gs_, r0_, needv_) do { int _ln; asm volatile("v_mov_b32 %0, %1" : "=v"(_ln) : "v"(lane)); \
      _Pragma("unroll") for (int _c = 0; _c < 2; ++_c) { const int _row = 8 * w + 4 * _c + (_ln >> 4); \
      const h16* _kp = (kb_) + (size_t)((r0_) + _row) * (gs_) + (((_ln & 15) ^ (_row & 15)) << 3); \
      __builtin_amdgcn_global_load_lds((const unsigned*)_kp, (LAS unsigned*)(lds + (st_) * 32768 + (2 * w + _c) * 1024), 16, 0, 0); \
      if (needv_) { const h16* _vp = (vb_) + (size_t)((r0_) + _row) * (gs_) + (((_ln & 15) ^ (2 * (_row & 7))) << 3); \
      __builtin_amdgcn_global_load_lds((const unsigned*)_vp, (LAS unsigned*)(lds + (st_) * 32768 + 16384 + (2 * w + _c) * 1024), 16, 0, 0); } } } while (0)
#define AF_WAITV(n) asm volatile("s_waitcnt vmcnt(" #n ")" ::: "memory")
#define AF_BAR() do { __builtin_amdgcn_s_barrier(); asm volatile("" ::: "memory"); } while (0)

__device__ __forceinline__ void attn_fast(const Ptrs& P, LAS unsigned char* lds, int G, int bid) {
    const int tid = threadIdx.x, lane = tid & 63, w = __builtin_amdgcn_readfirstlane(tid >> 6), fr = lane & 15, fq = lane >> 4, qi = fr >> 2, hh = fr & 3;
    LAS float* IMP = (LAS float*)(lds + 98304) + w * (8 * 132);
    LAS unsigned* SELM = (LAS unsigned*)(lds + 132096);
    const h16* U = (const h16*)(P.ws + WS_U); float* Y = (float*)(P.ws + WS_YACC);
    const float SC = 0.08838834764831845f * 1.4426950408889634f;
    const int NEGBIG = -(1 << 30);
    unsigned kl[4]; kl[0] = (unsigned)lane; kl[1] = kl[2] = kl[3] = 0u;
    const int vz = (4 * fq + (fr >> 2)) & 7;
    const unsigned vl0 = (unsigned)((4 * fq + (fr >> 2)) * 256 + 8 * (fr & 1) + 16 * ((fr >> 1) & 1));
    const int nunits = (512 + G - 1) / G;
#pragma unroll 1
    for (int ui = 0; ui < nunits; ++ui) {
        int b, qb;
        if (G == 256) { const int idx = (bid & 1) * 32 + (bid >> 3); b = (bid & 7) >> 1; qb = ui == 0 ? 127 - idx : idx; }
        else { const int u = ui * G + bid; if (u >= 512) break;
               b = u >> 7; qb = (((u & 1) ^ ((u >> 8) & 1)) != 0) ? 127 - ((u >> 1) & 63) : ((u >> 1) & 63); }
#pragma unroll 1
        for (int g = 0; g < 2; ++g) {
            const int bg = 2 * b + g;
            int tq[2]; tq[0] = 64 * qb + 8 * w + qi; tq[1] = tq[0] + 4;
            const h16* Ub = U + (size_t)b * SEQ * DINP;
            half8 qf[2][4];
#pragma unroll
            for (int ct = 0; ct < 2; ++ct)
#pragma unroll
                for (int ks = 0; ks < 4; ++ks) qf[ct][ks] = *(const half8*)(Ub + (size_t)tq[ct] * DINP + OFF_Q + (4 * g + hh) * 128 + 32 * ks + 8 * fq);
            for (int i = lane; i < 8 * 132; i += 64) IMP[i] = 0.f;
            f32x4 s[2][4];
            const h16* KC = (const h16*)(P.ws + WS_KCMP) + (size_t)bg * 512 * 128;
            const h16* VC = (const h16*)(P.ws + WS_VCMP) + (size_t)bg * 512 * 128;
            const int ntc = ((4 * qb + 2) >> 6) + 1;
            float m[2], l[2];
            m[0] = m[1] = -1.0e30f; l[0] = l[1] = 0.f;
            AF_ISSUE(0, KC, VC, 128, 0, false);
            if (ntc > 1) AF_ISSUE(1, KC, VC, 128, 64, false);
#pragma unroll 1
            for (int T = 0; T < ntc; ++T) {
                if (T + 1 < ntc) AF_WAITV(2); else AF_WAITV(0);
                AF_BAR();
                if (T + 2 < ntc) AF_ISSUE((T + 2) % 3, KC, VC, 128, 64 * (T + 2), false);
                af_qk<true, true>(lds + (T % 3) * 32768, kl, qf, s);
#pragma unroll
                for (int ct = 0; ct < 2; ++ct) {
                    if (1024 * T + 1039 > 64 * qb) af_maskraw(s[ct], 1024 * T + 31, 16, fq, tq[ct], NEGBIG);
                    const float mn = fmaxf(m[ct], af_rawmax(s[ct]) * SC); const float al = __builtin_amdgcn_exp2f(m[ct] - mn); m[ct] = mn; float ps = 0.f;
#pragma unroll
                    for (int kt = 0; kt < 4; ++kt)
#pragma unroll
                        for (int jj = 0; jj < 4; ++jj) ps += __builtin_amdgcn_exp2f(__builtin_fmaf(s[ct][kt][jj], SC, -mn));
                    l[ct] = l[ct] * al + ps; }
            }
            float il[2];
#pragma unroll
            for (int ct = 0; ct < 2; ++ct) { float lt = l[ct]; lt += __shfl_xor(lt, 16); lt += __shfl_xor(lt, 32); il[ct] = lt > 0.f ? 1.f / lt : 0.f; }
            f32x4 o[2][8];
#pragma unroll
            for (int ct = 0; ct < 2; ++ct)
#pragma unroll
                for (int dt = 0; dt < 8; ++dt) o[ct][dt] = (f32x4){0.f, 0.f, 0.f, 0.f};
            AF_BAR();
            AF_ISSUE(0, KC, VC, 128, 0, true);
            if (ntc > 1) AF_ISSUE(1, KC, VC, 128, 64, true);
#pragma unroll 1
            for (int T = 0; T < ntc; ++T) {
                if (T + 1 < ntc) AF_WAITV(4); else AF_WAITV(0);
                AF_BAR();
                if (T + 2 < ntc) AF_ISSUE((T + 2) % 3, KC, VC, 128, 64 * (T + 2), true);
                af_qk<true, true>(lds + (T % 3) * 32768, kl, qf, s);
                half8 pf[2][2];
#pragma unroll
                for (int ct = 0; ct < 2; ++ct) {
                    if (1024 * T + 1039 > 64 * qb) af_maskraw(s[ct], 1024 * T + 31, 16, fq, tq[ct], NEGBIG);
#pragma unroll
                    for (int kt = 0; kt < 4; ++kt) {
#pragma unroll
                        for (int jj = 0; jj < 4; ++jj) s[ct][kt][jj] = __builtin_amdgcn_exp2f(__builtin_fmaf(s[ct][kt][jj], SC, -m[ct])) * il[ct];
                        float s4 = (s[ct][kt][0] + s[ct][kt][1]) + (s[ct][kt][2] + s[ct][kt][3]), s3 = s[ct][kt][3];
                        s4 += __shfl_xor(s4, 1); s4 += __shfl_xor(s4, 2); s3 += __shfl_xor(s3, 1); s3 += __shfl_xor(s3, 2);
                        if (hh == 0) { LAS float* ip = IMP + (4 * ct + qi) * 132 + 16 * T + 4 * kt + fq;
                            __hip_atomic_fetch_add(ip, s4, __ATOMIC_RELAXED, __HIP_MEMORY_SCOPE_WORKGROUP);
                            __hip_atomic_fetch_add(ip + 1, s3, __ATOMIC_RELAXED, __HIP_MEMORY_SCOPE_WORKGROUP); }
                    }
                    af_pack(s[ct], pf[ct]); }
                af_pv<true, true>(lds + (T % 3) * 32768 + 16384, vl0, vz, pf, o);
            }
#pragma unroll
            for (int ct = 0; ct < 2; ++ct) { int _ln; asm volatile("v_mov_b32 %0, %1" : "=v"(_ln) : "v"(lane));
                const int fr_ = _ln & 15, fq_ = _ln >> 4, hh_ = fr_ & 3;
                const size_t row = (size_t)b * SEQ + 64 * qb + 8 * w + 4 * ct + (fr_ >> 2);
                const float g0 = af_sigmoid((float)U[row * DINP + OFF_GL + (4 * g + hh_) * 3 + 0]);
                af_write(Y, row, (4 * g + hh_) * 128 + 4 * fq_, o[ct], g0, false); }
            __syncthreads();
#pragma unroll 1
            for (int ql = 0; ql < 8; ++ql) {
                LAS float* rowp = IMP + ql * 132;
                float sc0, sc1;
                { const int j = lane; const bool valid = j <= qb, forced = (j == 0) || (j == qb) || (j == qb - 1); const float v = rowp[j]; sc0 = valid ? v + (forced ? 1.0e4f : 0.f) : -1.f; rowp[j] = sc0; }
                { const int j = lane + 64; const bool valid = j <= qb, forced = (j == 0) || (j == qb) || (j == qb - 1); const float v = rowp[j]; sc1 = valid ? v + (forced ? 1.0e4f : 0.f) : -1.f; rowp[j] = sc1; }
                int r0 = 0, r1 = 0;
                for (int j4 = 0; j4 <= qb; j4 += 4) { const f32x4 v4 = *(const LAS f32x4*)(rowp + j4);
#pragma unroll
                    for (int e = 0; e < 4; ++e) { const int j = j4 + e; const float v = v4[e];
                        r0 += (v > sc0 || (v == sc0 && j < lane)) ? 1 : 0; r1 += (v > sc1 || (v == sc1 && j < lane + 64)) ? 1 : 0; } }
                const unsigned long long blo = __ballot(r0 < 16 && lane <= qb), bhi = __ballot(r1 < 16 && lane + 64 <= qb);
                if (lane == 0) { LAS unsigned* sp = SELM + (8 * w + ql) * 4; sp[0] = (unsigned)blo; sp[1] = (unsigned)(blo >> 32); sp[2] = (unsigned)bhi; sp[3] = (unsigned)(bhi >> 32); }
            }
            __syncthreads();
#pragma unroll 1
            for (int br = 1; br < 3; ++br) {
                const h16* KB = Ub + (br == 1 ? OFF_KS : OFF_KW) + g * 128;
                const h16* VB = Ub + (br == 1 ? OFF_VS : OFF_VW) + g * 128;
                const int j_lo = br == 1 ? 0 : (qb >= 8 ? qb - 8 : 0);
                const int nt = qb - j_lo + 1;
                m[0] = m[1] = -1.0e30f; l[0] = l[1] = 0.f;
#pragma unroll
                for (int ct = 0; ct < 2; ++ct)
#pragma unroll
                    for (int dt = 0; dt < 8; ++dt) o[ct][dt] = (f32x4){0.f, 0.f, 0.f, 0.f};
                AF_ISSUE(0, KB, VB, DINP, 64 * j_lo, true);
                if (nt > 1) AF_ISSUE(1, KB, VB, DINP, 64 * (j_lo + 1), true);
                if (nt > 2) AF_ISSUE(2, KB, VB, DINP, 64 * (j_lo + 2), true);
#pragma unroll 1
                for (int i = 0; i < nt; ++i) {
                    const int j = j_lo + i;
                    if (i + 2 < nt) AF_WAITV(8); else if (i + 1 < nt) AF_WAITV(4); else AF_WAITV(0);
                    AF_BAR();
                    if (i + 3 < nt) AF_ISSUE((i + 3) & 3, KB, VB, DINP, 64 * (j + 3), true);
                    int hi[2], lo[2]; bool act[2];
                    const bool needmask = (j == qb) || (br == 2 && 64 * j <= 64 * qb + 63 - 512);
#pragma unroll
                    for (int ct = 0; ct < 2; ++ct) {
                        if (br == 1) { const unsigned wd = SELM[(8 * w + 4 * ct + qi) * 4 + (j >> 5)]; const bool bit = (wd >> (j & 31)) & 1u;
                            act[ct] = __ballot(bit) != 0ull; hi[ct] = bit ? tq[ct] : -1; lo[ct] = NEGBIG; }
                        else { act[ct] = true; hi[ct] = tq[ct]; lo[ct] = tq[ct] - 512; }
                    }
                    const LAS unsigned char* stg = lds + (i & 3) * 32768;
                    if (act[0] && act[1]) af_tile_online<true, true>(stg, kl, vl0, vz, qf, s, m, l, o, needmask, 64 * j, fq, hi, lo, SC);
                    else if (act[0])      af_tile_online<true, false>(stg, kl, vl0, vz, qf, s, m, l, o, needmask, 64 * j, fq, hi, lo, SC);
                    else if (act[1])      af_tile_online<false, true>(stg, kl, vl0, vz, qf, s, m, l, o, needmask, 64 * j, fq, hi, lo, SC);
                }
#pragma unroll
                for (int ct = 0; ct < 2; ++ct) { int _ln; asm volatile("v_mov_b32 %0, %1" : "=v"(_ln) : "v"(lane));
                    const int fr_ = _ln & 15, fq_ = _ln >> 4, hh_ = fr_ & 3;
                    const size_t row = (size_t)b * SEQ + 64 * qb + 8 * w + 4 * ct + (fr_ >> 2);
                    float lt = l[ct]; lt += __shfl_xor(lt, 16); lt += __shfl_xor(lt, 32);
                    const float gg = af_sigmoid((float)U[row * DINP + OFF_GL + (4 * g + hh_) * 3 + br]);
                    (void)af_write(Y, row, (4 * g + hh_) * 128 + 4 * fq_, o[ct], lt > 0.f ? gg / lt : 0.f, true); }
                AF_BAR();
            }
        }
        {
            h16* MIX = (h16*)(P.ws + WS_H); const float* gw = P.in[15];
            int _ln; asm volatile("v_mov_b32 %0, %1" : "=v"(_ln) : "v"(lane));
            const int fr_ = _ln & 15, fq_ = _ln >> 4, hh_ = fr_ & 3;
#pragma unroll 1
            for (int ct = 0; ct < 2; ++ct) {
                const size_t row = (size_t)b * SEQ + 64 * qb + 8 * w + 4 * ct + (fr_ >> 2);
                float sv = 0.f;
#pragma unroll 1
                for (int g2 = 0; g2 < 2; ++g2)
#pragma unroll
                    for (int dt = 0; dt < 8; ++dt) { const f32x4 v = *(const f32x4*)(Y + row * 1024 + (4 * g2 + hh_) * 128 + 16 * dt + 4 * fq_);
                        sv += (v[0] * v[0] + v[1] * v[1]) + (v[2] * v[2] + v[3] * v[3]); }
                sv += __shfl_xor(sv, 1); sv += __shfl_xor(sv, 2); sv += __shfl_xor(sv, 16); sv += __shfl_xor(sv, 32);
                const float rstd = rsqrtf(sv * (1.f / 1024.f) + EPS);
#pragma unroll 1
                for (int g2 = 0; g2 < 2; ++g2)
#pragma unroll
                    for (int dt = 0; dt < 8; ++dt) { const int ch = (4 * g2 + hh_) * 128 + 16 * dt + 4 * fq_;
                        const f32x4 v = *(const f32x4*)(Y + row * 1024 + ch); const f32x4 gv = *(const f32x4*)(gw + ch); const f32x4 ov = v * rstd * gv;
                        u32x2 wv; wv.x = pg8::pk_bf2(ov[0], ov[1]); wv.y = pg8::pk_bf2(ov[2], ov[3]);
                        *(u32x2*)(MIX + row * DM + 1024 + ch) = wv; }
            }
        }
    }
}

#define XB_TMO      128
#define XB_XCNT(j)  (256  + 64 * (j))
#define XB_XSUB(j)  (1280 + 64 * (j))
#define XB_XGEN(j)  (2304 + 64 * (j))
#define XB_TOP      3328
#define XB_TOPGEN   3392
#define XCD_BAR_WORDS 3456
#define XB_SPIN_CAP (1u << 18)
__device__ __forceinline__ unsigned xb_ld(unsigned* p)              { return __hip_atomic_load(p, __ATOMIC_RELAXED, __HIP_MEMORY_SCOPE_AGENT); }
__device__ __forceinline__ unsigned xb_add(unsigned* p, unsigned v) { return __hip_atomic_fetch_add(p, v, __ATOMIC_RELAXED, __HIP_MEMORY_SCOPE_AGENT); }
__device__ __forceinline__ unsigned xb_xcc_id() { return (unsigned)__builtin_amdgcn_s_getreg((3 << 11) | 20) & 0xFu; }
#define XB_SPIN(cond, bar) do { unsigned _sp = 0; while (cond) { __builtin_amdgcn_s_sleep(1); \
    if ((++_sp & 255u) == 0u) { if (xb_ld(&(bar)[XB_TMO])) break; if (_sp > XB_SPIN_CAP) { atomicAdd(&(bar)[XB_TMO], 1u); break; } } } } while (0)
struct XcdBarrier { unsigned* bar; unsigned x; volatile LAS unsigned* st; };
__device__ __forceinline__ XcdBarrier xcd_barrier_post(unsigned* bar, volatile LAS unsigned* st) {
    XcdBarrier b; b.bar = bar; b.x = xb_xcc_id(); b.st = st;
    if (threadIdx.x == 0) (void)xb_add(&bar[XB_XCNT(b.x)], 1u);
    return b;
}
__device__ __forceinline__ void xcd_barrier_complete(unsigned* bar, unsigned x, unsigned& nloc, unsigned& nx) {
    const unsigned G = gridDim.x * gridDim.y * gridDim.z;
    unsigned sum, cnt, mine, sp = 0u;
    for (;;) {
        sum = 0u; cnt = 0u; mine = 0u;
#pragma unroll
        for (unsigned j = 0; j < 16; ++j) { const unsigned c = xb_ld(&bar[XB_XCNT(j)]); sum += c; cnt += (c > 0u) ? 1u : 0u; mine = (j == x) ? c : mine; }
        if (sum == G) break;
        __builtin_amdgcn_s_sleep(1);
        if ((++sp & 255u) == 0u) { if (xb_ld(&bar[XB_TMO])) break; if (sp > XB_SPIN_CAP) { atomicAdd(&bar[XB_TMO], 1u); break; } }
    }
    nloc = mine > 0u ? mine : 1u; nx = cnt > 0u ? cnt : 1u;
}
__device__ __forceinline__ void xcd_barrier(const XcdBarrier& b) {
    asm volatile("s_waitcnt vmcnt(0)" ::: "memory");
    __syncthreads();
    if (threadIdx.x == 0) {
        unsigned* bar = b.bar;
        __builtin_amdgcn_s_waitcnt(0);
        unsigned nloc = b.st[0], nx = b.st[1];
        if (nloc == 0u) { xcd_barrier_complete(bar, b.x, nloc, nx); b.st[0] = nloc; b.st[1] = nx; }
        const unsigned old = xb_add(&bar[XB_XSUB(b.x)], 1u);
        const unsigned gen = old / nloc;
        if (old + 1u == (gen + 1u) * nloc) {
            __builtin_amdgcn_fence(__ATOMIC_RELEASE, "agent");
            asm volatile("s_waitcnt vmcnt(0)" ::: "memory");
            const unsigned og = xb_add(&bar[XB_TOP], 1u);
            const unsigned tg = og / nx;
            if (og + 1u == (tg + 1u) * nx) xb_add(&bar[XB_TOPGEN], 1u);
            else XB_SPIN(xb_ld(&bar[XB_TOPGEN]) == tg, bar);
            __builtin_amdgcn_fence(__ATOMIC_ACQUIRE, "agent");
            xb_add(&bar[XB_XGEN(b.x)], 1u);
            asm volatile("s_waitcnt vmcnt(0)" ::: "memory");
        } else {
            XB_SPIN(xb_ld(&bar[XB_XGEN(b.x)]) == gen, bar);
            __builtin_amdgcn_fence(__ATOMIC_ACQUIRE, "agent");
            asm volatile("s_waitcnt vmcnt(0)" ::: "memory");
        }
    }
    __syncthreads();
}

constexpr int NPHASE = 12;
struct Args { Ptrs p; int ph_lo, ph_hi; };

__global__ void __launch_bounds__(NTHR, 2) mega(Args args) {
    extern __shared__ __attribute__((aligned(16))) unsigned char lds_raw[];
    LAS unsigned char* lds = (LAS unsigned char*)lds_raw;
    const Ptrs& P = args.p;
    const int G = gridDim.x, bid = blockIdx.x;
    unsigned char* ws = P.ws;
    const float* mod = (const float*)(ws + WS_MOD);
    const int lo = args.ph_lo, hi = args.ph_hi;
    volatile LAS unsigned* MISC = (volatile LAS unsigned*)(lds + LDS_BYTES - 64);
    if (threadIdx.x < 16) MISC[threadIdx.x] = 0u;
    __syncthreads();
    XcdBarrier xbar; xbar.bar = (unsigned*)(ws + WS_BAR); xbar.x = 0; xbar.st = MISC;
    if (hi - lo > 1) xbar = xcd_barrier_post((unsigned*)(ws + WS_BAR), MISC);
#define PHASE_BEGIN(n) if (lo <= (n) && (n) < hi) {
#define PHASE_END(n) if ((n) + 1 < hi) { if (G != 256) cg::this_grid().sync(); else xcd_barrier(xbar); } }
    PHASE_BEGIN(0) p0_prologue(P, lds, G, bid); PHASE_END(0)
    PHASE_BEGIN(1) norm_mod_rows<false>(P.in[0], P.in[4], mod, 0, 2048, (h16*)(ws + WS_H), G, bid); PHASE_END(1)
    PHASE_BEGIN(2) { pg8::Gemm g{(const h16*)(ws + WS_H), (const h16*)(ws + WS_WIN), NT, DINP, DM}; pg8::StaticOrder S; S.init(NT, DINP, G, bid);
                  pg8::EpiF16<0> E{(h16*)(ws + WS_U), DINP}; pg8::gemm_phase<false>(lds, g, S, E); } PHASE_END(2)
    PHASE_BEGIN(3) post_u_rows(P, G, bid); PHASE_END(3)
    PHASE_BEGIN(4) compress_phase(P, lds, G, bid); PHASE_END(4)
    PHASE_BEGIN(5) attn_fast(P, lds, G, bid); PHASE_END(5)
    PHASE_BEGIN(7) { pg8::Gemm g{(const h16*)(ws + WS_H), (const h16*)(ws + WS_WOUT), NT, DM, DM}; pg8::StaticOrder S; S.init(NT, DM, G, bid);
                  pg8::EpiRes E{P.in[0], P.out, mod + 2 * 2048, 12288}; pg8::gemm_phase<true>(lds, g, S, E); } PHASE_END(7)
    PHASE_BEGIN(8) norm_mod_rows<true>(P.out, P.in[17], mod, 3 * 2048, 4 * 2048, (h16*)(ws + WS_H), G, bid); PHASE_END(8)
    PHASE_BEGIN(9) { pg8::Gemm g{(const h16*)(ws + WS_H), (const h16*)(ws + WS_W1), NT, DFF, DM}; pg8::StaticOrder S; S.init(NT, DFF, G, bid);
                  pg8::EpiF16<1, true> E{(h16*)(ws + WS_HID), DFF}; pg8::gemm_phase<true>(lds, g, S, E); } PHASE_END(9)
    PHASE_BEGIN(10) { pg8::Gemm g{(const h16*)(ws + WS_HID), (const h16*)(ws + WS_W2), NT, DM, DFF}; pg8::StaticOrder S; S.init(NT, DM, G, bid);
                   pg8::EpiRes E{P.out, P.out, mod + 5 * 2048, 12288}; pg8::gemm_phase<true>(lds, g, S, E); } PHASE_END(10)
    PHASE_BEGIN(11) final_norm_rows(P.out, P.in[20], G, bid); PHASE_END(11)
}

extern "C" void kernel_launch(void* const* d_in, const int* in_sizes, int n_in, void* d_out, int out_size, void* d_ws, size_t ws_size, hipStream_t stream) {
    static int grid = 0;
    if (grid == 0) {
        if (n_in != 21 || out_size != NT * DM || ws_size < WS_END) { fprintf(stderr, "kernel_launch: unexpected shapes (n_in %d out %d ws %zu need %zu)\n", n_in, out_size, ws_size, (size_t)WS_END); grid = -1; return; }
        int dev = 0, cus = 0, per_cu = 0;
        hipGetDevice(&dev); hipDeviceGetAttribute(&cus, hipDeviceAttributeMultiprocessorCount, dev);
        if (hipFuncSetAttribute((const void*)mega, hipFuncAttributeMaxDynamicSharedMemorySize, LDS_BYTES) != hipSuccess) { fprintf(stderr, "kernel_launch: hipFuncSetAttribute failed\n"); grid = -1; return; }
        if (hipOccupancyMaxActiveBlocksPerMultiprocessor(&per_cu, (const void*)mega, NTHR, LDS_BYTES) != hipSuccess || per_cu < 1) { fprintf(stderr, "kernel_launch: occupancy query says %d\n", per_cu); per_cu = 1; }
        (void)hipGetLastError();
        grid = cus * 1;
        fprintf(stderr, "kernel_launch: cus %d per_cu %d grid %d\n", cus, per_cu, grid);
    }
    if (grid < 0) return;
    if (hipMemsetAsync((char*)d_ws + WS_BAR, 0, WS_BAR_BYTES, stream) != hipSuccess) { fprintf(stderr, "kernel_launch: memset failed\n"); return; }
    Args a{};
    for (int i = 0; i < 21; ++i) a.p.in[i] = (const float*)d_in[i];
    a.p.out = (float*)d_out; a.p.ws = (unsigned char*)d_ws;
    a.ph_lo = 0; a.ph_hi = NPHASE;
    void* kargs[] = {&a};
    hipError_t e = hipLaunchCooperativeKernel((const void*)mega, dim3(grid), dim3(NTHR), kargs, LDS_BYTES, stream);
    if (e != hipSuccess) fprintf(stderr, "cooperative launch failed: %s (grid %d)\n", hipGetErrorString(e), grid);
}
```

```cpp
#include <hip/hip_runtime.h>
#include <hip/hip_cooperative_groups.h>
#include <cstdint>
#include <cstdio>
namespace cg = cooperative_groups;


#define LAS __attribute__((address_space(3)))
typedef _Float16 h16;
typedef _Float16 half8 __attribute__((ext_vector_type(8)));
typedef _Float16 half4 __attribute__((ext_vector_type(4)));
typedef _Float16 half2v __attribute__((ext_vector_type(2)));
typedef float f32x4 __attribute__((ext_vector_type(4)));
typedef float f32x2 __attribute__((ext_vector_type(2)));
typedef unsigned u32x4 __attribute__((ext_vector_type(4)));
typedef unsigned u32x2 __attribute__((ext_vector_type(2)));

constexpr int NB = 4, SEQ = 8192, NT = NB * SEQ, DM = 2048, DIN = 5656, DINP = 5888, DFF = 8192;
constexpr int OFF_UB = 0, OFF_UC = 1024, OFF_UH = 2048, OFF_Q = 3072, OFF_KC = 4096, OFF_VC = 4352, OFF_KS = 4608, OFF_VS = 4864,
              OFF_KW = 5120, OFF_VW = 5376, OFF_GL = 5632;
constexpr float EPS = 1e-6f;
constexpr int NTHR = 512;
constexpr int LDS_BYTES = 136 * 1024;

constexpr size_t WS_BAR   = 0;
constexpr size_t WS_BAR_BYTES = 16384;
constexpr size_t WS_MOD   = 16384;
constexpr size_t WS_B1P   = WS_MOD + (size_t)4 * 12288 * 4;
constexpr size_t WS_WIN   = WS_B1P + (size_t)2 * 32 * 256 * 4;
constexpr size_t WS_WOUT  = WS_WIN + (size_t)DINP * DM * 2;
constexpr size_t WS_W1    = WS_WOUT + (size_t)DM * DM * 2;
constexpr size_t WS_W2    = WS_W1 + (size_t)DFF * DM * 2;
constexpr size_t WS_CW1K  = WS_W2 + (size_t)DFF * DM * 2;
constexpr size_t WS_CW1V  = WS_CW1K + (size_t)256 * 4096 * 2;
constexpr size_t WS_CW2K  = WS_CW1V + (size_t)256 * 4096 * 2;
constexpr size_t WS_CW2V  = WS_CW2K + (size_t)128 * 256 * 2;
constexpr size_t WS_KCMP  = WS_CW2V + (size_t)128 * 256 * 2;
constexpr size_t WS_VCMP  = WS_KCMP + (size_t)8 * 512 * 128 * 2;
constexpr size_t WS_H     = WS_VCMP + (size_t)8 * 512 * 128 * 2;
constexpr size_t WS_BIG   = WS_H + (size_t)NT * DM * 2;
constexpr size_t WS_U     = WS_BIG;
constexpr size_t WS_YACC  = WS_U + (size_t)NT * DINP * 2;
constexpr size_t WS_HID   = WS_BIG;
constexpr size_t WS_END   = WS_BIG + (size_t)NT * DFF * 2;
static_assert(WS_YACC + (size_t)NT * 1024 * 4 <= WS_END, "ws map");
constexpr size_t WS_X1H   = WS_END;
constexpr size_t WS_END2  = WS_X1H + (size_t)NT * DM * 2;
static_assert(WS_END2 <= (size_t)1073741824, "ws map fits 4x largest tensor");
static_assert(WS_WIN % 256 == 0 && WS_H % 256 == 0 && WS_BIG % 256 == 0 && WS_YACC % 256 == 0, "alignment");

namespace pg8 {
constexpr int BM = 256, BK = 64, HALF = 128, HTB = HALF * BK * 2, STAGE_BYTES = 8 * HTB, NXCD = 8, WGM = 8;
__host__ __device__ __forceinline__ int lds_byte(int r, int c) { const int st = (r >> 4) * 2 + (c >> 5), rr = r & 15, cc = c & 31, ob = rr * 64 + cc * 2; return st * 1024 + (ob ^ (((ob >> 9) & 1) << 5)); }
__host__ __device__ __forceinline__ void stage_rc(int b, int& R, int& C) { const int st = b / 1024, sb = b % 1024, swz = sb ^ (((sb >> 9) & 1) << 5); R = (st >> 1) * 16 + swz / 64; C = (st & 1) * 32 + (swz % 64) / 2; }
__host__ __device__ __forceinline__ int perm32(int rho) { const int n = rho >> 4, i = rho & 15; return 8 * (i >> 2) + 4 * n + (i & 3); }

struct Unit { int pm, pn; };
struct Gemm { const h16* A; const h16* Bt; int M, N, K; };

struct StaticOrder {
    int nM, nN, nwg, G, c;
    __host__ __device__ void init(int M, int N, int G_, int c_) { nM = M / BM; nN = N / BM; nwg = nM * nN; G = G_; c = c_; }
    __host__ __device__ bool next(int i, Unit& u) const {
        const long L = (long)i * G + c; if (L >= nwg) return false;
        int wgid = (int)L; { const int q = nwg / NXCD, r = nwg % NXCD, xcd = wgid % NXCD, off = wgid / NXCD; wgid = (xcd < r ? xcd * (q + 1) : r * (q + 1) + (xcd - r) * q) + off; }
        const int nig = WGM * nN, gid = wgid / nig, fm = gid * WGM, gsz = (nM - fm) < WGM ? (nM - fm) : WGM;
        u.pm = fm + ((wgid % nig) % gsz); u.pn = (wgid % nig) / gsz; return true;
    }
    __device__ __forceinline__ void a_ready(const Unit&) const {}
    __device__ __forceinline__ void done(const Unit&) const {}
};

__device__ __forceinline__ unsigned pk_h2(float lo, float hi) { half2v v; v.x = (h16)lo; v.y = (h16)hi; return __builtin_bit_cast(unsigned, v); }
__device__ __forceinline__ unsigned pk_bf2(float lo, float hi) { unsigned r; asm("v_cvt_pk_bf16_f32 %0, %1, %2" : "=v"(r) : "v"(lo), "v"(hi)); return r; }
template <bool BF> __device__ __forceinline__ unsigned pk2(float lo, float hi) { return BF ? pk_bf2(lo, hi) : pk_h2(lo, hi); }
typedef short bfx8 __attribute__((ext_vector_type(8)));

template <int ACT, bool BF = false> struct EpiF16 {
    static constexpr bool PERM = true, AFTER_DRAIN = false;
    h16* O; int ldc;
    __device__ __forceinline__ void operator()(const f32x4 (&acc)[2][2][4][2], const Unit& u, int wr, int wc, int fr, int fq) const {
        const int row0 = u.pm * BM + wr * 64 + fr; const int col0 = u.pn * BM + wc * 32 + 8 * fq;
#pragma unroll
        for (int ai = 0; ai < 2; ++ai)
#pragma unroll
            for (int m = 0; m < 4; ++m) { h16* rowp = O + (size_t)(row0 + ai * HALF + m * 16) * ldc + col0;
#pragma unroll
                for (int bj = 0; bj < 2; ++bj) { f32x4 v0 = acc[ai][bj][m][0], v1 = acc[ai][bj][m][1];
                    if (ACT == 1) {
#pragma unroll
                        for (int j = 0; j < 4; ++j) { const float a = fmaxf(v0[j], 0.f), b = fmaxf(v1[j], 0.f); v0[j] = a * a; v1[j] = b * b; } }
                    u32x4 w; w.x = pk2<BF>(v0[0], v0[1]); w.y = pk2<BF>(v0[2], v0[3]); w.z = pk2<BF>(v1[0], v1[1]); w.w = pk2<BF>(v1[2], v1[3]);
                    *(u32x4*)(rowp + bj * HALF) = w; } }
    }
};
template <bool BASE_F32> struct EpiRes {
    static constexpr bool PERM = true, AFTER_DRAIN = false;
    const void* base; h16* out; const float* gate; int gate_ld;
    __device__ __forceinline__ void operator()(const f32x4 (&acc)[2][2][4][2], const Unit& u, int wr, int wc, int fr, int fq) const {
        const int row0 = u.pm * BM + wr * 64 + fr, col0 = u.pn * BM + wc * 32 + 8 * fq; const int b = (u.pm * BM) / SEQ;
        f32x4 gv[2][2];
#pragma unroll
        for (int bj = 0; bj < 2; ++bj)
#pragma unroll
            for (int n = 0; n < 2; ++n) gv[bj][n] = *(const f32x4*)(gate + (size_t)b * gate_ld + col0 + bj * HALF + 4 * n);
#pragma unroll
        for (int ai = 0; ai < 2; ++ai)
#pragma unroll
            for (int m = 0; m < 4; ++m) { const size_t ro = (size_t)(row0 + ai * HALF + m * 16) * DM + col0;
#pragma unroll
                for (int bj = 0; bj < 2; ++bj) { f32x4 b0, b1;
                    if (BASE_F32) { b0 = *(const f32x4*)((const float*)base + ro + bj * HALF); b1 = *(const f32x4*)((const float*)base + ro + bj * HALF + 4); }
                    else { const half8 hb = *(const half8*)((const h16*)base + ro + bj * HALF);
                           b0 = (f32x4){(float)hb[0], (float)hb[1], (float)hb[2], (float)hb[3]}; b1 = (f32x4){(float)hb[4], (float)hb[5], (float)hb[6], (float)hb[7]}; }
                    const f32x4 v0 = b0 + gv[bj][0] * acc[ai][bj][m][0], v1 = b1 + gv[bj][1] * acc[ai][bj][m][1];
                    u32x4 w; w.x = pk_h2(v0[0], v0[1]); w.y = pk_h2(v0[2], v0[3]); w.z = pk_h2(v1[0], v1[1]); w.w = pk_h2(v1[2], v1[3]);
                    *(u32x4*)(out + ro + bj * HALF) = w; } }
    }
};

template <bool BF16, class Epi, class Sched, bool ALIGN_EPI = true, bool SP2 = true>
__device__ __forceinline__ void gemm_phase(LAS unsigned char* lds, const Gemm g, const Sched& S, const Epi& E) {
    const int tid = threadIdx.x, wid = __builtin_amdgcn_readfirstlane(tid >> 6), lane = tid & 63, wr = wid >> 2, wc = wid & 3, fr = lane & 15, fq = lane >> 4;
    const int K = g.K, nt = K / BK;
    unsigned voffA[2], voffB[2];
#pragma unroll
    for (int i = 0; i < 2; ++i) { int R, C; stage_rc(tid * 16 + i * 8192, R, C); const int Rb = Epi::PERM ? ((R & ~31) + perm32(R & 31)) : R;
        voffA[i] = (unsigned)(R * K + C) * 2u; voffB[i] = (unsigned)(Rb * K + C) * 2u; }
    const size_t kstep = (size_t)(BK * 2);
    const size_t hstep = (size_t)HALF * K * 2;
    const size_t tstep = 2 * hstep;
    const unsigned ldsw = (unsigned)wid * 1024u;
    const int aoff = lds_byte(wr * 64 + fr, fq * 8), boff = lds_byte(wc * 32 + fr, fq * 8);
#define PG8_SA(b, h) (((b) * 2 + (h)) * HTB)
#define PG8_SB(b, h) ((4 + (b) * 2 + (h)) * HTB)
#define PG8_STAGE(bufoff, gbase, voff) do { _Pragma("unroll") for (int _i = 0; _i < 2; ++_i) \
        __builtin_amdgcn_global_load_lds((const unsigned*)((const char*)(gbase) + (voff)[_i]), (LAS unsigned*)(lds + (bufoff) + ldsw + _i * 8192), 16, 0, 0); } while (0)
#define PG8_LDA(dst, b, h) do { _Pragma("unroll") for (int m = 0; m < 4; ++m) _Pragma("unroll") for (int k = 0; k < 2; ++k) dst[m][k] = *(const LAS half8*)(lds + PG8_SA(b, h) + aoff + m * 2048 + k * 1024); } while (0)
#define PG8_LDB(dst, b, h) do { _Pragma("unroll") for (int n = 0; n < 2; ++n) _Pragma("unroll") for (int k = 0; k < 2; ++k) dst[n][k] = *(const LAS half8*)(lds + PG8_SB(b, h) + boff + n * 2048 + k * 1024); } while (0)
#define PG8_MMA(ai, bj, At, Bt) do { __builtin_amdgcn_s_setprio(1); _Pragma("unroll") for (int m = 0; m < 4; ++m) _Pragma("unroll") for (int n = 0; n < 2; ++n) _Pragma("unroll") for (int k = 0; k < 2; ++k) \
        acc[ai][bj][m][n] = BF16 ? __builtin_amdgcn_mfma_f32_16x16x32_bf16(__builtin_bit_cast(bfx8, Bt[n][k]), __builtin_bit_cast(bfx8, At[m][k]), acc[ai][bj][m][n], 0, 0, 0) \
                                 : __builtin_amdgcn_mfma_f32_16x16x32_f16(Bt[n][k], At[m][k], acc[ai][bj][m][n], 0, 0, 0); __builtin_amdgcn_s_setprio(0); } while (0)
#define PG8_WAIT_V(n) asm volatile("s_waitcnt vmcnt(" #n ")" ::: "memory")
#define PG8_WAIT_L(n) asm volatile("s_waitcnt lgkmcnt(" #n ")" ::: "memory")
#define PG8_BAR __builtin_amdgcn_s_barrier()
#define PG8_SCHED __builtin_amdgcn_sched_barrier(0)
    Unit cur, nxt; int ui = 0;
    if (!S.next(0, cur)) return;
    f32x4 acc[2][2][4][2];
#pragma unroll
    for (int a = 0; a < 2; ++a)
#pragma unroll
        for (int b = 0; b < 2; ++b)
#pragma unroll
            for (int m = 0; m < 4; ++m)
#pragma unroll
                for (int n = 0; n < 2; ++n) acc[a][b][m][n] = (f32x4){0.f, 0.f, 0.f, 0.f};
    half8 At[4][2], B0[2][2], B1[2][2];
    const char* cA = (const char*)g.A + (size_t)cur.pm * tstep; const char* cB = (const char*)g.Bt + (size_t)cur.pn * tstep;
    S.a_ready(cur);
    if constexpr (SP2) {
        PG8_STAGE(PG8_SB(0, 0), cB, voffB); PG8_STAGE(PG8_SB(0, 1), cB + hstep, voffB); PG8_STAGE(PG8_SA(0, 0), cA, voffA); PG8_STAGE(PG8_SA(0, 1), cA + hstep, voffA);
        if (wr == 1) PG8_BAR;
        PG8_WAIT_V(2); PG8_BAR;
        PG8_STAGE(PG8_SB(1, 0), cB + kstep, voffB); PG8_STAGE(PG8_SA(1, 0), cA + kstep, voffA); PG8_STAGE(PG8_SB(1, 1), cB + hstep + kstep, voffB);
        PG8_WAIT_V(6); PG8_BAR;
    } else {
        PG8_STAGE(PG8_SB(0, 0), cB, voffB); PG8_STAGE(PG8_SA(0, 0), cA, voffA); PG8_STAGE(PG8_SB(0, 1), cB + hstep, voffB); PG8_STAGE(PG8_SA(0, 1), cA + hstep, voffA);
        if (wr == 1) PG8_BAR;
        PG8_WAIT_V(4); PG8_BAR;
        PG8_STAGE(PG8_SB(1, 0), cB + kstep, voffB); PG8_STAGE(PG8_SA(1, 0), cA + kstep, voffA); PG8_STAGE(PG8_SB(1, 1), cB + hstep + kstep, voffB);
        PG8_WAIT_V(6); PG8_BAR;
    }
    for (;;) {
        const bool has_next = S.next(ui + 1, nxt);
        const char* nA = has_next ? (const char*)g.A + (size_t)nxt.pm * tstep : cA; const char* nB = has_next ? (const char*)g.Bt + (size_t)nxt.pn * tstep : cB;
        for (int t = 0; t < nt; t += 2) {
            const bool last = (t == nt - 2);
            const char* a1 = cA + (size_t)(t + 1) * kstep;
            const char* a2 = last ? nA : cA + (size_t)(t + 2) * kstep; const char* b2 = last ? nB : cB + (size_t)(t + 2) * kstep;
            const char* a3 = a2 + kstep; const char* b3 = b2 + kstep;
            if (last && has_next) S.a_ready(nxt);
            if constexpr (SP2) {
            PG8_LDB(B0, 0, 0); PG8_LDB(B1, 0, 1); PG8_SCHED; PG8_LDA(At, 0, 0); PG8_STAGE(PG8_SA(1, 1), a1 + hstep, voffA);
            PG8_WAIT_V(8); PG8_WAIT_L(0); PG8_BAR; PG8_MMA(0, 0, At, B0); PG8_MMA(0, 1, At, B1); PG8_BAR; PG8_SCHED;
            PG8_LDA(At, 0, 1); PG8_STAGE(PG8_SB(0, 0), b2, voffB); PG8_STAGE(PG8_SB(0, 1), b2 + hstep, voffB); PG8_STAGE(PG8_SA(0, 0), a2, voffA);
            PG8_WAIT_V(8); PG8_WAIT_L(0); PG8_BAR; PG8_MMA(1, 0, At, B0); PG8_MMA(1, 1, At, B1); PG8_BAR; PG8_SCHED;
            PG8_LDB(B0, 1, 0); PG8_LDB(B1, 1, 1); PG8_SCHED; PG8_LDA(At, 1, 0); PG8_STAGE(PG8_SA(0, 1), a2 + hstep, voffA);
            PG8_WAIT_V(8); PG8_WAIT_L(0); PG8_BAR; PG8_MMA(0, 0, At, B0); PG8_MMA(0, 1, At, B1); PG8_BAR; PG8_SCHED;
            PG8_LDA(At, 1, 1); PG8_STAGE(PG8_SB(1, 0), b3, voffB); PG8_STAGE(PG8_SB(1, 1), b3 + hstep, voffB); PG8_STAGE(PG8_SA(1, 0), a3, voffA);
            PG8_WAIT_V(8); PG8_WAIT_L(0); PG8_BAR; PG8_MMA(1, 0, At, B0); PG8_MMA(1, 1, At, B1); PG8_BAR; PG8_SCHED;
            } else {
            PG8_LDB(B0, 0, 0); PG8_SCHED; PG8_LDA(At, 0, 0); PG8_STAGE(PG8_SA(1, 1), a1 + hstep, voffA);
            PG8_WAIT_L(8); PG8_BAR; PG8_WAIT_L(0); PG8_MMA(0, 0, At, B0); PG8_BAR; PG8_SCHED;
            PG8_LDB(B1, 0, 1); PG8_STAGE(PG8_SB(0, 0), b2, voffB);
            PG8_BAR; PG8_WAIT_L(0); PG8_MMA(0, 1, At, B1); PG8_BAR;
            PG8_LDA(At, 0, 1); PG8_STAGE(PG8_SA(0, 0), a2, voffA);
            PG8_BAR; PG8_WAIT_L(0); PG8_MMA(1, 0, At, B0); PG8_BAR; PG8_SCHED;
            PG8_STAGE(PG8_SB(0, 1), b2 + hstep, voffB);
            PG8_WAIT_V(6); PG8_BAR; PG8_MMA(1, 1, At, B1); PG8_BAR;
            PG8_LDB(B0, 1, 0); PG8_SCHED; PG8_LDA(At, 1, 0); PG8_STAGE(PG8_SA(0, 1), a2 + hstep, voffA);
            PG8_WAIT_L(8); PG8_BAR; PG8_WAIT_L(0); PG8_MMA(0, 0, At, B0); PG8_BAR; PG8_SCHED;
            PG8_LDB(B1, 1, 1); PG8_STAGE(PG8_SB(1, 0), b3, voffB);
            PG8_BAR; PG8_WAIT_L(0); PG8_MMA(0, 1, At, B1); PG8_BAR;
            PG8_LDA(At, 1, 1); PG8_STAGE(PG8_SA(1, 0), a3, voffA);
            PG8_BAR; PG8_WAIT_L(0); PG8_MMA(1, 0, At, B0); PG8_BAR; PG8_SCHED;
            PG8_STAGE(PG8_SB(1, 1), b3 + hstep, voffB);
            PG8_WAIT_V(6); PG8_BAR; PG8_MMA(1, 1, At, B1); PG8_BAR;
            }
        }
        if constexpr (ALIGN_EPI) { if (wr == 0) PG8_BAR; }
        E(acc, cur, wr, wc, fr, fq); S.done(cur);
        if (!has_next) break;
#pragma unroll
        for (int a = 0; a < 2; ++a)
#pragma unroll
            for (int b = 0; b < 2; ++b)
#pragma unroll
                for (int m = 0; m < 4; ++m)
#pragma unroll
                    for (int n = 0; n < 2; ++n) acc[a][b][m][n] = (f32x4){0.f, 0.f, 0.f, 0.f};
        cur = nxt; cA = nA; cB = nB; ++ui;
        if constexpr (ALIGN_EPI) { if (wr == 1) PG8_BAR; }
    }
    PG8_WAIT_V(0);
    if constexpr (!ALIGN_EPI) { if (wr == 0) PG8_BAR; }
    PG8_BAR;
#undef PG8_SA
#undef PG8_SB
#undef PG8_STAGE
#undef PG8_LDA
#undef PG8_LDB
#undef PG8_MMA
#undef PG8_WAIT_V
#undef PG8_WAIT_L
#undef PG8_BAR
#undef PG8_SCHED
}
}

__device__ __forceinline__ float wave_sum(float v) {
#pragma unroll
    for (int o = 1; o < 64; o <<= 1) v += __shfl_xor(v, o);
    return v;
}
__device__ __forceinline__ float wave_max(float v) {
#pragma unroll
    for (int o = 1; o < 64; o <<= 1) v = fmaxf(v, __shfl_xor(v, o));
    return v;
}
__device__ __forceinline__ float bcast_lane(float v, int j) { return __builtin_bit_cast(float, __builtin_amdgcn_readlane(__builtin_bit_cast(int, v), j)); }

struct Ptrs {
    const float* in[21]; float* out; unsigned char* ws;
};

constexpr int P0_ADA = 192, P0_B1 = 64;
constexpr int P0_TWIN = 32 * 23, P0_TWOUT = 32 * 8, P0_TW1 = 32 * 32, P0_TW2 = 128 * 8, P0_TC1 = 64 * 1, P0_TC2 = 4 * 1;
constexpr int P0_OFF_B1 = P0_ADA, P0_OFF_TWIN = P0_OFF_B1 + P0_B1, P0_OFF_TWOUT = P0_OFF_TWIN + P0_TWIN, P0_OFF_TW1 = P0_OFF_TWOUT + P0_TWOUT,
              P0_OFF_TW2 = P0_OFF_TW1 + P0_TW1, P0_OFF_TC1K = P0_OFF_TW2 + P0_TW2, P0_OFF_TC1V = P0_OFF_TC1K + P0_TC1, P0_OFF_TC2K = P0_OFF_TC1V + P0_TC1,
              P0_OFF_TC2V = P0_OFF_TC2K + P0_TC2, P0_ITEMS = P0_OFF_TC2V + P0_TC2;

__device__ __forceinline__ void transpose_tile(const float* __restrict__ W, int K, int N, int Nout, h16* __restrict__ Wt, int item, LAS float* scr, int tid, bool bf = false) {
    const int nkt = K / 64; const int kt = item % nkt, ntl = item / nkt;
    { const int c4 = tid & 63, r = tid >> 6; f32x4 v[8];
#pragma unroll
      for (int i = 0; i < 8; ++i) { const int k = kt * 64 + r + 8 * i, n = ntl * 256 + 4 * c4;
          v[i] = (f32x4){0.f, 0.f, 0.f, 0.f}; if (n < N) v[i] = *(const f32x4*)(W + (size_t)k * N + n); }
#pragma unroll
      for (int i = 0; i < 8; ++i) *(LAS f32x4*)(scr + (r + 8 * i) * 260 + 4 * c4) = v[i]; }
    __syncthreads();
    { const int n = tid >> 1, hf = tid & 1;
      if (ntl * 256 + n < Nout) {
#pragma unroll
          for (int q = 0; q < 4; ++q) { float f[8];
#pragma unroll
              for (int j = 0; j < 8; ++j) f[j] = scr[(32 * hf + 8 * q + j) * 260 + n];
              u32x4 o;
              if (bf) { o.x = pg8::pk_bf2(f[0], f[1]); o.y = pg8::pk_bf2(f[2], f[3]); o.z = pg8::pk_bf2(f[4], f[5]); o.w = pg8::pk_bf2(f[6], f[7]); }
              else    { o.x = pg8::pk_h2(f[0], f[1]);  o.y = pg8::pk_h2(f[2], f[3]);  o.z = pg8::pk_h2(f[4], f[5]);  o.w = pg8::pk_h2(f[6], f[7]); }
              *(u32x4*)(Wt + (size_t)(ntl * 256 + n) * K + kt * 64 + 32 * hf + 8 * q) = o; } } }
    __syncthreads();
}

__device__ __forceinline__ void p0_prologue(const Ptrs& P, LAS unsigned char* lds, int G, int bid) {
    const int tid = threadIdx.x;
    LAS float* scr = (LAS float*)lds;
    unsigned char* ws = P.ws;
    for (int it = bid; it < P0_ITEMS; it += G) {
        if (it < P0_ADA) {
            LAS float* sc = scr;
            LAS float* red = scr + 8192;
            const float* c = P.in[1];
            for (int i = tid; i < 8192; i += NTHR) { const float v = c[i]; sc[i] = v / (1.f + __expf(-v)); }
            __syncthreads();
            const int cl = tid & 15, kg = tid >> 4;
            f32x4 a0 = {0, 0, 0, 0}, a1 = a0, a2 = a0, a3 = a0;
            const float* W = P.in[2] + 64 * it + 4 * cl;
#pragma unroll 8
            for (int k = kg; k < 2048; k += 32) { const f32x4 w = *(const f32x4*)(W + (size_t)k * 12288);
                a0 += sc[k] * w; a1 += sc[2048 + k] * w; a2 += sc[4096 + k] * w; a3 += sc[6144 + k] * w; }
#pragma unroll
            for (int j = 0; j < 4; ++j) { red[(kg * 4 + 0) * 64 + 4 * cl + j] = a0[j]; red[(kg * 4 + 1) * 64 + 4 * cl + j] = a1[j];
                red[(kg * 4 + 2) * 64 + 4 * cl + j] = a2[j]; red[(kg * 4 + 3) * 64 + 4 * cl + j] = a3[j]; }
            __syncthreads();
            if (tid < 256) { const int b = tid >> 6, col = tid & 63; float s = 0.f;
                for (int q = 0; q < 32; ++q) s += red[(q * 4 + b) * 64 + col];
                ((float*)(ws + WS_MOD))[b * 12288 + 64 * it + col] = s + P.in[3][64 * it + col]; }
            __syncthreads();
        } else if (it < P0_OFF_TWIN) {
            const int q = it - P0_OFF_B1, kv = q >> 5, part = q & 31;
            const float* pe = P.in[8 + kv]; const float* W1 = P.in[kv ? 12 : 10];
            const int col = tid & 255, kh = tid >> 8; float s = 0.f;
            for (int k = 128 * part + 64 * kh; k < 128 * part + 64 * kh + 64; ++k) s += pe[k] * W1[(size_t)k * 256 + col];
            scr[tid] = s; __syncthreads();
            if (tid < 256) ((float*)(ws + WS_B1P))[(kv * 32 + part) * 256 + tid] = scr[tid] + scr[tid + 256];
            __syncthreads();
        } else if (it < P0_OFF_TWOUT) transpose_tile(P.in[5], DM, DIN, DINP, (h16*)(ws + WS_WIN), it - P0_OFF_TWIN, scr, tid);
        else if (it < P0_OFF_TW1)     transpose_tile(P.in[16], DM, DM, DM, (h16*)(ws + WS_WOUT), it - P0_OFF_TWOUT, scr, tid, true);
        else if (it < P0_OFF_TW2)     transpose_tile(P.in[18], DM, DFF, DFF, (h16*)(ws + WS_W1), it - P0_OFF_TW1, scr, tid, true);
        else if (it < P0_OFF_TC1K)    transpose_tile(P.in[19], DFF, DM, DM, (h16*)(ws + WS_W2), it - P0_OFF_TW2, scr, tid, true);
        else if (it < P0_OFF_TC1V)    transpose_tile(P.in[10], 4096, 256, 256, (h16*)(ws + WS_CW1K), it - P0_OFF_TC1K, scr, tid);
        else if (it < P0_OFF_TC2K)    transpose_tile(P.in[12], 4096, 256, 256, (h16*)(ws + WS_CW1V), it - P0_OFF_TC1V, scr, tid);
        else if (it < P0_OFF_TC2V)    transpose_tile(P.in[11], 256, 128, 128, (h16*)(ws + WS_CW2K), it - P0_OFF_TC2K, scr, tid);
        else                          transpose_tile(P.in[13], 256, 128, 128, (h16*)(ws + WS_CW2V), it - P0_OFF_TC2V, scr, tid);
    }
}

template <bool BF, bool IN_F16> __device__ __forceinline__ void norm_mod_rows(const void* __restrict__ Xv, const float* __restrict__ gw, const float* __restrict__ mod, int sh_off, int sc_off,
                                              h16* __restrict__ H, int G, int bid) {
    const int lane = threadIdx.x & 63, wave = threadIdx.x >> 6;
    for (int r = bid * 8 + wave; r < NT; r += G * 8) {
        const int b = r >> 13; f32x4 v[8]; float ss = 0.f;
        if (IN_F16) { const h16* xr = (const h16*)Xv + (size_t)r * DM;
#pragma unroll
            for (int i = 0; i < 8; ++i) { const half4 hv = *(const half4*)(xr + 4 * (lane + 64 * i)); v[i] = (f32x4){(float)hv[0], (float)hv[1], (float)hv[2], (float)hv[3]}; } }
        else { const float* xr = (const float*)Xv + (size_t)r * DM;
#pragma unroll
            for (int i = 0; i < 8; ++i) v[i] = *(const f32x4*)(xr + 4 * (lane + 64 * i)); }
#pragma unroll
        for (int i = 0; i < 8; ++i) ss += v[i][0] * v[i][0] + v[i][1] * v[i][1] + v[i][2] * v[i][2] + v[i][3] * v[i][3];
        ss = wave_sum(ss); const float rstd = rsqrtf(ss * (1.f / DM) + EPS);
        const float* mb = mod + (size_t)b * 12288;
#pragma unroll
        for (int i = 0; i < 8; ++i) { const int c = 4 * (lane + 64 * i);
            const f32x4 g = *(const f32x4*)(gw + c), sh = *(const f32x4*)(mb + sh_off + c), sc = *(const f32x4*)(mb + sc_off + c);
            const f32x4 o = (v[i] * rstd) * g * (1.f + sc) + sh;
            u32x2 w; w.x = pg8::pk2<BF>(o[0], o[1]); w.y = pg8::pk2<BF>(o[2], o[3]);
            *(u32x2*)(H + (size_t)r * DM + c) = w; }
    }
}
__device__ __forceinline__ void final_norm_rows(const h16* __restrict__ X, float* __restrict__ O, const float* __restrict__ gw, int G, int bid) {
    const int lane = threadIdx.x & 63, wave = threadIdx.x >> 6;
    for (int r = bid * 8 + wave; r < NT; r += G * 8) {
        const h16* xr = X + (size_t)r * DM; f32x4 v[8]; float ss = 0.f;
#pragma unroll
        for (int i = 0; i < 8; ++i) { const half4 hv = *(const half4*)(xr + 4 * (lane + 64 * i)); v[i] = (f32x4){(float)hv[0], (float)hv[1], (float)hv[2], (float)hv[3]};
            ss += v[i][0] * v[i][0] + v[i][1] * v[i][1] + v[i][2] * v[i][2] + v[i][3] * v[i][3]; }
        ss = wave_sum(ss); const float rstd = rsqrtf(ss * (1.f / DM) + EPS);
#pragma unroll
        for (int i = 0; i < 8; ++i) { const int c = 4 * (lane + 64 * i); const f32x4 g = *(const f32x4*)(gw + c); *(f32x4*)(O + (size_t)r * DM + c) = (v[i] * rstd) * g; }
    }
}

__device__ __forceinline__ void post_u_rows(const Ptrs& P, int G, int bid) {
    const int lane = threadIdx.x & 63, wave = threadIdx.x >> 6;
    h16* U = (h16*)(P.ws + WS_U); h16* MIX = (h16*)(P.ws + WS_H);
    const float* cw = P.in[6]; const float* cb = P.in[7]; const float* gcv = P.in[14];
    const int hsel = lane >> 3, c8 = lane & 7;
    float inv[8];
#pragma unroll
    for (int e = 0; e < 8; ++e) inv[e] = (float)exp2(-(double)(8 * c8 + e) * (13.287712379549449 / 64.0));
    float wcb[16], wc0[16], wc1[16], wc2[16], wg[16];
#pragma unroll
    for (int hf = 0; hf < 2; ++hf)
#pragma unroll
        for (int j = 0; j < 8; ++j) { const int ch = 512 * hf + 8 * lane + j; wcb[8 * hf + j] = cb[ch]; wc0[8 * hf + j] = cw[ch]; wc1[8 * hf + j] = cw[1024 + ch]; wc2[8 * hf + j] = cw[2048 + ch]; wg[8 * hf + j] = gcv[ch]; }
    for (int r = bid * 8 + wave; r < NT; r += G * 8) {
        const int pos = r & (SEQ - 1); h16* u = U + (size_t)r * DINP;
        float cs[8], sn[8];
#pragma unroll
        for (int e = 0; e < 8; ++e) { const float ang = (float)pos * inv[e];
            double rev = (double)ang * 0.15915494309189535; rev -= __builtin_rint(rev);
            const float rf = (float)rev; cs[e] = __builtin_amdgcn_cosf(rf); sn[e] = __builtin_amdgcn_sinf(rf); }
#pragma unroll
        for (int rd = 0; rd < 2; ++rd) {
            const int base = rd == 0 ? OFF_Q + 128 * hsel : (hsel < 2 ? OFF_KC + 128 * hsel : (hsel < 4 ? OFF_KS + 128 * (hsel - 2) : OFF_KW + 128 * (hsel - 4)));
            if (rd == 0 || hsel < 6) {
                const half8 x1 = *(const half8*)(u + base + 8 * c8), x2 = *(const half8*)(u + base + 64 + 8 * c8); half8 o1, o2;
#pragma unroll
                for (int e = 0; e < 8; ++e) { const float a = (float)x1[e], bq = (float)x2[e]; o1[e] = (h16)(a * cs[e] - bq * sn[e]); o2[e] = (h16)(bq * cs[e] + a * sn[e]); }
                *(half8*)(u + base + 8 * c8) = o1; *(half8*)(u + base + 64 + 8 * c8) = o2; }
        }
        float y[16]; float ss = 0.f;
#pragma unroll
        for (int hf = 0; hf < 2; ++hf) {
            const int ch = 512 * hf + 8 * lane;
            const half8 ub = *(const half8*)(u + OFF_UB + ch), c0 = *(const half8*)(u + OFF_UC + ch), h0 = *(const half8*)(u + OFF_UH + ch);
            half8 c1 = c0 * (h16)0, h1 = c1, c2 = c1, h2 = c1;
            if (pos >= 1) { c1 = *(const half8*)(u - DINP + OFF_UC + ch); h1 = *(const half8*)(u - DINP + OFF_UH + ch); }
            if (pos >= 2) { c2 = *(const half8*)(u - 2 * DINP + OFF_UC + ch); h2 = *(const half8*)(u - 2 * DINP + OFF_UH + ch); }
#pragma unroll
            for (int j = 0; j < 8; ++j) {
                const float v0 = (float)c0[j] * (float)h0[j], v1 = (float)c1[j] * (float)h1[j], v2 = (float)c2[j] * (float)h2[j];
                const float z = wcb[8 * hf + j] + wc0[8 * hf + j] * v2 + wc1[8 * hf + j] * v1 + wc2[8 * hf + j] * v0;
                const float yy = (float)ub[j] * z; y[8 * hf + j] = yy; ss += yy * yy; }
        }
        ss = wave_sum(ss); const float rstd = rsqrtf(ss * (1.f / 1024.f) + EPS);
#pragma unroll
        for (int hf = 0; hf < 2; ++hf) { const int ch = 512 * hf + 8 * lane; float f[8];
#pragma unroll
            for (int j = 0; j < 8; ++j) f[j] = y[8 * hf + j] * rstd * wg[8 * hf + j];
            u32x4 o; o.x = pg8::pk_bf2(f[0], f[1]); o.y = pg8::pk_bf2(f[2], f[3]); o.z = pg8::pk_bf2(f[4], f[5]); o.w = pg8::pk_bf2(f[6], f[7]);
            *(u32x4*)(MIX + (size_t)r * DM + ch) = o; }
    }
}

__device__ __forceinline__ float gelu_tanh(float x) {
    const float z = 0.7978845608028654f * (x + 0.044715f * x * x * x);
    const float e = __expf(2.f * z);
    const float th = 1.f - 2.f / (e + 1.f);
    return 0.5f * x * (1.f + th);
}
__device__ __forceinline__ void compress_phase(const Ptrs& P, LAS unsigned char* lds, int G, int bid) {
    const int tid = threadIdx.x, lane = tid & 63, w = tid >> 6, fr = lane & 15, fq = lane >> 4;
    const h16* U = (const h16*)(P.ws + WS_U);
    LAS h16* hid = (LAS h16*)lds;
    for (int unit = bid; unit < 256; unit += G) {
        const int kv = unit >> 7, bg = (unit >> 4) & 7, nb = unit & 15, b = bg >> 1, g = bg & 1, n0 = nb * 32;
        const h16* W1t = (const h16*)(P.ws + (kv ? WS_CW1V : WS_CW1K));
        const h16* W2t = (const h16*)(P.ws + (kv ? WS_CW2V : WS_CW2K));
        const float* b1p = (const float*)(P.ws + WS_B1P) + kv * 32 * 256;
        h16* OUT = (h16*)(P.ws + (kv ? WS_VCMP : WS_KCMP)) + (size_t)bg * 512 * 128;
        const int coff = (kv ? OFF_VC : OFF_KC) + g * 128;
        f32x4 acc[2][2];
#pragma unroll
        for (int i = 0; i < 2; ++i)
#pragma unroll
            for (int j = 0; j < 2; ++j) acc[i][j] = (f32x4){0.f, 0.f, 0.f, 0.f};
        half8 fa[2][4][2], fb[2][4][2];
        half8 zero8;
#pragma unroll
        for (int j = 0; j < 8; ++j) zero8[j] = (h16)0.f;
        const h16* arow[2]; bool aok0[2];
#pragma unroll
        for (int mt = 0; mt < 2; ++mt) arow[mt] = U + (size_t)(b * SEQ + 16 * (n0 + 16 * mt + fr)) * DINP + coff + 8 * fq;
        const h16* brow[2];
#pragma unroll
        for (int nt = 0; nt < 2; ++nt) brow[nt] = W1t + (size_t)(32 * w + 16 * nt + fr) * 4096 + 8 * fq;
        (void)aok0;
#define CP_LOAD(buf_, pos_) do { _Pragma("unroll") for (int ks = 0; ks < 4; ++ks) { \
            _Pragma("unroll") for (int mt = 0; mt < 2; ++mt) { const int tok = 16 * (n0 + 16 * mt + fr) + (pos_); \
                fa[buf_][ks][mt] = tok < SEQ ? *(const half8*)(arow[mt] + (size_t)(pos_) * DINP + 32 * ks) : zero8; } \
            _Pragma("unroll") for (int nt = 0; nt < 2; ++nt) fb[buf_][ks][nt] = *(const half8*)(brow[nt] + (pos_) * 128 + 32 * ks); } } while (0)
#define CP_MMA(buf_) do { _Pragma("unroll") for (int ks = 0; ks < 4; ++ks) _Pragma("unroll") for (int mt = 0; mt < 2; ++mt) _Pragma("unroll") for (int nt = 0; nt < 2; ++nt) \
            acc[mt][nt] = __builtin_amdgcn_mfma_f32_16x16x32_f16(fa[buf_][ks][mt], fb[buf_][ks][nt], acc[mt][nt], 0, 0, 0); } while (0)
        CP_LOAD(0, 0);
#pragma unroll 1
        for (int pos = 0; pos < 32; pos += 2) {
            CP_LOAD(1, pos + 1);
            CP_MMA(0);
            if (pos + 2 < 32) CP_LOAD(0, pos + 2);
            CP_MMA(1);
        }
#undef CP_LOAD
#undef CP_MMA
#pragma unroll
        for (int nt = 0; nt < 2; ++nt) { const int col = 32 * w + 16 * nt + fr; float bias = 0.f;
            for (int q = 0; q < 32; ++q) bias += b1p[q * 256 + col];
#pragma unroll
            for (int mt = 0; mt < 2; ++mt)
#pragma unroll
                for (int j = 0; j < 4; ++j) hid[(16 * mt + 4 * fq + j) * 264 + col] = (h16)gelu_tanh(acc[mt][nt][j] + bias); }
        __syncthreads();
        f32x4 acc2[2]; acc2[0] = (f32x4){0.f, 0.f, 0.f, 0.f}; acc2[1] = acc2[0];
#pragma unroll
        for (int ks = 0; ks < 8; ++ks) {
            const half8 bb = *(const half8*)(W2t + (size_t)(16 * w + fr) * 256 + 32 * ks + 8 * fq);
#pragma unroll
            for (int mt = 0; mt < 2; ++mt) { const half8 a = *(const LAS half8*)(hid + (16 * mt + fr) * 264 + 32 * ks + 8 * fq);
                acc2[mt] = __builtin_amdgcn_mfma_f32_16x16x32_f16(a, bb, acc2[mt], 0, 0, 0); }
        }
#pragma unroll
        for (int mt = 0; mt < 2; ++mt)
#pragma unroll
            for (int j = 0; j < 4; ++j) OUT[(size_t)(n0 + 16 * mt + 4 * fq + j) * 128 + 16 * w + fr] = (h16)acc2[mt][j];
        __syncthreads();
    }
}

typedef short s16x4 __attribute__((ext_vector_type(4)));
typedef short s16x8 __attribute__((ext_vector_type(8)));
template <bool a0, bool a1> __device__ __forceinline__ void af_qk(const LAS unsigned char* kbuf, const unsigned (&kl)[4], const half8 (&qf)[2][4], f32x4 (&s)[2][4]) {
    const LAS unsigned char* ka[4];
    { int _ln; asm volatile("v_mov_b32 %0, %1" : "=v"(_ln) : "v"(kl[0]));
      const int fr_ = _ln & 15, e_ = (_ln >> 4) ^ fr_;
#pragma unroll
      for (int ks = 0; ks < 4; ++ks) ka[ks] = kbuf + fr_ * 256 + ((e_ ^ (4 * ks)) << 4); }
    half8 kf[2][4];
#pragma unroll
    for (int ks = 0; ks < 4; ++ks) kf[0][ks] = *(const LAS half8*)(ka[ks]);
#pragma unroll
    for (int kt = 0; kt < 4; ++kt) {
        if (kt < 3) {
#pragma unroll
            for (int ks = 0; ks < 4; ++ks) kf[(kt + 1) & 1][ks] = *(const LAS half8*)(ka[ks] + (kt + 1) * 4096); }
        s[0][kt] = (f32x4){0.f, 0.f, 0.f, 0.f}; s[1][kt] = (f32x4){0.f, 0.f, 0.f, 0.f};
#pragma unroll
        for (int ks = 0; ks < 4; ++ks) {
            if (a0) s[0][kt] = __builtin_amdgcn_mfma_f32_16x16x32_f16(kf[kt & 1][ks], qf[0][ks], s[0][kt], 0, 0, 0);
            if (a1) s[1][kt] = __builtin_amdgcn_mfma_f32_16x16x32_f16(kf[kt & 1][ks], qf[1][ks], s[1][kt], 0, 0, 0); }
        __builtin_amdgcn_sched_barrier(0);
    }
}
template <bool a0, bool a1> __device__ __forceinline__ void af_pv(const LAS unsigned char* vbuf, unsigned vl0, int z, const half8 (&pf)[2][2], f32x4 (&o)[2][8]) {
    const unsigned rb = (unsigned)(__UINTPTR_TYPE__)(vbuf + vl0);
    s16x4 vr[2][8];
#define AF_VLOAD(buf_, dt_) asm volatile("ds_read_b64_tr_b16 %0, %8\n\tds_read_b64_tr_b16 %1, %8 offset:4096\n\tds_read_b64_tr_b16 %2, %8 offset:8192\n\tds_read_b64_tr_b16 %3, %8 offset:12288\n\t" \
        "ds_read_b64_tr_b16 %4, %9\n\tds_read_b64_tr_b16 %5, %9 offset:4096\n\tds_read_b64_tr_b16 %6, %9 offset:8192\n\tds_read_b64_tr_b16 %7, %9 offset:12288" \
        : "=&v"(vr[buf_][0]), "=&v"(vr[buf_][1]), "=&v"(vr[buf_][2]), "=&v"(vr[buf_][3]), "=&v"(vr[buf_][4]), "=&v"(vr[buf_][5]), "=&v"(vr[buf_][6]), "=&v"(vr[buf_][7]) \
        : "v"(rb + ((unsigned)((dt_) ^ z) << 5)), "v"(rb + ((unsigned)(((dt_) + 1) ^ z) << 5)) : "memory")
#define AF_VWAIT(buf_, n_) asm volatile("s_waitcnt lgkmcnt(" #n_ ")" : "+v"(vr[buf_][0]), "+v"(vr[buf_][1]), "+v"(vr[buf_][2]), "+v"(vr[buf_][3]), "+v"(vr[buf_][4]), "+v"(vr[buf_][5]), "+v"(vr[buf_][6]), "+v"(vr[buf_][7]) :: "memory")
#define AF_VMMA(buf_, dt0_) do { _Pragma("unroll") for (int dd = 0; dd < 2; ++dd) _Pragma("unroll") for (int kp = 0; kp < 2; ++kp) { \
            const s16x4 lo = vr[buf_][4 * dd + 2 * kp], hi = vr[buf_][4 * dd + 2 * kp + 1]; \
            s16x8 v8; v8[0] = lo[0]; v8[1] = lo[1]; v8[2] = lo[2]; v8[3] = lo[3]; v8[4] = hi[0]; v8[5] = hi[1]; v8[6] = hi[2]; v8[7] = hi[3]; \
            const half8 vf = __builtin_bit_cast(half8, v8); \
            if (a0) o[0][(dt0_) + dd] = __builtin_amdgcn_mfma_f32_16x16x32_f16(vf, pf[0][kp], o[0][(dt0_) + dd], 0, 0, 0); \
            if (a1) o[1][(dt0_) + dd] = __builtin_amdgcn_mfma_f32_16x16x32_f16(vf, pf[1][kp], o[1][(dt0_) + dd], 0, 0, 0); } \
        __builtin_amdgcn_sched_barrier(0); } while (0)
    AF_VLOAD(0, 0); AF_VLOAD(1, 2);
    AF_VWAIT(0, 8); AF_VMMA(0, 0); AF_VLOAD(0, 4);
    AF_VWAIT(1, 8); AF_VMMA(1, 2); AF_VLOAD(1, 6);
    AF_VWAIT(0, 8); AF_VMMA(0, 4);
    AF_VWAIT(1, 0); AF_VMMA(1, 6);
#undef AF_VMMA
#undef AF_VLOAD
#undef AF_VWAIT
}
__device__ __forceinline__ void af_maskraw(f32x4 (&s)[4], int mbase, int mstep, int fq, int hi, int lo) {
#pragma unroll
    for (int kt = 0; kt < 4; ++kt)
#pragma unroll
        for (int jj = 0; jj < 4; ++jj) { const int met = mbase + mstep * (16 * kt + 4 * fq + jj); s[kt][jj] = (met <= hi && met > lo) ? s[kt][jj] : -3.0e38f; }
}
__device__ __forceinline__ float af_colmax(const f32x4 (&s)[4]) {
    float v = -1.0e30f;
#pragma unroll
    for (int kt = 0; kt < 4; ++kt) v = fmaxf(v, fmaxf(fmaxf(s[kt][0], s[kt][1]), fmaxf(s[kt][2], s[kt][3])));
    v = fmaxf(v, __shfl_xor(v, 16)); v = fmaxf(v, __shfl_xor(v, 32)); return v;
}
__device__ __forceinline__ void af_pack(const f32x4 (&s)[4], half8 (&pf)[2]) {
#pragma unroll
    for (int kp = 0; kp < 2; ++kp) { half8 h;
#pragma unroll
        for (int jj = 0; jj < 4; ++jj) { h[jj] = (h16)s[2 * kp][jj]; h[4 + jj] = (h16)s[2 * kp + 1][jj]; }
        pf[kp] = h; }
}
__device__ __forceinline__ float af_rawmax(const f32x4 (&s)[4]) {
    float v = fmaxf(fmaxf(s[0][0], s[0][1]), fmaxf(s[0][2], s[0][3]));
#pragma unroll
    for (int kt = 1; kt < 4; ++kt) v = fmaxf(v, fmaxf(fmaxf(s[kt][0], s[kt][1]), fmaxf(s[kt][2], s[kt][3])));
    v = fmaxf(v, __shfl_xor(v, 16)); v = fmaxf(v, __shfl_xor(v, 32)); return v;
}
__device__ __forceinline__ void af_online_fast(f32x4 (&s)[4], bool colsel, float& m, float& l, f32x4 (&o)[8], half8 (&pf)[2], float SC) {
    float lm = fmaxf(fmaxf(s[0][0], s[0][1]), fmaxf(s[0][2], s[0][3]));
#pragma unroll
    for (int kt = 1; kt < 4; ++kt) lm = fmaxf(lm, fmaxf(fmaxf(s[kt][0], s[kt][1]), fmaxf(s[kt][2], s[kt][3])));
    if (__ballot(colsel && (lm * SC > m + 8.f)) != 0ull) {
        float v = lm; v = fmaxf(v, __shfl_xor(v, 16)); v = fmaxf(v, __shfl_xor(v, 32));
        const float mloc = colsel ? v * SC : -1.0e30f;
        const float mn = fmaxf(m, mloc); const float al = __builtin_amdgcn_exp2f(m - mn); m = mn;
        l *= al;
#pragma unroll
        for (int dt = 0; dt < 8; ++dt) o[dt] *= al;
    }
    const float bias = colsel ? -m : -1.0e30f; float ps = 0.f;
#pragma unroll
    for (int kt = 0; kt < 4; ++kt)
#pragma unroll
        for (int jj = 0; jj < 4; ++jj) { const float p = __builtin_amdgcn_exp2f(__builtin_fmaf(s[kt][jj], SC, bias)); s[kt][jj] = p; ps += p; }
    l += ps;
    af_pack(s, pf);
}
__device__ __forceinline__ float af_write(float* Y, size_t row, int colbase, const f32x4 (&o)[8], float sc, bool accumulate) {
    float ss = 0.f;
#pragma unroll
    for (int dt = 0; dt < 8; ++dt) { float* p = Y + row * 1024 + colbase + 16 * dt; f32x4 v = o[dt] * sc; if (accumulate) v += *(const f32x4*)p; *(f32x4*)p = v;
        ss += (v[0] * v[0] + v[1] * v[1]) + (v[2] * v[2] + v[3] * v[3]); }
    return ss;
}
__device__ __forceinline__ float af_sigmoid(float x) { return 1.f / (1.f + __expf(-x)); }

template <bool A0, bool A1>
__device__ __forceinline__ void af_tile_online(const LAS unsigned char* stage, const unsigned (&kl)[4], unsigned vl0, int vz, const half8 (&qf)[2][4], f32x4 (&s)[2][4],
                                               float (&m)[2], float (&l)[2], f32x4 (&o)[2][8], bool needmask, int mbase, int fq, const int (&hi)[2], const int (&lo)[2], float SC) {
    af_qk<A0, A1>(stage, kl, qf, s);
    half8 pf[2][2];
    if (A0) { if (needmask) af_maskraw(s[0], mbase, 1, fq, hi[0], lo[0]); af_online_fast(s[0], hi[0] >= 0, m[0], l[0], o[0], pf[0], SC); } else { pf[0][0] = qf[0][0]; pf[0][1] = qf[0][0]; }
    if (A1) { if (needmask) af_maskraw(s[1], mbase, 1, fq, hi[1], lo[1]); af_online_fast(s[1], hi[1] >= 0, m[1], l[1], o[1], pf[1], SC); } else { pf[1][0] = qf[1][0]; pf[1][1] = qf[1][0]; }
    af_pv<A0, A1>(stage + 16384, vl0, vz, pf, o);
}
#define AF_ISSUE(st_, kb_, vb_, gs_, r0_, needv_) do { int _ln; asm volatile("v_mov_b32 %0, %1" : "=v"(_ln) : "v"(lane)); \
      _Pragma("unroll") for (int _c = 0; _c < 2; ++_c) { const int _row = 8 * w + 4 * _c + (_ln >> 4); \
      const h16* _kp = (kb_) + (size_t)((r0_) + _row) * (gs_) + (((_ln & 15) ^ (_row & 15)) << 3); \
      __builtin_amdgcn_global_load_lds((const unsigned*)_kp, (LAS unsigned*)(lds + (st_) * 32768 + (2 * w + _c) * 1024), 16, 0, 0); \
      if (needv_) { const h16* _vp = (vb_) + (size_t)((r0_) + _row) * (gs_) + (((_ln & 15) ^ (2 * (_row & 7))) << 3); \
      __builtin_amdgcn_global_load_lds((const unsigned*)_vp, (LAS unsigned*)(lds + (st_) * 32768 + 16384 + (2 * w + _c) * 1024), 16, 0, 0); } } } while (0)
#define AF_WAITV(n) asm volatile("s_waitcnt vmcnt(" #n ")" ::: "memory")
#define AF_BAR() do { __builtin_amdgcn_s_barrier(); asm volatile("" ::: "memory"); } while (0)

__device__ __forceinline__ void attn_fast(const Ptrs& P, LAS unsigned char* lds, int G, int bid) {
    const int tid = threadIdx.x, lane = tid & 63, w = __builtin_amdgcn_readfirstlane(tid >> 6), fr = lane & 15, fq = lane >> 4, qi = fr >> 2, hh = fr & 3;
    LAS float* IMP = (LAS float*)(lds + 98304) + w * (8 * 132);
    LAS unsigned* SELM = (LAS unsigned*)(lds + 132096);
    const h16* U = (const h16*)(P.ws + WS_U); float* Y = (float*)(P.ws + WS_YACC);
    const float SC = 0.08838834764831845f * 1.4426950408889634f;
    const int NEGBIG = -(1 << 30);
    unsigned kl[4]; kl[0] = (unsigned)lane; kl[1] = kl[2] = kl[3] = 0u;
    const int vz = (4 * fq + (fr >> 2)) & 7;
    const unsigned vl0 = (unsigned)((4 * fq + (fr >> 2)) * 256 + 8 * (fr & 1) + 16 * ((fr >> 1) & 1));
    const int nunits = (512 + G - 1) / G;
#pragma unroll 1
    for (int ui = 0; ui < nunits; ++ui) {
        int b, qb;
        if (G == 256) { const int idx = (bid & 1) * 32 + (bid >> 3); b = (bid & 7) >> 1; qb = ui == 0 ? 127 - idx : idx; }
        else { const int u = ui * G + bid; if (u >= 512) break;
               b = u >> 7; qb = (((u & 1) ^ ((u >> 8) & 1)) != 0) ? 127 - ((u >> 1) & 63) : ((u >> 1) & 63); }
#pragma unroll 1
        for (int g = 0; g < 2; ++g) {
            const int bg = 2 * b + g;
            int tq[2]; tq[0] = 64 * qb + 8 * w + qi; tq[1] = tq[0] + 4;
            const h16* Ub = U + (size_t)b * SEQ * DINP;
            half8 qf[2][4];
#pragma unroll
            for (int ct = 0; ct < 2; ++ct)
#pragma unroll
                for (int ks = 0; ks < 4; ++ks) qf[ct][ks] = *(const half8*)(Ub + (size_t)tq[ct] * DINP + OFF_Q + (4 * g + hh) * 128 + 32 * ks + 8 * fq);
            for (int i = lane; i < 8 * 132; i += 64) IMP[i] = 0.f;
            f32x4 s[2][4];
            const h16* KC = (const h16*)(P.ws + WS_KCMP) + (size_t)bg * 512 * 128;
            const h16* VC = (const h16*)(P.ws + WS_VCMP) + (size_t)bg * 512 * 128;
            const int ntc = ((4 * qb + 2) >> 6) + 1;
            float m[2], l[2];
            m[0] = m[1] = -1.0e30f; l[0] = l[1] = 0.f;
            AF_ISSUE(0, KC, VC, 128, 0, false);
            if (ntc > 1) AF_ISSUE(1, KC, VC, 128, 64, false);
#pragma unroll 1
            for (int T = 0; T < ntc; ++T) {
                if (T + 1 < ntc) AF_WAITV(2); else AF_WAITV(0);
                AF_BAR();
                if (T + 2 < ntc) AF_ISSUE((T + 2) % 3, KC, VC, 128, 64 * (T + 2), false);
                af_qk<true, true>(lds + (T % 3) * 32768, kl, qf, s);
#pragma unroll
                for (int ct = 0; ct < 2; ++ct) {
                    if (1024 * T + 1039 > 64 * qb) af_maskraw(s[ct], 1024 * T + 31, 16, fq, tq[ct], NEGBIG);
                    const float mn = fmaxf(m[ct], af_rawmax(s[ct]) * SC); const float al = __builtin_amdgcn_exp2f(m[ct] - mn); m[ct] = mn; float ps = 0.f;
#pragma unroll
                    for (int kt = 0; kt < 4; ++kt)
#pragma unroll
                        for (int jj = 0; jj < 4; ++jj) ps += __builtin_amdgcn_exp2f(__builtin_fmaf(s[ct][kt][jj], SC, -mn));
                    l[ct] = l[ct] * al + ps; }
            }
            float il[2];
#pragma unroll
            for (int ct = 0; ct < 2; ++ct) { float lt = l[ct]; lt += __shfl_xor(lt, 16); lt += __shfl_xor(lt, 32); il[ct] = lt > 0.f ? 1.f / lt : 0.f; }
            f32x4 o[2][8];
#pragma unroll
            for (int ct = 0; ct < 2; ++ct)
#pragma unroll
                for (int dt = 0; dt < 8; ++dt) o[ct][dt] = (f32x4){0.f, 0.f, 0.f, 0.f};
            AF_BAR();
            AF_ISSUE(0, KC, VC, 128, 0, true);
            if (ntc > 1) AF_ISSUE(1, KC, VC, 128, 64, true);
#pragma unroll 1
            for (int T = 0; T < ntc; ++T) {
                if (T + 1 < ntc) AF_WAITV(4); else AF_WAITV(0);
                AF_BAR();
                if (T + 2 < ntc) AF_ISSUE((T + 2) % 3, KC, VC, 128, 64 * (T + 2), true);
                af_qk<true, true>(lds + (T % 3) * 32768, kl, qf, s);
                half8 pf[2][2];
#pragma unroll
                for (int ct = 0; ct < 2; ++ct) {
                    if (1024 * T + 1039 > 64 * qb) af_maskraw(s[ct], 1024 * T + 31, 16, fq, tq[ct], NEGBIG);
#pragma unroll
                    for (int kt = 0; kt < 4; ++kt) {
#pragma unroll
                        for (int jj = 0; jj < 4; ++jj) s[ct][kt][jj] = __builtin_amdgcn_exp2f(__builtin_fmaf(s[ct][kt][jj], SC, -m[ct])) * il[ct];
                        float s4 = (s[ct][kt][0] + s[ct][kt][1]) + (s[ct][kt][2] + s[ct][kt][3]), s3 = s[ct][kt][3];
                        s4 += __shfl_xor(s4, 1); s4 += __shfl_xor(s4, 2); s3 += __shfl_xor(s3, 1); s3 += __shfl_xor(s3, 2);
                        if (hh == 0) { LAS float* ip = IMP + (4 * ct + qi) * 132 + 16 * T + 4 * kt + fq;
                            __hip_atomic_fetch_add(ip, s4, __ATOMIC_RELAXED, __HIP_MEMORY_SCOPE_WORKGROUP);
                            __hip_atomic_fetch_add(ip + 1, s3, __ATOMIC_RELAXED, __HIP_MEMORY_SCOPE_WORKGROUP); }
                    }
                    af_pack(s[ct], pf[ct]); }
                af_pv<true, true>(lds + (T % 3) * 32768 + 16384, vl0, vz, pf, o);
            }
#pragma unroll
            for (int ct = 0; ct < 2; ++ct) { int _ln; asm volatile("v_mov_b32 %0, %1" : "=v"(_ln) : "v"(lane));
                const int fr_ = _ln & 15, fq_ = _ln >> 4, hh_ = fr_ & 3;
                const size_t row = (size_t)b * SEQ + 64 * qb + 8 * w + 4 * ct + (fr_ >> 2);
                const float g0 = af_sigmoid((float)U[row * DINP + OFF_GL + (4 * g + hh_) * 3 + 0]);
                af_write(Y, row, (4 * g + hh_) * 128 + 4 * fq_, o[ct], g0, false); }
            __syncthreads();
#pragma unroll 1
            for (int ql = 0; ql < 8; ql += 2) {
                LAS float* rowa = IMP + ql * 132; LAS float* rowb = rowa + 132;
                float a0, a1, b0, b1;
                { const int j = lane; const bool valid = j <= qb, forced = (j == 0) || (j == qb) || (j == qb - 1); const float bonus = forced ? 1.0e4f : 0.f;
                  const float va = rowa[j], vb = rowb[j]; a0 = valid ? va + bonus : -1.f; b0 = valid ? vb + bonus : -1.f; rowa[j] = a0; rowb[j] = b0; }
                { const int j = lane + 64; const bool valid = j <= qb, forced = (j == 0) || (j == qb) || (j == qb - 1); const float bonus = forced ? 1.0e4f : 0.f;
                  const float va = rowa[j], vb = rowb[j]; a1 = valid ? va + bonus : -1.f; b1 = valid ? vb + bonus : -1.f; rowa[j] = a1; rowb[j] = b1; }
                int ra0 = 0, ra1 = 0, rb0 = 0, rb1 = 0;
                for (int j4 = 0; j4 <= qb; j4 += 4) { const f32x4 xa = *(const LAS f32x4*)(rowa + j4); const f32x4 xb = *(const LAS f32x4*)(rowb + j4);
#pragma unroll
                    for (int e = 0; e < 4; ++e) { const int j = j4 + e;
                        ra0 += (xa[e] > a0 || (xa[e] == a0 && j < lane)) ? 1 : 0; ra1 += (xa[e] > a1 || (xa[e] == a1 && j < lane + 64)) ? 1 : 0;
                        rb0 += (xb[e] > b0 || (xb[e] == b0 && j < lane)) ? 1 : 0; rb1 += (xb[e] > b1 || (xb[e] == b1 && j < lane + 64)) ? 1 : 0; } }
                const unsigned long long alo = __ballot(ra0 < 16 && lane <= qb), ahi = __ballot(ra1 < 16 && lane + 64 <= qb);
                const unsigned long long blo = __ballot(rb0 < 16 && lane <= qb), bhi = __ballot(rb1 < 16 && lane + 64 <= qb);
                if (lane == 0) { LAS unsigned* sp = SELM + (8 * w + ql) * 4; sp[0] = (unsigned)alo; sp[1] = (unsigned)(alo >> 32); sp[2] = (unsigned)ahi; sp[3] = (unsigned)(ahi >> 32);
                                 sp[4] = (unsigned)blo; sp[5] = (unsigned)(blo >> 32); sp[6] = (unsigned)bhi; sp[7] = (unsigned)(bhi >> 32); }
            }
            __syncthreads();
#pragma unroll 1
            for (int br = 1; br < 3; ++br) {
                const h16* KB = Ub + (br == 1 ? OFF_KS : OFF_KW) + g * 128;
                const h16* VB = Ub + (br == 1 ? OFF_VS : OFF_VW) + g * 128;
                const int j_lo = br == 1 ? 0 : (qb >= 8 ? qb - 8 : 0);
                const int nt = qb - j_lo + 1;
                m[0] = m[1] = -1.0e30f; l[0] = l[1] = 0.f;
#pragma unroll
                for (int ct = 0; ct < 2; ++ct)
#pragma unroll
                    for (int dt = 0; dt < 8; ++dt) o[ct][dt] = (f32x4){0.f, 0.f, 0.f, 0.f};
                AF_ISSUE(0, KB, VB, DINP, 64 * j_lo, true);
                if (nt > 1) AF_ISSUE(1, KB, VB, DINP, 64 * (j_lo + 1), true);
                if (nt > 2) AF_ISSUE(2, KB, VB, DINP, 64 * (j_lo + 2), true);
#pragma unroll 1
                for (int i = 0; i < nt; ++i) {
                    const int j = j_lo + i;
                    if (i + 2 < nt) AF_WAITV(8); else if (i + 1 < nt) AF_WAITV(4); else AF_WAITV(0);
                    AF_BAR();
                    if (i + 3 < nt) AF_ISSUE((i + 3) & 3, KB, VB, DINP, 64 * (j + 3), true);
                    int hi[2], lo[2]; bool act[2];
                    const bool needmask = (j == qb) || (br == 2 && 64 * j <= 64 * qb + 63 - 512);
#pragma unroll
                    for (int ct = 0; ct < 2; ++ct) {
                        if (br == 1) { const unsigned wd = SELM[(8 * w + 4 * ct + qi) * 4 + (j >> 5)]; const bool bit = (wd >> (j & 31)) & 1u;
                            act[ct] = __ballot(bit) != 0ull; hi[ct] = bit ? tq[ct] : -1; lo[ct] = NEGBIG; }
                        else { act[ct] = true; hi[ct] = tq[ct]; lo[ct] = tq[ct] - 512; }
                    }
                    const LAS unsigned char* stg = lds + (i & 3) * 32768;
                    if (act[0] && act[1]) af_tile_online<true, true>(stg, kl, vl0, vz, qf, s, m, l, o, needmask, 64 * j, fq, hi, lo, SC);
                    else if (act[0])      af_tile_online<true, false>(stg, kl, vl0, vz, qf, s, m, l, o, needmask, 64 * j, fq, hi, lo, SC);
                    else if (act[1])      af_tile_online<false, true>(stg, kl, vl0, vz, qf, s, m, l, o, needmask, 64 * j, fq, hi, lo, SC);
                }
#pragma unroll
                for (int ct = 0; ct < 2; ++ct) { int _ln; asm volatile("v_mov_b32 %0, %1" : "=v"(_ln) : "v"(lane));
                    const int fr_ = _ln & 15, fq_ = _ln >> 4, hh_ = fr_ & 3;
                    const size_t row = (size_t)b * SEQ + 64 * qb + 8 * w + 4 * ct + (fr_ >> 2);
                    float lt = l[ct]; lt += __shfl_xor(lt, 16); lt += __shfl_xor(lt, 32);
                    const float gg = af_sigmoid((float)U[row * DINP + OFF_GL + (4 * g + hh_) * 3 + br]);
                    (void)af_write(Y, row, (4 * g + hh_) * 128 + 4 * fq_, o[ct], lt > 0.f ? gg / lt : 0.f, true); }
                AF_BAR();
            }
        }
        {
            h16* MIX = (h16*)(P.ws + WS_H); const float* gw = P.in[15];
            int _ln; asm volatile("v_mov_b32 %0, %1" : "=v"(_ln) : "v"(lane));
            const int fr_ = _ln & 15, fq_ = _ln >> 4, hh_ = fr_ & 3;
#pragma unroll 1
            for (int ct = 0; ct < 2; ++ct) {
                const size_t row = (size_t)b * SEQ + 64 * qb + 8 * w + 4 * ct + (fr_ >> 2);
                float sv = 0.f;
#pragma unroll
                for (int g2 = 0; g2 < 2; ++g2)
#pragma unroll
                    for (int dt = 0; dt < 8; ++dt) { const f32x4 v = *(const f32x4*)(Y + row * 1024 + (4 * g2 + hh_) * 128 + 16 * dt + 4 * fq_);
                        sv += (v[0] * v[0] + v[1] * v[1]) + (v[2] * v[2] + v[3] * v[3]); }
                sv += __shfl_xor(sv, 1); sv += __shfl_xor(sv, 2); sv += __shfl_xor(sv, 16); sv += __shfl_xor(sv, 32);
                const float rstd = rsqrtf(sv * (1.f / 1024.f) + EPS);
#pragma unroll 1
                for (int g2 = 0; g2 < 2; ++g2)
#pragma unroll
                    for (int dt = 0; dt < 8; ++dt) { const int ch = (4 * g2 + hh_) * 128 + 16 * dt + 4 * fq_;
                        const f32x4 v = *(const f32x4*)(Y + row * 1024 + ch); const f32x4 gv = *(const f32x4*)(gw + ch); const f32x4 ov = v * rstd * gv;
                        u32x2 wv; wv.x = pg8::pk_bf2(ov[0], ov[1]); wv.y = pg8::pk_bf2(ov[2], ov[3]);
                        *(u32x2*)(MIX + row * DM + 1024 + ch) = wv; }
            }
        }
    }
}

#define XB_TMO      128
#define XB_XCNT(j)  (256  + 64 * (j))
#define XB_XSUB(j)  (1280 + 64 * (j))
#define XB_XGEN(j)  (2304 + 64 * (j))
#define XB_TOP      3328
#define XB_TOPGEN   3392
#define XCD_BAR_WORDS 3456
#define XB_SPIN_CAP (1u << 18)
__device__ __forceinline__ unsigned xb_ld(unsigned* p)              { return __hip_atomic_load(p, __ATOMIC_RELAXED, __HIP_MEMORY_SCOPE_AGENT); }
__device__ __forceinline__ unsigned xb_add(unsigned* p, unsigned v) { return __hip_atomic_fetch_add(p, v, __ATOMIC_RELAXED, __HIP_MEMORY_SCOPE_AGENT); }
__device__ __forceinline__ unsigned xb_xcc_id() { return (unsigned)__builtin_amdgcn_s_getreg((3 << 11) | 20) & 0xFu; }
#define XB_SPIN(cond, bar) do { unsigned _sp = 0; while (cond) { __builtin_amdgcn_s_sleep(1); \
    if ((++_sp & 255u) == 0u) { if (xb_ld(&(bar)[XB_TMO])) break; if (_sp > XB_SPIN_CAP) { atomicAdd(&(bar)[XB_TMO], 1u); break; } } } } while (0)
struct XcdBarrier { unsigned* bar; unsigned x; volatile LAS unsigned* st; };
__device__ __forceinline__ XcdBarrier xcd_barrier_post(unsigned* bar, volatile LAS unsigned* st) {
    XcdBarrier b; b.bar = bar; b.x = xb_xcc_id(); b.st = st;
    if (threadIdx.x == 0) (void)xb_add(&bar[XB_XCNT(b.x)], 1u);
    return b;
}
__device__ __forceinline__ void xcd_barrier_complete(unsigned* bar, unsigned x, unsigned& nloc, unsigned& nx) {
    const unsigned G = gridDim.x * gridDim.y * gridDim.z;
    unsigned sum, cnt, mine, sp = 0u;
    for (;;) {
        sum = 0u; cnt = 0u; mine = 0u;
#pragma unroll
        for (unsigned j = 0; j < 16; ++j) { const unsigned c = xb_ld(&bar[XB_XCNT(j)]); sum += c; cnt += (c > 0u) ? 1u : 0u; mine = (j == x) ? c : mine; }
        if (sum == G) break;
        __builtin_amdgcn_s_sleep(1);
        if ((++sp & 255u) == 0u) { if (xb_ld(&bar[XB_TMO])) break; if (sp > XB_SPIN_CAP) { atomicAdd(&bar[XB_TMO], 1u); break; } }
    }
    nloc = mine > 0u ? mine : 1u; nx = cnt > 0u ? cnt : 1u;
}
__device__ __forceinline__ void xcd_barrier(const XcdBarrier& b) {
    asm volatile("s_waitcnt vmcnt(0)" ::: "memory");
    __syncthreads();
    if (threadIdx.x == 0) {
        unsigned* bar = b.bar;
        __builtin_amdgcn_s_waitcnt(0);
        unsigned nloc = b.st[0], nx = b.st[1];
        if (nloc == 0u) { xcd_barrier_complete(bar, b.x, nloc, nx); b.st[0] = nloc; b.st[1] = nx; }
        const unsigned old = xb_add(&bar[XB_XSUB(b.x)], 1u);
        const unsigned gen = old / nloc;
        if (old + 1u == (gen + 1u) * nloc) {
            __builtin_amdgcn_fence(__ATOMIC_RELEASE, "agent");
            asm volatile("s_waitcnt vmcnt(0)" ::: "memory");
            const unsigned og = xb_add(&bar[XB_TOP], 1u);
            const unsigned tg = og / nx;
            if (og + 1u == (tg + 1u) * nx) xb_add(&bar[XB_TOPGEN], 1u);
            else XB_SPIN(xb_ld(&bar[XB_TOPGEN]) == tg, bar);
            __builtin_amdgcn_fence(__ATOMIC_ACQUIRE, "agent");
            xb_add(&bar[XB_XGEN(b.x)], 1u);
            asm volatile("s_waitcnt vmcnt(0)" ::: "memory");
        } else {
            XB_SPIN(xb_ld(&bar[XB_XGEN(b.x)]) == gen, bar);
            __builtin_amdgcn_fence(__ATOMIC_ACQUIRE, "agent");
            asm volatile("s_waitcnt vmcnt(0)" ::: "memory");
        }
    }
    __syncthreads();
}

constexpr int NPHASE = 12;
struct Args { Ptrs p; int ph_lo, ph_hi; };

__global__ void __launch_bounds__(NTHR, 2) mega(Args args) {
    extern __shared__ __attribute__((aligned(16))) unsigned char lds_raw[];
    LAS unsigned char* lds = (LAS unsigned char*)lds_raw;
    const Ptrs& P = args.p;
    const int G = gridDim.x, bid = blockIdx.x;
    unsigned char* ws = P.ws;
    const float* mod = (const float*)(ws + WS_MOD);
    const int lo = args.ph_lo, hi = args.ph_hi;
    volatile LAS unsigned* MISC = (volatile LAS unsigned*)(lds + LDS_BYTES - 64);
    if (threadIdx.x < 16) MISC[threadIdx.x] = 0u;
    __syncthreads();
    XcdBarrier xbar; xbar.bar = (unsigned*)(ws + WS_BAR); xbar.x = 0; xbar.st = MISC;
    if (hi - lo > 1) xbar = xcd_barrier_post((unsigned*)(ws + WS_BAR), MISC);
#define PHASE_BEGIN(n) if (lo <= (n) && (n) < hi) {
#define PHASE_END(n) if ((n) + 1 < hi) { if (G != 256) cg::this_grid().sync(); else xcd_barrier(xbar); } }
    PHASE_BEGIN(0) p0_prologue(P, lds, G, bid); PHASE_END(0)
    PHASE_BEGIN(1) norm_mod_rows<false, false>(P.in[0], P.in[4], mod, 0, 2048, (h16*)(ws + WS_H), G, bid); PHASE_END(1)
    PHASE_BEGIN(2) { pg8::Gemm g{(const h16*)(ws + WS_H), (const h16*)(ws + WS_WIN), NT, DINP, DM}; pg8::StaticOrder S; S.init(NT, DINP, G, bid);
                  pg8::EpiF16<0> E{(h16*)(ws + WS_U), DINP}; pg8::gemm_phase<false>(lds, g, S, E); } PHASE_END(2)
    PHASE_BEGIN(3) post_u_rows(P, G, bid); PHASE_END(3)
    PHASE_BEGIN(4) compress_phase(P, lds, G, bid); PHASE_END(4)
    PHASE_BEGIN(5) attn_fast(P, lds, G, bid); PHASE_END(5)
    PHASE_BEGIN(7) { pg8::Gemm g{(const h16*)(ws + WS_H), (const h16*)(ws + WS_WOUT), NT, DM, DM}; pg8::StaticOrder S; S.init(NT, DM, G, bid);
                  pg8::EpiRes<true> E{P.in[0], (h16*)(ws + WS_X1H), mod + 2 * 2048, 12288}; pg8::gemm_phase<true>(lds, g, S, E); } PHASE_END(7)
    PHASE_BEGIN(8) norm_mod_rows<true, true>(ws + WS_X1H, P.in[17], mod, 3 * 2048, 4 * 2048, (h16*)(ws + WS_H), G, bid); PHASE_END(8)
    PHASE_BEGIN(9) { pg8::Gemm g{(const h16*)(ws + WS_H), (const h16*)(ws + WS_W1), NT, DFF, DM}; pg8::StaticOrder S; S.init(NT, DFF, G, bid);
                  pg8::EpiF16<1, true> E{(h16*)(ws + WS_HID), DFF}; pg8::gemm_phase<true>(lds, g, S, E); } PHASE_END(9)
    PHASE_BEGIN(10) { pg8::Gemm g{(const h16*)(ws + WS_HID), (const h16*)(ws + WS_W2), NT, DM, DFF}; pg8::StaticOrder S; S.init(NT, DM, G, bid);
                   pg8::EpiRes<false> E{ws + WS_X1H, (h16*)(ws + WS_X1H), mod + 5 * 2048, 12288}; pg8::gemm_phase<true>(lds, g, S, E); } PHASE_END(10)
    PHASE_BEGIN(11) final_norm_rows((const h16*)(ws + WS_X1H), P.out, P.in[20], G, bid); PHASE_END(11)
}

extern "C" void kernel_launch(void* const* d_in, const int* in_sizes, int n_in, void* d_out, int out_size, void* d_ws, size_t ws_size, hipStream_t stream) {
    static int grid = 0;
    if (grid == 0) {
        if (n_in != 21 || out_size != NT * DM || ws_size < WS_END2) { fprintf(stderr, "kernel_launch: unexpected shapes (n_in %d out %d ws %zu need %zu)\n", n_in, out_size, ws_size, (size_t)WS_END2); grid = -1; return; }
        int dev = 0, cus = 0, per_cu = 0;
        hipGetDevice(&dev); hipDeviceGetAttribute(&cus, hipDeviceAttributeMultiprocessorCount, dev);
        if (hipFuncSetAttribute((const void*)mega, hipFuncAttributeMaxDynamicSharedMemorySize, LDS_BYTES) != hipSuccess) { fprintf(stderr, "kernel_launch: hipFuncSetAttribute failed\n"); grid = -1; return; }
        if (hipOccupancyMaxActiveBlocksPerMultiprocessor(&per_cu, (const void*)mega, NTHR, LDS_BYTES) != hipSuccess || per_cu < 1) { fprintf(stderr, "kernel_launch: occupancy query says %d\n", per_cu); per_cu = 1; }
        (void)hipGetLastError();
        grid = cus * 1;
        fprintf(stderr, "kernel_launch: cus %d per_cu %d grid %d\n", cus, per_cu, grid);
    }
    if (grid < 0) return;
    if (hipMemsetAsync((char*)d_ws + WS_BAR, 0, WS_BAR_BYTES, stream) != hipSuccess) { fprintf(stderr, "kernel_launch: memset failed\n"); return; }
    Args a{};
    for (int i = 0; i < 21; ++i) a.p.in[i] = (const float*)d_in[i];
    a.p.out = (float*)d_out; a.p.ws = (unsigned char*)d_ws;
    a.ph_lo = 0; a.ph_hi = NPHASE;
    void* kargs[] = {&a};
    hipError_t e = hipLaunchCooperativeKernel((const void*)mega, dim3(grid), dim3(NTHR), kargs, LDS_BYTES, stream);
    if (e != hipSuccess) fprintf(stderr, "cooperative launch failed: %s (grid %d)\n", hipGetErrorString(e), grid);
}
```

```cpp
#include <hip/hip_runtime.h>
#include <hip/hip_cooperative_groups.h>
#include <cstdint>
#include <cstdio>
namespace cg = cooperative_groups;


#define LAS __attribute__((address_space(3)))
typedef _Float16 h16;
typedef _Float16 half8 __attribute__((ext_vector_type(8)));
typedef _Float16 half4 __attribute__((ext_vector_type(4)));
typedef _Float16 half2v __attribute__((ext_vector_type(2)));
typedef float f32x4 __attribute__((ext_vector_type(4)));
typedef float f32x2 __attribute__((ext_vector_type(2)));
typedef unsigned u32x4 __attribute__((ext_vector_type(4)));
typedef unsigned u32x2 __attribute__((ext_vector_type(2)));

constexpr int NB = 4, SEQ = 8192, NT = NB * SEQ, DM = 2048, DIN = 5656, DINP = 5888, DFF = 8192;
constexpr int OFF_UB = 0, OFF_UC = 1024, OFF_UH = 2048, OFF_Q = 3072, OFF_KC = 4096, OFF_VC = 4352, OFF_KS = 4608, OFF_VS = 4864,
              OFF_KW = 5120, OFF_VW = 5376, OFF_GL = 5632;
constexpr float EPS = 1e-6f;
constexpr int NTHR = 512;
constexpr int LDS_BYTES = 136 * 1024;

constexpr size_t WS_BAR   = 0;
constexpr size_t WS_BAR_BYTES = 16384;
constexpr size_t WS_MOD   = 16384;
constexpr size_t WS_B1P   = WS_MOD + (size_t)4 * 12288 * 4;
constexpr size_t WS_WIN   = WS_B1P + (size_t)2 * 32 * 256 * 4;
constexpr size_t WS_WOUT  = WS_WIN + (size_t)DINP * DM * 2;
constexpr size_t WS_W1    = WS_WOUT + (size_t)DM * DM * 2;
constexpr size_t WS_W2    = WS_W1 + (size_t)DFF * DM * 2;
constexpr size_t WS_CW1K  = WS_W2 + (size_t)DFF * DM * 2;
constexpr size_t WS_CW1V  = WS_CW1K + (size_t)256 * 4096 * 2;
constexpr size_t WS_CW2K  = WS_CW1V + (size_t)256 * 4096 * 2;
constexpr size_t WS_CW2V  = WS_CW2K + (size_t)128 * 256 * 2;
constexpr size_t WS_KCMP  = WS_CW2V + (size_t)128 * 256 * 2;
constexpr size_t WS_VCMP  = WS_KCMP + (size_t)8 * 512 * 128 * 2;
constexpr size_t WS_H     = WS_VCMP + (size_t)8 * 512 * 128 * 2;
constexpr size_t WS_BIG   = WS_H + (size_t)NT * DM * 2;
constexpr size_t WS_U     = WS_BIG;
constexpr size_t WS_YACC  = WS_U + (size_t)NT * DINP * 2;
constexpr size_t WS_HID   = WS_BIG;
constexpr size_t WS_END   = WS_BIG + (size_t)NT * DFF * 2;
static_assert(WS_YACC + (size_t)NT * 1024 * 4 <= WS_END, "ws map");
constexpr size_t WS_X1H   = WS_END;
constexpr size_t WS_END2  = WS_X1H + (size_t)NT * DM * 2;
static_assert(WS_END2 <= (size_t)1073741824, "ws map fits 4x largest tensor");
static_assert(WS_WIN % 256 == 0 && WS_H % 256 == 0 && WS_BIG % 256 == 0 && WS_YACC % 256 == 0, "alignment");

namespace pg8 {
constexpr int BM = 256, BK = 64, HALF = 128, HTB = HALF * BK * 2, STAGE_BYTES = 8 * HTB, NXCD = 8, WGM = 8;
__host__ __device__ __forceinline__ int lds_byte(int r, int c) { const int st = (r >> 4) * 2 + (c >> 5), rr = r & 15, cc = c & 31, ob = rr * 64 + cc * 2; return st * 1024 + (ob ^ (((ob >> 9) & 1) << 5)); }
__host__ __device__ __forceinline__ void stage_rc(int b, int& R, int& C) { const int st = b / 1024, sb = b % 1024, swz = sb ^ (((sb >> 9) & 1) << 5); R = (st >> 1) * 16 + swz / 64; C = (st & 1) * 32 + (swz % 64) / 2; }
__host__ __device__ __forceinline__ int perm32(int rho) { const int n = rho >> 4, i = rho & 15; return 8 * (i >> 2) + 4 * n + (i & 3); }

struct Unit { int pm, pn; };
struct Gemm { const h16* A; const h16* Bt; int M, N, K; };

struct StaticOrder {
    int nM, nN, nwg, G, c;
    __host__ __device__ void init(int M, int N, int G_, int c_) { nM = M / BM; nN = N / BM; nwg = nM * nN; G = G_; c = c_; }
    __host__ __device__ bool next(int i, Unit& u) const {
        const long L = (long)i * G + c; if (L >= nwg) return false;
        int wgid = (int)L; { const int q = nwg / NXCD, r = nwg % NXCD, xcd = wgid % NXCD, off = wgid / NXCD; wgid = (xcd < r ? xcd * (q + 1) : r * (q + 1) + (xcd - r) * q) + off; }
        const int nig = WGM * nN, gid = wgid / nig, fm = gid * WGM, gsz = (nM - fm) < WGM ? (nM - fm) : WGM;
        u.pm = fm + ((wgid % nig) % gsz); u.pn = (wgid % nig) / gsz; return true;
    }
    __device__ __forceinline__ void a_ready(const Unit&) const {}
    __device__ __forceinline__ void done(const Unit&) const {}
};

__device__ __forceinline__ unsigned pk_h2(float lo, float hi) { half2v v; v.x = (h16)lo; v.y = (h16)hi; return __builtin_bit_cast(unsigned, v); }
__device__ __forceinline__ unsigned pk_bf2(float lo, float hi) { unsigned r; asm("v_cvt_pk_bf16_f32 %0, %1, %2" : "=v"(r) : "v"(lo), "v"(hi)); return r; }
template <bool BF> __device__ __forceinline__ unsigned pk2(float lo, float hi) { return BF ? pk_bf2(lo, hi) : pk_h2(lo, hi); }
typedef short bfx8 __attribute__((ext_vector_type(8)));

template <int ACT, bool BF = false> struct EpiF16 {
    static constexpr bool PERM = true, AFTER_DRAIN = false;
    h16* O; int ldc;
    __device__ __forceinline__ void operator()(const f32x4 (&acc)[2][2][4][2], const Unit& u, int wr, int wc, int fr, int fq) const {
        const int row0 = u.pm * BM + wr * 64 + fr; const int col0 = u.pn * BM + wc * 32 + 8 * fq;
#pragma unroll
        for (int ai = 0; ai < 2; ++ai)
#pragma unroll
            for (int m = 0; m < 4; ++m) { h16* rowp = O + (size_t)(row0 + ai * HALF + m * 16) * ldc + col0;
#pragma unroll
                for (int bj = 0; bj < 2; ++bj) { f32x4 v0 = acc[ai][bj][m][0], v1 = acc[ai][bj][m][1];
                    if (ACT == 1) {
#pragma unroll
                        for (int j = 0; j < 4; ++j) { const float a = fmaxf(v0[j], 0.f), b = fmaxf(v1[j], 0.f); v0[j] = a * a; v1[j] = b * b; } }
                    u32x4 w; w.x = pk2<BF>(v0[0], v0[1]); w.y = pk2<BF>(v0[2], v0[3]); w.z = pk2<BF>(v1[0], v1[1]); w.w = pk2<BF>(v1[2], v1[3]);
                    *(u32x4*)(rowp + bj * HALF) = w; } }
    }
};
template <bool BASE_F32> struct EpiRes {
    static constexpr bool PERM = true, AFTER_DRAIN = false;
    const void* base; h16* out; const float* gate; int gate_ld;
    __device__ __forceinline__ void operator()(const f32x4 (&acc)[2][2][4][2], const Unit& u, int wr, int wc, int fr, int fq) const {
        const int row0 = u.pm * BM + wr * 64 + fr, col0 = u.pn * BM + wc * 32 + 8 * fq; const int b = (u.pm * BM) / SEQ;
        f32x4 gv[2][2];
#pragma unroll
        for (int bj = 0; bj < 2; ++bj)
#pragma unroll
            for (int n = 0; n < 2; ++n) gv[bj][n] = *(const f32x4*)(gate + (size_t)b * gate_ld + col0 + bj * HALF + 4 * n);
#pragma unroll
        for (int ai = 0; ai < 2; ++ai)
#pragma unroll
            for (int m = 0; m < 4; ++m) { const size_t ro = (size_t)(row0 + ai * HALF + m * 16) * DM + col0;
#pragma unroll
                for (int bj = 0; bj < 2; ++bj) { f32x4 b0, b1;
                    if (BASE_F32) { b0 = *(const f32x4*)((const float*)base + ro + bj * HALF); b1 = *(const f32x4*)((const float*)base + ro + bj * HALF + 4); }
                    else { const half8 hb = *(const half8*)((const h16*)base + ro + bj * HALF);
                           b0 = (f32x4){(float)hb[0], (float)hb[1], (float)hb[2], (float)hb[3]}; b1 = (f32x4){(float)hb[4], (float)hb[5], (float)hb[6], (float)hb[7]}; }
                    const f32x4 v0 = b0 + gv[bj][0] * acc[ai][bj][m][0], v1 = b1 + gv[bj][1] * acc[ai][bj][m][1];
                    u32x4 w; w.x = pk_h2(v0[0], v0[1]); w.y = pk_h2(v0[2], v0[3]); w.z = pk_h2(v1[0], v1[1]); w.w = pk_h2(v1[2], v1[3]);
                    *(u32x4*)(out + ro + bj * HALF) = w; } }
    }
};

template <bool BF16, class Epi, class Sched, bool ALIGN_EPI = true, bool SP2 = true>
__device__ __forceinline__ void gemm_phase(LAS unsigned char* lds, const Gemm g, const Sched& S, const Epi& E) {
    const int tid = threadIdx.x, wid = __builtin_amdgcn_readfirstlane(tid >> 6), lane = tid & 63, wr = wid >> 2, wc = wid & 3, fr = lane & 15, fq = lane >> 4;
    const int K = g.K, nt = K / BK;
    unsigned voffA[2], voffB[2];
#pragma unroll
    for (int i = 0; i < 2; ++i) { int R, C; stage_rc(tid * 16 + i * 8192, R, C); const int Rb = Epi::PERM ? ((R & ~31) + perm32(R & 31)) : R;
        voffA[i] = (unsigned)(R * K + C) * 2u; voffB[i] = (unsigned)(Rb * K + C) * 2u; }
    const size_t kstep = (size_t)(BK * 2);
    const size_t hstep = (size_t)HALF * K * 2;
    const size_t tstep = 2 * hstep;
    const unsigned ldsw = (unsigned)wid * 1024u;
    const int aoff = lds_byte(wr * 64 + fr, fq * 8), boff = lds_byte(wc * 32 + fr, fq * 8);
#define PG8_SA(b, h) (((b) * 2 + (h)) * HTB)
#define PG8_SB(b, h) ((4 + (b) * 2 + (h)) * HTB)
#define PG8_STAGE(bufoff, gbase, voff) do { _Pragma("unroll") for (int _i = 0; _i < 2; ++_i) \
        __builtin_amdgcn_global_load_lds((const unsigned*)((const char*)(gbase) + (voff)[_i]), (LAS unsigned*)(lds + (bufoff) + ldsw + _i * 8192), 16, 0, 0); } while (0)
#define PG8_LDA(dst, b, h) do { _Pragma("unroll") for (int m = 0; m < 4; ++m) _Pragma("unroll") for (int k = 0; k < 2; ++k) dst[m][k] = *(const LAS half8*)(lds + PG8_SA(b, h) + aoff + m * 2048 + k * 1024); } while (0)
#define PG8_LDB(dst, b, h) do { _Pragma("unroll") for (int n = 0; n < 2; ++n) _Pragma("unroll") for (int k = 0; k < 2; ++k) dst[n][k] = *(const LAS half8*)(lds + PG8_SB(b, h) + boff + n * 2048 + k * 1024); } while (0)
#define PG8_MMA(ai, bj, At, Bt) do { __builtin_amdgcn_s_setprio(1); _Pragma("unroll") for (int m = 0; m < 4; ++m) _Pragma("unroll") for (int n = 0; n < 2; ++n) _Pragma("unroll") for (int k = 0; k < 2; ++k) \
        acc[ai][bj][m][n] = BF16 ? __builtin_amdgcn_mfma_f32_16x16x32_bf16(__builtin_bit_cast(bfx8, Bt[n][k]), __builtin_bit_cast(bfx8, At[m][k]), acc[ai][bj][m][n], 0, 0, 0) \
                                 : __builtin_amdgcn_mfma_f32_16x16x32_f16(Bt[n][k], At[m][k], acc[ai][bj][m][n], 0, 0, 0); __builtin_amdgcn_s_setprio(0); } while (0)
#define PG8_WAIT_V(n) asm volatile("s_waitcnt vmcnt(" #n ")" ::: "memory")
#define PG8_WAIT_L(n) asm volatile("s_waitcnt lgkmcnt(" #n ")" ::: "memory")
#define PG8_BAR __builtin_amdgcn_s_barrier()
#define PG8_SCHED __builtin_amdgcn_sched_barrier(0)
    Unit cur, nxt; int ui = 0;
    if (!S.next(0, cur)) return;
    f32x4 acc[2][2][4][2];
#pragma unroll
    for (int a = 0; a < 2; ++a)
#pragma unroll
        for (int b = 0; b < 2; ++b)
#pragma unroll
            for (int m = 0; m < 4; ++m)
#pragma unroll
                for (int n = 0; n < 2; ++n) acc[a][b][m][n] = (f32x4){0.f, 0.f, 0.f, 0.f};
    half8 At[4][2], B0[2][2], B1[2][2];
    const char* cA = (const char*)g.A + (size_t)cur.pm * tstep; const char* cB = (const char*)g.Bt + (size_t)cur.pn * tstep;
    S.a_ready(cur);
    if constexpr (SP2) {
        PG8_STAGE(PG8_SB(0, 0), cB, voffB); PG8_STAGE(PG8_SB(0, 1), cB + hstep, voffB); PG8_STAGE(PG8_SA(0, 0), cA, voffA); PG8_STAGE(PG8_SA(0, 1), cA + hstep, voffA);
        if (wr == 1) PG8_BAR;
        PG8_WAIT_V(2); PG8_BAR;
        PG8_STAGE(PG8_SB(1, 0), cB + kstep, voffB); PG8_STAGE(PG8_SA(1, 0), cA + kstep, voffA); PG8_STAGE(PG8_SB(1, 1), cB + hstep + kstep, voffB);
        PG8_WAIT_V(6); PG8_BAR;
    } else {
        PG8_STAGE(PG8_SB(0, 0), cB, voffB); PG8_STAGE(PG8_SA(0, 0), cA, voffA); PG8_STAGE(PG8_SB(0, 1), cB + hstep, voffB); PG8_STAGE(PG8_SA(0, 1), cA + hstep, voffA);
        if (wr == 1) PG8_BAR;
        PG8_WAIT_V(4); PG8_BAR;
        PG8_STAGE(PG8_SB(1, 0), cB + kstep, voffB); PG8_STAGE(PG8_SA(1, 0), cA + kstep, voffA); PG8_STAGE(PG8_SB(1, 1), cB + hstep + kstep, voffB);
        PG8_WAIT_V(6); PG8_BAR;
    }
    for (;;) {
        const bool has_next = S.next(ui + 1, nxt);
        const char* nA = has_next ? (const char*)g.A + (size_t)nxt.pm * tstep : cA; const char* nB = has_next ? (const char*)g.Bt + (size_t)nxt.pn * tstep : cB;
        for (int t = 0; t < nt; t += 2) {
            const bool last = (t == nt - 2);
            const char* a1 = cA + (size_t)(t + 1) * kstep;
            const char* a2 = last ? nA : cA + (size_t)(t + 2) * kstep; const char* b2 = last ? nB : cB + (size_t)(t + 2) * kstep;
            const char* a3 = a2 + kstep; const char* b3 = b2 + kstep;
            if (last && has_next) S.a_ready(nxt);
            if constexpr (SP2) {
            PG8_LDB(B0, 0, 0); PG8_LDB(B1, 0, 1); PG8_SCHED; PG8_LDA(At, 0, 0); PG8_STAGE(PG8_SA(1, 1), a1 + hstep, voffA);
            PG8_WAIT_V(8); PG8_WAIT_L(0); PG8_BAR; PG8_MMA(0, 0, At, B0); PG8_MMA(0, 1, At, B1); PG8_BAR; PG8_SCHED;
            PG8_LDA(At, 0, 1); PG8_STAGE(PG8_SB(0, 0), b2, voffB); PG8_STAGE(PG8_SB(0, 1), b2 + hstep, voffB); PG8_STAGE(PG8_SA(0, 0), a2, voffA);
            PG8_WAIT_V(8); PG8_WAIT_L(0); PG8_BAR; PG8_MMA(1, 0, At, B0); PG8_MMA(1, 1, At, B1); PG8_BAR; PG8_SCHED;
            PG8_LDB(B0, 1, 0); PG8_LDB(B1, 1, 1); PG8_SCHED; PG8_LDA(At, 1, 0); PG8_STAGE(PG8_SA(0, 1), a2 + hstep, voffA);
            PG8_WAIT_V(8); PG8_WAIT_L(0); PG8_BAR; PG8_MMA(0, 0, At, B0); PG8_MMA(0, 1, At, B1); PG8_BAR; PG8_SCHED;
            PG8_LDA(At, 1, 1); PG8_STAGE(PG8_SB(1, 0), b3, voffB); PG8_STAGE(PG8_SB(1, 1), b3 + hstep, voffB); PG8_STAGE(PG8_SA(1, 0), a3, voffA);
            PG8_WAIT_V(8); PG8_WAIT_L(0); PG8_BAR; PG8_MMA(1, 0, At, B0); PG8_MMA(1, 1, At, B1); PG8_BAR; PG8_SCHED;
            } else {
            PG8_LDB(B0, 0, 0); PG8_SCHED; PG8_LDA(At, 0, 0); PG8_STAGE(PG8_SA(1, 1), a1 + hstep, voffA);
            PG8_WAIT_L(8); PG8_BAR; PG8_WAIT_L(0); PG8_MMA(0, 0, At, B0); PG8_BAR; PG8_SCHED;
            PG8_LDB(B1, 0, 1); PG8_STAGE(PG8_SB(0, 0), b2, voffB);
            PG8_BAR; PG8_WAIT_L(0); PG8_MMA(0, 1, At, B1); PG8_BAR;
            PG8_LDA(At, 0, 1); PG8_STAGE(PG8_SA(0, 0), a2, voffA);
            PG8_BAR; PG8_WAIT_L(0); PG8_MMA(1, 0, At, B0); PG8_BAR; PG8_SCHED;
            PG8_STAGE(PG8_SB(0, 1), b2 + hstep, voffB);
            PG8_WAIT_V(6); PG8_BAR; PG8_MMA(1, 1, At, B1); PG8_BAR;
            PG8_LDB(B0, 1, 0); PG8_SCHED; PG8_LDA(At, 1, 0); PG8_STAGE(PG8_SA(0, 1), a2 + hstep, voffA);
            PG8_WAIT_L(8); PG8_BAR; PG8_WAIT_L(0); PG8_MMA(0, 0, At, B0); PG8_BAR; PG8_SCHED;
            PG8_LDB(B1, 1, 1); PG8_STAGE(PG8_SB(1, 0), b3, voffB);
            PG8_BAR; PG8_WAIT_L(0); PG8_MMA(0, 1, At, B1); PG8_BAR;
            PG8_LDA(At, 1, 1); PG8_STAGE(PG8_SA(1, 0), a3, voffA);
            PG8_BAR; PG8_WAIT_L(0); PG8_MMA(1, 0, At, B0); PG8_BAR; PG8_SCHED;
            PG8_STAGE(PG8_SB(1, 1), b3 + hstep, voffB);
            PG8_WAIT_V(6); PG8_BAR; PG8_MMA(1, 1, At, B1); PG8_BAR;
            }
        }
        if constexpr (ALIGN_EPI) { if (wr == 0) PG8_BAR; }
        E(acc, cur, wr, wc, fr, fq); S.done(cur);
        if (!has_next) break;
#pragma unroll
        for (int a = 0; a < 2; ++a)
#pragma unroll
            for (int b = 0; b < 2; ++b)
#pragma unroll
                for (int m = 0; m < 4; ++m)
#pragma unroll
                    for (int n = 0; n < 2; ++n) acc[a][b][m][n] = (f32x4){0.f, 0.f, 0.f, 0.f};
        cur = nxt; cA = nA; cB = nB; ++ui;
        if constexpr (ALIGN_EPI) { if (wr == 1) PG8_BAR; }
    }
    PG8_WAIT_V(0);
    if constexpr (!ALIGN_EPI) { if (wr == 0) PG8_BAR; }
    PG8_BAR;
#undef PG8_SA
#undef PG8_SB
#undef PG8_STAGE
#undef PG8_LDA
#undef PG8_LDB
#undef PG8_MMA
#undef PG8_WAIT_V
#undef PG8_WAIT_L
#undef PG8_BAR
#undef PG8_SCHED
}
}

__device__ __forceinline__ float wave_sum(float v) {
#pragma unroll
    for (int o = 1; o < 64; o <<= 1) v += __shfl_xor(v, o);
    return v;
}
__device__ __forceinline__ float wave_max(float v) {
#pragma unroll
    for (int o = 1; o < 64; o <<= 1) v = fmaxf(v, __shfl_xor(v, o));
    return v;
}
__device__ __forceinline__ float bcast_lane(float v, int j) { return __builtin_bit_cast(float, __builtin_amdgcn_readlane(__builtin_bit_cast(int, v), j)); }

struct Ptrs {
    const float* in[21]; float* out; unsigned char* ws;
};

constexpr int P0_ADA = 192, P0_B1 = 64;
constexpr int P0_TWIN = 32 * 23, P0_TWOUT = 32 * 8, P0_TW1 = 32 * 32, P0_TW2 = 128 * 8, P0_TC1 = 64 * 1, P0_TC2 = 4 * 1;
constexpr int P0_OFF_B1 = P0_ADA, P0_OFF_TWIN = P0_OFF_B1 + P0_B1, P0_OFF_TWOUT = P0_OFF_TWIN + P0_TWIN, P0_OFF_TW1 = P0_OFF_TWOUT + P0_TWOUT,
              P0_OFF_TW2 = P0_OFF_TW1 + P0_TW1, P0_OFF_TC1K = P0_OFF_TW2 + P0_TW2, P0_OFF_TC1V = P0_OFF_TC1K + P0_TC1, P0_OFF_TC2K = P0_OFF_TC1V + P0_TC1,
              P0_OFF_TC2V = P0_OFF_TC2K + P0_TC2, P0_ITEMS = P0_OFF_TC2V + P0_TC2;

__device__ __forceinline__ void transpose_tile(const float* __restrict__ W, int K, int N, int Nout, h16* __restrict__ Wt, int item, LAS float* scr, int tid, bool bf = false) {
    const int nkt = K / 64; const int kt = item % nkt, ntl = item / nkt;
    { const int c4 = tid & 63, r = tid >> 6; f32x4 v[8];
#pragma unroll
      for (int i = 0; i < 8; ++i) { const int k = kt * 64 + r + 8 * i, n = ntl * 256 + 4 * c4;
          v[i] = (f32x4){0.f, 0.f, 0.f, 0.f}; if (n < N) v[i] = *(const f32x4*)(W + (size_t)k * N + n); }
#pragma unroll
      for (int i = 0; i < 8; ++i) *(LAS f32x4*)(scr + (r + 8 * i) * 260 + 4 * c4) = v[i]; }
    __syncthreads();
    { const int n = tid >> 1, hf = tid & 1;
      if (ntl * 256 + n < Nout) {
#pragma unroll
          for (int q = 0; q < 4; ++q) { float f[8];
#pragma unroll
              for (int j = 0; j < 8; ++j) f[j] = scr[(32 * hf + 8 * q + j) * 260 + n];
              u32x4 o;
              if (bf) { o.x = pg8::pk_bf2(f[0], f[1]); o.y = pg8::pk_bf2(f[2], f[3]); o.z = pg8::pk_bf2(f[4], f[5]); o.w = pg8::pk_bf2(f[6], f[7]); }
              else    { o.x = pg8::pk_h2(f[0], f[1]);  o.y = pg8::pk_h2(f[2], f[3]);  o.z = pg8::pk_h2(f[4], f[5]);  o.w = pg8::pk_h2(f[6], f[7]); }
              *(u32x4*)(Wt + (size_t)(ntl * 256 + n) * K + kt * 64 + 32 * hf + 8 * q) = o; } } }
    __syncthreads();
}

__device__ __forceinline__ void p0_prologue(const Ptrs& P, LAS unsigned char* lds, int G, int bid) {
    const int tid = threadIdx.x;
    LAS float* scr = (LAS float*)lds;
    unsigned char* ws = P.ws;
    for (int it = bid; it < P0_ITEMS; it += G) {
        if (it < P0_ADA) {
            LAS float* sc = scr;
            LAS float* red = scr + 8192;
            const float* c = P.in[1];
            for (int i = tid; i < 8192; i += NTHR) { const float v = c[i]; sc[i] = v / (1.f + __expf(-v)); }
            __syncthreads();
            const int cl = tid & 15, kg = tid >> 4;
            f32x4 a0 = {0, 0, 0, 0}, a1 = a0, a2 = a0, a3 = a0;
            const float* W = P.in[2] + 64 * it + 4 * cl;
#pragma unroll 8
            for (int k = kg; k < 2048; k += 32) { const f32x4 w = *(const f32x4*)(W + (size_t)k * 12288);
                a0 += sc[k] * w; a1 += sc[2048 + k] * w; a2 += sc[4096 + k] * w; a3 += sc[6144 + k] * w; }
#pragma unroll
            for (int j = 0; j < 4; ++j) { red[(kg * 4 + 0) * 64 + 4 * cl + j] = a0[j]; red[(kg * 4 + 1) * 64 + 4 * cl + j] = a1[j];
                red[(kg * 4 + 2) * 64 + 4 * cl + j] = a2[j]; red[(kg * 4 + 3) * 64 + 4 * cl + j] = a3[j]; }
            __syncthreads();
            if (tid < 256) { const int b = tid >> 6, col = tid & 63; float s = 0.f;
                for (int q = 0; q < 32; ++q) s += red[(q * 4 + b) * 64 + col];
                ((float*)(ws + WS_MOD))[b * 12288 + 64 * it + col] = s + P.in[3][64 * it + col]; }
            __syncthreads();
        } else if (it < P0_OFF_TWIN) {
            const int q = it - P0_OFF_B1, kv = q >> 5, part = q & 31;
            const float* pe = P.in[8 + kv]; const float* W1 = P.in[kv ? 12 : 10];
            const int col = tid & 255, kh = tid >> 8; float s = 0.f;
            for (int k = 128 * part + 64 * kh; k < 128 * part + 64 * kh + 64; ++k) s += pe[k] * W1[(size_t)k * 256 + col];
            scr[tid] = s; __syncthreads();
            if (tid < 256) ((float*)(ws + WS_B1P))[(kv * 32 + part) * 256 + tid] = scr[tid] + scr[tid + 256];
            __syncthreads();
        } else if (it < P0_OFF_TWOUT) transpose_tile(P.in[5], DM, DIN, DINP, (h16*)(ws + WS_WIN), it - P0_OFF_TWIN, scr, tid);
        else if (it < P0_OFF_TW1)     transpose_tile(P.in[16], DM, DM, DM, (h16*)(ws + WS_WOUT), it - P0_OFF_TWOUT, scr, tid, true);
        else if (it < P0_OFF_TW2)     transpose_tile(P.in[18], DM, DFF, DFF, (h16*)(ws + WS_W1), it - P0_OFF_TW1, scr, tid, true);
        else if (it < P0_OFF_TC1K)    transpose_tile(P.in[19], DFF, DM, DM, (h16*)(ws + WS_W2), it - P0_OFF_TW2, scr, tid, true);
        else if (it < P0_OFF_TC1V)    transpose_tile(P.in[10], 4096, 256, 256, (h16*)(ws + WS_CW1K), it - P0_OFF_TC1K, scr, tid);
        else if (it < P0_OFF_TC2K)    transpose_tile(P.in[12], 4096, 256, 256, (h16*)(ws + WS_CW1V), it - P0_OFF_TC1V, scr, tid);
        else if (it < P0_OFF_TC2V)    transpose_tile(P.in[11], 256, 128, 128, (h16*)(ws + WS_CW2K), it - P0_OFF_TC2K, scr, tid);
        else                          transpose_tile(P.in[13], 256, 128, 128, (h16*)(ws + WS_CW2V), it - P0_OFF_TC2V, scr, tid);
    }
}

template <bool BF, bool IN_F16> __device__ __forceinline__ void norm_mod_rows(const void* __restrict__ Xv, const float* __restrict__ gw, const float* __restrict__ mod, int sh_off, int sc_off,
                                              h16* __restrict__ H, int G, int bid) {
    const int lane = threadIdx.x & 63, wave = threadIdx.x >> 6;
    for (int r = bid * 8 + wave; r < NT; r += G * 8) {
        const int b = r >> 13; f32x4 v[8]; float ss = 0.f;
        if (IN_F16) { const h16* xr = (const h16*)Xv + (size_t)r * DM;
#pragma unroll
            for (int i = 0; i < 8; ++i) { const half4 hv = *(const half4*)(xr + 4 * (lane + 64 * i)); v[i] = (f32x4){(float)hv[0], (float)hv[1], (float)hv[2], (float)hv[3]}; } }
        else { const float* xr = (const float*)Xv + (size_t)r * DM;
#pragma unroll
            for (int i = 0; i < 8; ++i) v[i] = *(const f32x4*)(xr + 4 * (lane + 64 * i)); }
#pragma unroll
        for (int i = 0; i < 8; ++i) ss += v[i][0] * v[i][0] + v[i][1] * v[i][1] + v[i][2] * v[i][2] + v[i][3] * v[i][3];
        ss = wave_sum(ss); const float rstd = rsqrtf(ss * (1.f / DM) + EPS);
        const float* mb = mod + (size_t)b * 12288;
#pragma unroll
        for (int i = 0; i < 8; ++i) { const int c = 4 * (lane + 64 * i);
            const f32x4 g = *(const f32x4*)(gw + c), sh = *(const f32x4*)(mb + sh_off + c), sc = *(const f32x4*)(mb + sc_off + c);
            const f32x4 o = (v[i] * rstd) * g * (1.f + sc) + sh;
            u32x2 w; w.x = pg8::pk2<BF>(o[0], o[1]); w.y = pg8::pk2<BF>(o[2], o[3]);
            *(u32x2*)(H + (size_t)r * DM + c) = w; }
    }
}
__device__ __forceinline__ void final_norm_rows(const h16* __restrict__ X, float* __restrict__ O, const float* __restrict__ gw, int G, int bid) {
    const int lane = threadIdx.x & 63, wave = threadIdx.x >> 6;
    for (int r = bid * 8 + wave; r < NT; r += G * 8) {
        const h16* xr = X + (size_t)r * DM; f32x4 v[8]; float ss = 0.f;
#pragma unroll
        for (int i = 0; i < 8; ++i) { const half4 hv = *(const half4*)(xr + 4 * (lane + 64 * i)); v[i] = (f32x4){(float)hv[0], (float)hv[1], (float)hv[2], (float)hv[3]};
            ss += v[i][0] * v[i][0] + v[i][1] * v[i][1] + v[i][2] * v[i][2] + v[i][3] * v[i][3]; }
        ss = wave_sum(ss); const float rstd = rsqrtf(ss * (1.f / DM) + EPS);
#pragma unroll
        for (int i = 0; i < 8; ++i) { const int c = 4 * (lane + 64 * i); const f32x4 g = *(const f32x4*)(gw + c); *(f32x4*)(O + (size_t)r * DM + c) = (v[i] * rstd) * g; }
    }
}

__device__ __forceinline__ void post_u_rows(const Ptrs& P, int G, int bid) {
    const int lane = threadIdx.x & 63, wave = threadIdx.x >> 6;
    h16* U = (h16*)(P.ws + WS_U); h16* MIX = (h16*)(P.ws + WS_H);
    const float* cw = P.in[6]; const float* cb = P.in[7]; const float* gcv = P.in[14];
    const int hsel = lane >> 3, c8 = lane & 7;
    float inv[8];
#pragma unroll
    for (int e = 0; e < 8; ++e) inv[e] = (float)exp2(-(double)(8 * c8 + e) * (13.287712379549449 / 64.0));
    float wcb[16], wc0[16], wc1[16], wc2[16], wg[16];
#pragma unroll
    for (int hf = 0; hf < 2; ++hf)
#pragma unroll
        for (int j = 0; j < 8; ++j) { const int ch = 512 * hf + 8 * lane + j; wcb[8 * hf + j] = cb[ch]; wc0[8 * hf + j] = cw[ch]; wc1[8 * hf + j] = cw[1024 + ch]; wc2[8 * hf + j] = cw[2048 + ch]; wg[8 * hf + j] = gcv[ch]; }
    for (int r = bid * 8 + wave; r < NT; r += G * 8) {
        const int pos = r & (SEQ - 1); h16* u = U + (size_t)r * DINP;
        float cs[8], sn[8];
#pragma unroll
        for (int e = 0; e < 8; ++e) { const float ang = (float)pos * inv[e];
            double rev = (double)ang * 0.15915494309189535; rev -= __builtin_rint(rev);
            const float rf = (float)rev; cs[e] = __builtin_amdgcn_cosf(rf); sn[e] = __builtin_amdgcn_sinf(rf); }
#pragma unroll
        for (int rd = 0; rd < 2; ++rd) {
            const int base = rd == 0 ? OFF_Q + 128 * hsel : (hsel < 2 ? OFF_KC + 128 * hsel : (hsel < 4 ? OFF_KS + 128 * (hsel - 2) : OFF_KW + 128 * (hsel - 4)));
            if (rd == 0 || hsel < 6) {
                const half8 x1 = *(const half8*)(u + base + 8 * c8), x2 = *(const half8*)(u + base + 64 + 8 * c8); half8 o1, o2;
#pragma unroll
                for (int e = 0; e < 8; ++e) { const float a = (float)x1[e], bq = (float)x2[e]; o1[e] = (h16)(a * cs[e] - bq * sn[e]); o2[e] = (h16)(bq * cs[e] + a * sn[e]); }
                *(half8*)(u + base + 8 * c8) = o1; *(half8*)(u + base + 64 + 8 * c8) = o2; }
        }
        float y[16]; float ss = 0.f;
#pragma unroll
        for (int hf = 0; hf < 2; ++hf) {
            const int ch = 512 * hf + 8 * lane;
            const half8 ub = *(const half8*)(u + OFF_UB + ch), c0 = *(const half8*)(u + OFF_UC + ch), h0 = *(const half8*)(u + OFF_UH + ch);
            half8 c1 = c0 * (h16)0, h1 = c1, c2 = c1, h2 = c1;
            if (pos >= 1) { c1 = *(const half8*)(u - DINP + OFF_UC + ch); h1 = *(const half8*)(u - DINP + OFF_UH + ch); }
            if (pos >= 2) { c2 = *(const half8*)(u - 2 * DINP + OFF_UC + ch); h2 = *(const half8*)(u - 2 * DINP + OFF_UH + ch); }
#pragma unroll
            for (int j = 0; j < 8; ++j) {
                const float v0 = (float)c0[j] * (float)h0[j], v1 = (float)c1[j] * (float)h1[j], v2 = (float)c2[j] * (float)h2[j];
                const float z = wcb[8 * hf + j] + wc0[8 * hf + j] * v2 + wc1[8 * hf + j] * v1 + wc2[8 * hf + j] * v0;
                const float yy = (float)ub[j] * z; y[8 * hf + j] = yy; ss += yy * yy; }
        }
        ss = wave_sum(ss); const float rstd = rsqrtf(ss * (1.f / 1024.f) + EPS);
#pragma unroll
        for (int hf = 0; hf < 2; ++hf) { const int ch = 512 * hf + 8 * lane; float f[8];
#pragma unroll
            for (int j = 0; j < 8; ++j) f[j] = y[8 * hf + j] * rstd * wg[8 * hf + j];
            u32x4 o; o.x = pg8::pk_bf2(f[0], f[1]); o.y = pg8::pk_bf2(f[2], f[3]); o.z = pg8::pk_bf2(f[4], f[5]); o.w = pg8::pk_bf2(f[6], f[7]);
            *(u32x4*)(MIX + (size_t)r * DM + ch) = o; }
    }
}

__device__ __forceinline__ float gelu_tanh(float x) {
    const float z = 0.7978845608028654f * (x + 0.044715f * x * x * x);
    const float e = __expf(2.f * z);
    const float th = 1.f - 2.f / (e + 1.f);
    return 0.5f * x * (1.f + th);
}
__device__ __forceinline__ void compress_phase(const Ptrs& P, LAS unsigned char* lds, int G, int bid) {
    const int tid = threadIdx.x, lane = tid & 63, w = tid >> 6, fr = lane & 15, fq = lane >> 4;
    const h16* U = (const h16*)(P.ws + WS_U);
    LAS h16* hid = (LAS h16*)lds;
    for (int unit = bid; unit < 256; unit += G) {
        const int kv = unit >> 7, bg = (unit >> 4) & 7, nb = unit & 15, b = bg >> 1, g = bg & 1, n0 = nb * 32;
        const h16* W1t = (const h16*)(P.ws + (kv ? WS_CW1V : WS_CW1K));
        const h16* W2t = (const h16*)(P.ws + (kv ? WS_CW2V : WS_CW2K));
        const float* b1p = (const float*)(P.ws + WS_B1P) + kv * 32 * 256;
        h16* OUT = (h16*)(P.ws + (kv ? WS_VCMP : WS_KCMP)) + (size_t)bg * 512 * 128;
        const int coff = (kv ? OFF_VC : OFF_KC) + g * 128;
        f32x4 acc[2][2];
#pragma unroll
        for (int i = 0; i < 2; ++i)
#pragma unroll
            for (int j = 0; j < 2; ++j) acc[i][j] = (f32x4){0.f, 0.f, 0.f, 0.f};
        half8 fa[4][4][2], fb[2][4][2];
        const h16* arow[2];
#pragma unroll
        for (int mt = 0; mt < 2; ++mt) arow[mt] = U + (size_t)(b * SEQ + 16 * (n0 + 16 * mt + fr)) * DINP + coff + 8 * fq;
        const h16* brow[2];
#pragma unroll
        for (int nt = 0; nt < 2; ++nt) brow[nt] = W1t + (size_t)(32 * w + 16 * nt + fr) * 4096 + 8 * fq;
#define CP_LOADA(buf_, pos_) do { _Pragma("unroll") for (int mt = 0; mt < 2; ++mt) { const int t0 = 16 * (n0 + 16 * mt + fr); const int pc = (t0 + (pos_) < SEQ) ? (pos_) : (SEQ - 1 - t0); \
            _Pragma("unroll") for (int ks = 0; ks < 4; ++ks) fa[buf_][ks][mt] = *(const half8*)(arow[mt] + (size_t)pc * DINP + 32 * ks); } } while (0)
#define CP_LOADB(buf_, pos_) do { _Pragma("unroll") for (int ks = 0; ks < 4; ++ks) _Pragma("unroll") for (int nt = 0; nt < 2; ++nt) fb[buf_][ks][nt] = *(const half8*)(brow[nt] + (pos_) * 128 + 32 * ks); } while (0)
#define CP_MMA(ba_, bb_) do { _Pragma("unroll") for (int ks = 0; ks < 4; ++ks) _Pragma("unroll") for (int mt = 0; mt < 2; ++mt) _Pragma("unroll") for (int nt = 0; nt < 2; ++nt) \
            acc[mt][nt] = __builtin_amdgcn_mfma_f32_16x16x32_f16(fa[ba_][ks][mt], fb[bb_][ks][nt], acc[mt][nt], 0, 0, 0); } while (0)
        CP_LOADA(0, 0); CP_LOADB(0, 0); CP_LOADA(1, 1); CP_LOADA(2, 2);
#pragma unroll 1
        for (int pos = 0; pos < 32; pos += 4) {
            CP_LOADB(1, pos + 1); CP_LOADA(3, pos + 3); CP_MMA(0, 0);
            CP_LOADB(0, pos + 2); if (pos + 4 < 32) CP_LOADA(0, pos + 4); CP_MMA(1, 1);
            CP_LOADB(1, pos + 3); if (pos + 5 < 32) CP_LOADA(1, pos + 5); CP_MMA(2, 0);
            if (pos + 4 < 32) CP_LOADB(0, pos + 4); if (pos + 6 < 32) CP_LOADA(2, pos + 6); CP_MMA(3, 1);
        }
#undef CP_LOADA
#undef CP_LOADB
#undef CP_MMA
#pragma unroll
        for (int nt = 0; nt < 2; ++nt) { const int col = 32 * w + 16 * nt + fr; float bias = 0.f;
            { float bp[8];
#pragma unroll
              for (int q = 0; q < 8; ++q) bp[q] = b1p[(8 * fq + q) * 256 + col];
              bias = ((bp[0] + bp[1]) + (bp[2] + bp[3])) + ((bp[4] + bp[5]) + (bp[6] + bp[7]));
              bias += __shfl_xor(bias, 16); bias += __shfl_xor(bias, 32); }
#pragma unroll
            for (int mt = 0; mt < 2; ++mt)
#pragma unroll
                for (int j = 0; j < 4; ++j) hid[(16 * mt + 4 * fq + j) * 264 + col] = (h16)gelu_tanh(acc[mt][nt][j] + bias); }
        __syncthreads();
        f32x4 acc2[2]; acc2[0] = (f32x4){0.f, 0.f, 0.f, 0.f}; acc2[1] = acc2[0];
#pragma unroll
        for (int ks = 0; ks < 8; ++ks) {
            const half8 bb = *(const half8*)(W2t + (size_t)(16 * w + fr) * 256 + 32 * ks + 8 * fq);
#pragma unroll
            for (int mt = 0; mt < 2; ++mt) { const half8 a = *(const LAS half8*)(hid + (16 * mt + fr) * 264 + 32 * ks + 8 * fq);
                acc2[mt] = __builtin_amdgcn_mfma_f32_16x16x32_f16(a, bb, acc2[mt], 0, 0, 0); }
        }
#pragma unroll
        for (int mt = 0; mt < 2; ++mt)
#pragma unroll
            for (int j = 0; j < 4; ++j) OUT[(size_t)(n0 + 16 * mt + 4 * fq + j) * 128 + 16 * w + fr] = (h16)acc2[mt][j];
        __syncthreads();
    }
}

typedef short s16x4 __attribute__((ext_vector_type(4)));
typedef short s16x8 __attribute__((ext_vector_type(8)));
template <bool a0, bool a1> __device__ __forceinline__ void af_qk(const LAS unsigned char* kbuf, const unsigned (&kl)[4], const half8 (&qf)[2][4], f32x4 (&s)[2][4]) {
    const LAS unsigned char* ka[4];
    { int _ln; asm volatile("v_mov_b32 %0, %1" : "=v"(_ln) : "v"(kl[0]));
      const int fr_ = _ln & 15, e_ = (_ln >> 4) ^ fr_;
#pragma unroll
      for (int ks = 0; ks < 4; ++ks) ka[ks] = kbuf + fr_ * 256 + ((e_ ^ (4 * ks)) << 4); }
    half8 kf[2][4];
#pragma unroll
    for (int ks = 0; ks < 4; ++ks) kf[0][ks] = *(const LAS half8*)(ka[ks]);
#pragma unroll
    for (int kt = 0; kt < 4; ++kt) {
        if (kt < 3) {
#pragma unroll
            for (int ks = 0; ks < 4; ++ks) kf[(kt + 1) & 1][ks] = *(const LAS half8*)(ka[ks] + (kt + 1) * 4096); }
        s[0][kt] = (f32x4){0.f, 0.f, 0.f, 0.f}; s[1][kt] = (f32x4){0.f, 0.f, 0.f, 0.f};
#pragma unroll
        for (int ks = 0; ks < 4; ++ks) {
            if (a0) s[0][kt] = __builtin_amdgcn_mfma_f32_16x16x32_f16(kf[kt & 1][ks], qf[0][ks], s[0][kt], 0, 0, 0);
            if (a1) s[1][kt] = __builtin_amdgcn_mfma_f32_16x16x32_f16(kf[kt & 1][ks], qf[1][ks], s[1][kt], 0, 0, 0); }
        __builtin_amdgcn_sched_barrier(0);
    }
}
template <bool a0, bool a1> __device__ __forceinline__ void af_pv(const LAS unsigned char* vbuf, unsigned vl0, int z, const half8 (&pf)[2][2], f32x4 (&o)[2][8]) {
    const unsigned rb = (unsigned)(__UINTPTR_TYPE__)(vbuf + vl0);
    s16x4 vr[2][8];
#define AF_VLOAD(buf_, dt_) asm volatile("ds_read_b64_tr_b16 %0, %8\n\tds_read_b64_tr_b16 %1, %8 offset:4096\n\tds_read_b64_tr_b16 %2, %8 offset:8192\n\tds_read_b64_tr_b16 %3, %8 offset:12288\n\t" \
        "ds_read_b64_tr_b16 %4, %9\n\tds_read_b64_tr_b16 %5, %9 offset:4096\n\tds_read_b64_tr_b16 %6, %9 offset:8192\n\tds_read_b64_tr_b16 %7, %9 offset:12288" \
        : "=&v"(vr[buf_][0]), "=&v"(vr[buf_][1]), "=&v"(vr[buf_][2]), "=&v"(vr[buf_][3]), "=&v"(vr[buf_][4]), "=&v"(vr[buf_][5]), "=&v"(vr[buf_][6]), "=&v"(vr[buf_][7]) \
        : "v"(rb + ((unsigned)((dt_) ^ z) << 5)), "v"(rb + ((unsigned)(((dt_) + 1) ^ z) << 5)) : "memory")
#define AF_VWAIT(buf_, n_) asm volatile("s_waitcnt lgkmcnt(" #n_ ")" : "+v"(vr[buf_][0]), "+v"(vr[buf_][1]), "+v"(vr[buf_][2]), "+v"(vr[buf_][3]), "+v"(vr[buf_][4]), "+v"(vr[buf_][5]), "+v"(vr[buf_][6]), "+v"(vr[buf_][7]) :: "memory")
#define AF_VMMA(buf_, dt0_) do { _Pragma("unroll") for (int dd = 0; dd < 2; ++dd) _Pragma("unroll") for (int kp = 0; kp < 2; ++kp) { \
            const s16x4 lo = vr[buf_][4 * dd + 2 * kp], hi = vr[buf_][4 * dd + 2 * kp + 1]; \
            s16x8 v8; v8[0] = lo[0]; v8[1] = lo[1]; v8[2] = lo[2]; v8[3] = lo[3]; v8[4] = hi[0]; v8[5] = hi[1]; v8[6] = hi[2]; v8[7] = hi[3]; \
            const half8 vf = __builtin_bit_cast(half8, v8); \
            if (a0) o[0][(dt0_) + dd] = __builtin_amdgcn_mfma_f32_16x16x32_f16(vf, pf[0][kp], o[0][(dt0_) + dd], 0, 0, 0); \
            if (a1) o[1][(dt0_) + dd] = __builtin_amdgcn_mfma_f32_16x16x32_f16(vf, pf[1][kp], o[1][(dt0_) + dd], 0, 0, 0); } \
        __builtin_amdgcn_sched_barrier(0); } while (0)
    AF_VLOAD(0, 0); AF_VLOAD(1, 2);
    AF_VWAIT(0, 8); AF_VMMA(0, 0); AF_VLOAD(0, 4);
    AF_VWAIT(1, 8); AF_VMMA(1, 2); AF_VLOAD(1, 6);
    AF_VWAIT(0, 8); AF_VMMA(0, 4);
    AF_VWAIT(1, 0); AF_VMMA(1, 6);
#undef AF_VMMA
#undef AF_VLOAD
#undef AF_VWAIT
}
__device__ __forceinline__ void af_maskraw(f32x4 (&s)[4], int mbase, int mstep, int fq, int hi, int lo) {
#pragma unroll
    for (int kt = 0; kt < 4; ++kt)
#pragma unroll
        for (int jj = 0; jj < 4; ++jj) { const int met = mbase + mstep * (16 * kt + 4 * fq + jj); s[kt][jj] = (met <= hi && met > lo) ? s[kt][jj] : -3.0e38f; }
}
__device__ __forceinline__ float af_colmax(const f32x4 (&s)[4]) {
    float v = -1.0e30f;
#pragma unroll
    for (int kt = 0; kt < 4; ++kt) v = fmaxf(v, fmaxf(fmaxf(s[kt][0], s[kt][1]), fmaxf(s[kt][2], s[kt][3])));
    v = fmaxf(v, __shfl_xor(v, 16)); v = fmaxf(v, __shfl_xor(v, 32)); return v;
}
__device__ __forceinline__ void af_pack(const f32x4 (&s)[4], half8 (&pf)[2]) {
#pragma unroll
    for (int kp = 0; kp < 2; ++kp) { half8 h;
#pragma unroll
        for (int jj = 0; jj < 4; ++jj) { h[jj] = (h16)s[2 * kp][jj]; h[4 + jj] = (h16)s[2 * kp + 1][jj]; }
        pf[kp] = h; }
}
__device__ __forceinline__ float af_rawmax(const f32x4 (&s)[4]) {
    float v = fmaxf(fmaxf(s[0][0], s[0][1]), fmaxf(s[0][2], s[0][3]));
#pragma unroll
    for (int kt = 1; kt < 4; ++kt) v = fmaxf(v, fmaxf(fmaxf(s[kt][0], s[kt][1]), fmaxf(s[kt][2], s[kt][3])));
    v = fmaxf(v, __shfl_xor(v, 16)); v = fmaxf(v, __shfl_xor(v, 32)); return v;
}
__device__ __forceinline__ void af_online_fast(f32x4 (&s)[4], bool colsel, float& m, float& l, f32x4 (&o)[8], half8 (&pf)[2], float SC) {
    float lm = fmaxf(fmaxf(s[0][0], s[0][1]), fmaxf(s[0][2], s[0][3]));
#pragma unroll
    for (int kt = 1; kt < 4; ++kt) lm = fmaxf(lm, fmaxf(fmaxf(s[kt][0], s[kt][1]), fmaxf(s[kt][2], s[kt][3])));
    if (__ballot(colsel && (lm * SC > m + 8.f)) != 0ull) {
        float v = lm; v = fmaxf(v, __shfl_xor(v, 16)); v = fmaxf(v, __shfl_xor(v, 32));
        const float mloc = colsel ? v * SC : -1.0e30f;
        const float mn = fmaxf(m, mloc); const float al = __builtin_amdgcn_exp2f(m - mn); m = mn;
        l *= al;
#pragma unroll
        for (int dt = 0; dt < 8; ++dt) o[dt] *= al;
    }
    const float bias = colsel ? -m : -1.0e30f; float ps = 0.f;
#pragma unroll
    for (int kt = 0; kt < 4; ++kt)
#pragma unroll
        for (int jj = 0; jj < 4; ++jj) { const float p = __builtin_amdgcn_exp2f(__builtin_fmaf(s[kt][jj], SC, bias)); s[kt][jj] = p; ps += p; }
    l += ps;
    af_pack(s, pf);
}
__device__ __forceinline__ float af_write(float* Y, size_t row, int colbase, const f32x4 (&o)[8], float sc, bool accumulate) {
    float ss = 0.f;
#pragma unroll
    for (int dt = 0; dt < 8; ++dt) { float* p = Y + row * 1024 + colbase + 16 * dt; f32x4 v = o[dt] * sc; if (accumulate) v += *(const f32x4*)p; *(f32x4*)p = v;
        ss += (v[0] * v[0] + v[1] * v[1]) + (v[2] * v[2] + v[3] * v[3]); }
    return ss;
}
__device__ __forceinline__ float af_sigmoid(float x) { return 1.f / (1.f + __expf(-x)); }

template <bool A0, bool A1>
__device__ __forceinline__ void af_tile_online(const LAS unsigned char* stage, const unsigned (&kl)[4], unsigned vl0, int vz, const half8 (&qf)[2][4], f32x4 (&s)[2][4],
                                               float (&m)[2], float (&l)[2], f32x4 (&o)[2][8], bool needmask, int mbase, int fq, const int (&hi)[2], const int (&lo)[2], float SC) {
    af_qk<A0, A1>(stage, kl, qf, s);
    half8 pf[2][2];
    if (A0) { if (needmask) af_maskraw(s[0], mbase, 1, fq, hi[0], lo[0]); af_online_fast(s[0], hi[0] >= 0, m[0], l[0], o[0], pf[0], SC); } else { pf[0][0] = qf[0][0]; pf[0][1] = qf[0][0]; }
    if (A1) { if (needmask) af_maskraw(s[1], mbase, 1, fq, hi[1], lo[1]); af_online_fast(s[1], hi[1] >= 0, m[1], l[1], o[1], pf[1], SC); } else { pf[1][0] = qf[1][0]; pf[1][1] = qf[1][0]; }
    af_pv<A0, A1>(stage + 16384, vl0, vz, pf, o);
}
#define AF_ISSUE(st_, kb_, vb_, gs_, r0_, needv_) do { int _ln; asm volatile("v_mov_b32 %0, %1" : "=v"(_ln) : "v"(lane)); \
      _Pragma("unroll") for (int _c = 0; _c < 2; ++_c) { const int _row = 8 * w + 4 * _c + (_ln >> 4); \
      const h16* _kp = (kb_) + (size_t)((r0_) + _row) * (gs_) + (((_ln & 15) ^ (_row & 15)) << 3); \
      __builtin_amdgcn_global_load_lds((const unsigned*)_kp, (LAS unsigned*)(lds + (st_) * 32768 + (2 * w + _c) * 1024), 16, 0, 0); \
      if (needv_) { const h16* _vp = (vb_) + (size_t)((r0_) + _row) * (gs_) + (((_ln & 15) ^ (2 * (_row & 7))) << 3); \
      __builtin_amdgcn_global_load_lds((const unsigned*)_vp, (LAS unsigned*)(lds + (st_) * 32768 + 16384 + (2 * w + _c) * 1024), 16, 0, 0); } } } while (0)
#define AF_WAITV(n) asm volatile("s_waitcnt vmcnt(" #n ")" ::: "memory")
#define AF_BAR() do { __builtin_amdgcn_s_barrier(); asm volatile("" ::: "memory"); } while (0)

__device__ __forceinline__ void attn_fast(const Ptrs& P, LAS unsigned char* lds, int G, int bid) {
    const int tid = threadIdx.x, lane = tid & 63, w = __builtin_amdgcn_readfirstlane(tid >> 6), fr = lane & 15, fq = lane >> 4, qi = fr >> 2, hh = fr & 3;
    LAS float* IMP = (LAS float*)(lds + 98304) + w * (8 * 132);
    LAS unsigned* SELM = (LAS unsigned*)(lds + 132096);
    const h16* U = (const h16*)(P.ws + WS_U); float* Y = (float*)(P.ws + WS_YACC);
    const float SC = 0.08838834764831845f * 1.4426950408889634f;
    const int NEGBIG = -(1 << 30);
    unsigned kl[4]; kl[0] = (unsigned)lane; kl[1] = kl[2] = kl[3] = 0u;
    const int vz = (4 * fq + (fr >> 2)) & 7;
    const unsigned vl0 = (unsigned)((4 * fq + (fr >> 2)) * 256 + 8 * (fr & 1) + 16 * ((fr >> 1) & 1));
    const int nunits = (512 + G - 1) / G;
#pragma unroll 1
    for (int ui = 0; ui < nunits; ++ui) {
        int b, qb;
        if (G == 256) { const int idx = (bid & 1) * 32 + (bid >> 3); b = (bid & 7) >> 1; qb = ui == 0 ? 127 - idx : idx; }
        else { const int u = ui * G + bid; if (u >= 512) break;
               b = u >> 7; qb = (((u & 1) ^ ((u >> 8) & 1)) != 0) ? 127 - ((u >> 1) & 63) : ((u >> 1) & 63); }
#pragma unroll 1
        for (int g = 0; g < 2; ++g) {
            const int bg = 2 * b + g;
            int tq[2]; tq[0] = 64 * qb + 8 * w + qi; tq[1] = tq[0] + 4;
            const h16* Ub = U + (size_t)b * SEQ * DINP;
            half8 qf[2][4];
#pragma unroll
            for (int ct = 0; ct < 2; ++ct)
#pragma unroll
                for (int ks = 0; ks < 4; ++ks) qf[ct][ks] = *(const half8*)(Ub + (size_t)tq[ct] * DINP + OFF_Q + (4 * g + hh) * 128 + 32 * ks + 8 * fq);
            for (int i = lane; i < 8 * 132; i += 64) IMP[i] = 0.f;
            f32x4 s[2][4];
            const h16* KC = (const h16*)(P.ws + WS_KCMP) + (size_t)bg * 512 * 128;
            const h16* VC = (const h16*)(P.ws + WS_VCMP) + (size_t)bg * 512 * 128;
            const int ntc = ((4 * qb + 2) >> 6) + 1;
            float m[2], l[2];
            m[0] = m[1] = -1.0e30f; l[0] = l[1] = 0.f;
            AF_ISSUE(0, KC, VC, 128, 0, false);
            if (ntc > 1) AF_ISSUE(1, KC, VC, 128, 64, false);
#pragma unroll 1
            for (int T = 0; T < ntc; ++T) {
                if (T + 1 < ntc) AF_WAITV(2); else AF_WAITV(0);
                AF_BAR();
                if (T + 2 < ntc) AF_ISSUE((T + 2) % 3, KC, VC, 128, 64 * (T + 2), false);
                af_qk<true, true>(lds + (T % 3) * 32768, kl, qf, s);
#pragma unroll
                for (int ct = 0; ct < 2; ++ct) {
                    if (1024 * T + 1039 > 64 * qb) af_maskraw(s[ct], 1024 * T + 31, 16, fq, tq[ct], NEGBIG);
                    const float mn = fmaxf(m[ct], af_rawmax(s[ct]) * SC); const float al = __builtin_amdgcn_exp2f(m[ct] - mn); m[ct] = mn; float ps = 0.f;
#pragma unroll
                    for (int kt = 0; kt < 4; ++kt)
#pragma unroll
                        for (int jj = 0; jj < 4; ++jj) ps += __builtin_amdgcn_exp2f(__builtin_fmaf(s[ct][kt][jj], SC, -mn));
                    l[ct] = l[ct] * al + ps; }
            }
            float il[2];
#pragma unroll
            for (int ct = 0; ct < 2; ++ct) { float lt = l[ct]; lt += __shfl_xor(lt, 16); lt += __shfl_xor(lt, 32); il[ct] = lt > 0.f ? 1.f / lt : 0.f; }
            f32x4 o[2][8];
#pragma unroll
            for (int ct = 0; ct < 2; ++ct)
#pragma unroll
                for (int dt = 0; dt < 8; ++dt) o[ct][dt] = (f32x4){0.f, 0.f, 0.f, 0.f};
            AF_BAR();
            AF_ISSUE(0, KC, VC, 128, 0, true);
            if (ntc > 1) AF_ISSUE(1, KC, VC, 128, 64, true);
#pragma unroll 1
            for (int T = 0; T < ntc; ++T) {
                if (T + 1 < ntc) AF_WAITV(4); else AF_WAITV(0);
                AF_BAR();
                if (T + 2 < ntc) AF_ISSUE((T + 2) % 3, KC, VC, 128, 64 * (T + 2), true);
                af_qk<true, true>(lds + (T % 3) * 32768, kl, qf, s);
                half8 pf[2][2];
#pragma unroll
                for (int ct = 0; ct < 2; ++ct) {
                    if (1024 * T + 1039 > 64 * qb) af_maskraw(s[ct], 1024 * T + 31, 16, fq, tq[ct], NEGBIG);
#pragma unroll
                    for (int kt = 0; kt < 4; ++kt) {
#pragma unroll
                        for (int jj = 0; jj < 4; ++jj) s[ct][kt][jj] = __builtin_amdgcn_exp2f(__builtin_fmaf(s[ct][kt][jj], SC, -m[ct])) * il[ct];
                        float s4 = (s[ct][kt][0] + s[ct][kt][1]) + (s[ct][kt][2] + s[ct][kt][3]), s3 = s[ct][kt][3];
                        s4 += __shfl_xor(s4, 1); s4 += __shfl_xor(s4, 2); s3 += __shfl_xor(s3, 1); s3 += __shfl_xor(s3, 2);
                        if (hh == 0) { LAS float* ip = IMP + (4 * ct + qi) * 132 + 16 * T + 4 * kt + fq;
                            __hip_atomic_fetch_add(ip, s4, __ATOMIC_RELAXED, __HIP_MEMORY_SCOPE_WORKGROUP);
                            __hip_atomic_fetch_add(ip + 1, s3, __ATOMIC_RELAXED, __HIP_MEMORY_SCOPE_WORKGROUP); }
                    }
                    af_pack(s[ct], pf[ct]); }
                af_pv<true, true>(lds + (T % 3) * 32768 + 16384, vl0, vz, pf, o);
            }
#pragma unroll
            for (int ct = 0; ct < 2; ++ct) { int _ln; asm volatile("v_mov_b32 %0, %1" : "=v"(_ln) : "v"(lane));
                const int fr_ = _ln & 15, fq_ = _ln >> 4, hh_ = fr_ & 3;
                const size_t row = (size_t)b * SEQ + 64 * qb + 8 * w + 4 * ct + (fr_ >> 2);
                const float g0 = af_sigmoid((float)U[row * DINP + OFF_GL + (4 * g + hh_) * 3 + 0]);
                af_write(Y, row, (4 * g + hh_) * 128 + 4 * fq_, o[ct], g0, false); }
            __syncthreads();
#pragma unroll 1
            for (int ql = 0; ql < 8; ql += 2) {
                LAS float* rowa = IMP + ql * 132; LAS float* rowb = rowa + 132;
                float a0, a1, b0, b1;
                { const int j = lane; const bool valid = j <= qb, forced = (j == 0) || (j == qb) || (j == qb - 1); const float bonus = forced ? 1.0e4f : 0.f;
                  const float va = rowa[j], vb = rowb[j]; a0 = valid ? va + bonus : -1.f; b0 = valid ? vb + bonus : -1.f; rowa[j] = a0; rowb[j] = b0; }
                { const int j = lane + 64; const bool valid = j <= qb, forced = (j == 0) || (j == qb) || (j == qb - 1); const float bonus = forced ? 1.0e4f : 0.f;
                  const float va = rowa[j], vb = rowb[j]; a1 = valid ? va + bonus : -1.f; b1 = valid ? vb + bonus : -1.f; rowa[j] = a1; rowb[j] = b1; }
                int ra0 = 0, ra1 = 0, rb0 = 0, rb1 = 0;
                for (int j4 = 0; j4 <= qb; j4 += 4) { const f32x4 xa = *(const LAS f32x4*)(rowa + j4); const f32x4 xb = *(const LAS f32x4*)(rowb + j4);
#pragma unroll
                    for (int e = 0; e < 4; ++e) { const int j = j4 + e;
                        ra0 += (xa[e] > a0 || (xa[e] == a0 && j < lane)) ? 1 : 0; ra1 += (xa[e] > a1 || (xa[e] == a1 && j < lane + 64)) ? 1 : 0;
                        rb0 += (xb[e] > b0 || (xb[e] == b0 && j < lane)) ? 1 : 0; rb1 += (xb[e] > b1 || (xb[e] == b1 && j < lane + 64)) ? 1 : 0; } }
                const unsigned long long alo = __ballot(ra0 < 16 && lane <= qb), ahi = __ballot(ra1 < 16 && lane + 64 <= qb);
                const unsigned long long blo = __ballot(rb0 < 16 && lane <= qb), bhi = __ballot(rb1 < 16 && lane + 64 <= qb);
                if (lane == 0) { LAS unsigned* sp = SELM + (8 * w + ql) * 4; sp[0] = (unsigned)alo; sp[1] = (unsigned)(alo >> 32); sp[2] = (unsigned)ahi; sp[3] = (unsigned)(ahi >> 32);
                                 sp[4] = (unsigned)blo; sp[5] = (unsigned)(blo >> 32); sp[6] = (unsigned)bhi; sp[7] = (unsigned)(bhi >> 32); }
            }
            __syncthreads();
#pragma unroll 1
            for (int br = 1; br < 3; ++br) {
                const h16* KB = Ub + (br == 1 ? OFF_KS : OFF_KW) + g * 128;
                const h16* VB = Ub + (br == 1 ? OFF_VS : OFF_VW) + g * 128;
                const int j_lo = br == 1 ? 0 : (qb >= 8 ? qb - 8 : 0);
                const int nt = qb - j_lo + 1;
                m[0] = m[1] = -1.0e30f; l[0] = l[1] = 0.f;
#pragma unroll
                for (int ct = 0; ct < 2; ++ct)
#pragma unroll
                    for (int dt = 0; dt < 8; ++dt) o[ct][dt] = (f32x4){0.f, 0.f, 0.f, 0.f};
                AF_ISSUE(0, KB, VB, DINP, 64 * j_lo, true);
                if (nt > 1) AF_ISSUE(1, KB, VB, DINP, 64 * (j_lo + 1), true);
                if (nt > 2) AF_ISSUE(2, KB, VB, DINP, 64 * (j_lo + 2), true);
#pragma unroll 1
                for (int i = 0; i < nt; ++i) {
                    const int j = j_lo + i;
                    if (i + 2 < nt) AF_WAITV(8); else if (i + 1 < nt) AF_WAITV(4); else AF_WAITV(0);
                    AF_BAR();
                    if (i + 3 < nt) AF_ISSUE((i + 3) & 3, KB, VB, DINP, 64 * (j + 3), true);
                    int hi[2], lo[2]; bool act[2];
                    const bool needmask = (j == qb) || (br == 2 && 64 * j <= 64 * qb + 63 - 512);
#pragma unroll
                    for (int ct = 0; ct < 2; ++ct) {
                        if (br == 1) { const unsigned wd = SELM[(8 * w + 4 * ct + qi) * 4 + (j >> 5)]; const bool bit = (wd >> (j & 31)) & 1u;
                            act[ct] = __ballot(bit) != 0ull; hi[ct] = bit ? tq[ct] : -1; lo[ct] = NEGBIG; }
                        else { act[ct] = true; hi[ct] = tq[ct]; lo[ct] = tq[ct] - 512; }
                    }
                    const LAS unsigned char* stg = lds + (i & 3) * 32768;
                    if (act[0] && act[1]) af_tile_online<true, true>(stg, kl, vl0, vz, qf, s, m, l, o, needmask, 64 * j, fq, hi, lo, SC);
                    else if (act[0])      af_tile_online<true, false>(stg, kl, vl0, vz, qf, s, m, l, o, needmask, 64 * j, fq, hi, lo, SC);
                    else if (act[1])      af_tile_online<false, true>(stg, kl, vl0, vz, qf, s, m, l, o, needmask, 64 * j, fq, hi, lo, SC);
                }
#pragma unroll
                for (int ct = 0; ct < 2; ++ct) { int _ln; asm volatile("v_mov_b32 %0, %1" : "=v"(_ln) : "v"(lane));
                    const int fr_ = _ln & 15, fq_ = _ln >> 4, hh_ = fr_ & 3;
                    const size_t row = (size_t)b * SEQ + 64 * qb + 8 * w + 4 * ct + (fr_ >> 2);
                    float lt = l[ct]; lt += __shfl_xor(lt, 16); lt += __shfl_xor(lt, 32);
                    const float gg = af_sigmoid((float)U[row * DINP + OFF_GL + (4 * g + hh_) * 3 + br]);
                    (void)af_write(Y, row, (4 * g + hh_) * 128 + 4 * fq_, o[ct], lt > 0.f ? gg / lt : 0.f, true); }
                AF_BAR();
            }
        }
        {
            h16* MIX = (h16*)(P.ws + WS_H); const float* gw = P.in[15];
            int _ln; asm volatile("v_mov_b32 %0, %1" : "=v"(_ln) : "v"(lane));
            const int fr_ = _ln & 15, fq_ = _ln >> 4, hh_ = fr_ & 3;
#pragma unroll 1
            for (int ct = 0; ct < 2; ++ct) {
                const size_t row = (size_t)b * SEQ + 64 * qb + 8 * w + 4 * ct + (fr_ >> 2);
                float sv = 0.f;
#pragma unroll
                for (int g2 = 0; g2 < 2; ++g2)
#pragma unroll
                    for (int dt = 0; dt < 8; ++dt) { const f32x4 v = *(const f32x4*)(Y + row * 1024 + (4 * g2 + hh_) * 128 + 16 * dt + 4 * fq_);
                        sv += (v[0] * v[0] + v[1] * v[1]) + (v[2] * v[2] + v[3] * v[3]); }
                sv += __shfl_xor(sv, 1); sv += __shfl_xor(sv, 2); sv += __shfl_xor(sv, 16); sv += __shfl_xor(sv, 32);
                const float rstd = rsqrtf(sv * (1.f / 1024.f) + EPS);
#pragma unroll 1
                for (int g2 = 0; g2 < 2; ++g2)
#pragma unroll
                    for (int dt = 0; dt < 8; ++dt) { const int ch = (4 * g2 + hh_) * 128 + 16 * dt + 4 * fq_;
                        const f32x4 v = *(const f32x4*)(Y + row * 1024 + ch); const f32x4 gv = *(const f32x4*)(gw + ch); const f32x4 ov = v * rstd * gv;
                        u32x2 wv; wv.x = pg8::pk_bf2(ov[0], ov[1]); wv.y = pg8::pk_bf2(ov[2], ov[3]);
                        *(u32x2*)(MIX + row * DM + 1024 + ch) = wv; }
            }
        }
    }
}

#define XB_TMO      128
#define XB_XCNT(j)  (256  + 64 * (j))
#define XB_XSUB(j)  (1280 + 64 * (j))
#define XB_XGEN(j)  (2304 + 64 * (j))
#define XB_TOP      3328
#define XB_TOPGEN   3392
#define XCD_BAR_WORDS 3456
#define XB_SPIN_CAP (1u << 18)
__device__ __forceinline__ unsigned xb_ld(unsigned* p)              { return __hip_atomic_load(p, __ATOMIC_RELAXED, __HIP_MEMORY_SCOPE_AGENT); }
__device__ __forceinline__ unsigned xb_add(unsigned* p, unsigned v) { return __hip_atomic_fetch_add(p, v, __ATOMIC_RELAXED, __HIP_MEMORY_SCOPE_AGENT); }
__device__ __forceinline__ unsigned xb_xcc_id() { return (unsigned)__builtin_amdgcn_s_getreg((3 << 11) | 20) & 0xFu; }
#define XB_SPIN(cond, bar) do { unsigned _sp = 0; while (cond) { __builtin_amdgcn_s_sleep(1); \
    if ((++_sp & 255u) == 0u) { if (xb_ld(&(bar)[XB_TMO])) break; if (_sp > XB_SPIN_CAP) { atomicAdd(&(bar)[XB_TMO], 1u); break; } } } } while (0)
struct XcdBarrier { unsigned* bar; unsigned x; volatile LAS unsigned* st; };
__device__ __forceinline__ XcdBarrier xcd_barrier_post(unsigned* bar, volatile LAS unsigned* st) {
    XcdBarrier b; b.bar = bar; b.x = xb_xcc_id(); b.st = st;
    if (threadIdx.x == 0) (void)xb_add(&bar[XB_XCNT(b.x)], 1u);
    return b;
}
__device__ __forceinline__ void xcd_barrier_complete(unsigned* bar, unsigned x, unsigned& nloc, unsigned& nx) {
    const unsigned G = gridDim.x * gridDim.y * gridDim.z;
    unsigned sum, cnt, mine, sp = 0u;
    for (;;) {
        sum = 0u; cnt = 0u; mine = 0u;
#pragma unroll
        for (unsigned j = 0; j < 16; ++j) { const unsigned c = xb_ld(&bar[XB_XCNT(j)]); sum += c; cnt += (c > 0u) ? 1u : 0u; mine = (j == x) ? c : mine; }
        if (sum == G) break;
        __builtin_amdgcn_s_sleep(1);
        if ((++sp & 255u) == 0u) { if (xb_ld(&bar[XB_TMO])) break; if (sp > XB_SPIN_CAP) { atomicAdd(&bar[XB_TMO], 1u); break; } }
    }
    nloc = mine > 0u ? mine : 1u; nx = cnt > 0u ? cnt : 1u;
}
__device__ __forceinline__ void xcd_barrier(const XcdBarrier& b) {
    asm volatile("s_waitcnt vmcnt(0)" ::: "memory");
    __syncthreads();
    if (threadIdx.x == 0) {
        unsigned* bar = b.bar;
        __builtin_amdgcn_s_waitcnt(0);
        unsigned nloc = b.st[0], nx = b.st[1];
        if (nloc == 0u) { xcd_barrier_complete(bar, b.x, nloc, nx); b.st[0] = nloc; b.st[1] = nx; }
        const unsigned old = xb_add(&bar[XB_XSUB(b.x)], 1u);
        const unsigned gen = old / nloc;
        if (old + 1u == (gen + 1u) * nloc) {
            __builtin_amdgcn_fence(__ATOMIC_RELEASE, "agent");
            asm volatile("s_waitcnt vmcnt(0)" ::: "memory");
            const unsigned og = xb_add(&bar[XB_TOP], 1u);
            const unsigned tg = og / nx;
            if (og + 1u == (tg + 1u) * nx) xb_add(&bar[XB_TOPGEN], 1u);
            else XB_SPIN(xb_ld(&bar[XB_TOPGEN]) == tg, bar);
            __builtin_amdgcn_fence(__ATOMIC_ACQUIRE, "agent");
            xb_add(&bar[XB_XGEN(b.x)], 1u);
            asm volatile("s_waitcnt vmcnt(0)" ::: "memory");
        } else {
            XB_SPIN(xb_ld(&bar[XB_XGEN(b.x)]) == gen, bar);
            __builtin_amdgcn_fence(__ATOMIC_ACQUIRE, "agent");
            asm volatile("s_waitcnt vmcnt(0)" ::: "memory");
        }
    }
    __syncthreads();
}

constexpr int NPHASE = 12;
struct Args { Ptrs p; int ph_lo, ph_hi; };

__global__ void __launch_bounds__(NTHR, 2) mega(Args args) {
    extern __shared__ __attribute__((aligned(16))) unsigned char lds_raw[];
    LAS unsigned char* lds = (LAS unsigned char*)lds_raw;
    const Ptrs& P = args.p;
    const int G = gridDim.x, bid = blockIdx.x;
    unsigned char* ws = P.ws;
    const float* mod = (const float*)(ws + WS_MOD);
    const int lo = args.ph_lo, hi = args.ph_hi;
    volatile LAS unsigned* MISC = (volatile LAS unsigned*)(lds + LDS_BYTES - 64);
    if (threadIdx.x < 16) MISC[threadIdx.x] = 0u;
    __syncthreads();
    XcdBarrier xbar; xbar.bar = (unsigned*)(ws + WS_BAR); xbar.x = 0; xbar.st = MISC;
    if (hi - lo > 1) xbar = xcd_barrier_post((unsigned*)(ws + WS_BAR), MISC);
#define PHASE_BEGIN(n) if (lo <= (n) && (n) < hi) {
#define PHASE_END(n) if ((n) + 1 < hi) { if (G != 256) cg::this_grid().sync(); else xcd_barrier(xbar); } }
    PHASE_BEGIN(0) p0_prologue(P, lds, G, bid); PHASE_END(0)
    PHASE_BEGIN(1) norm_mod_rows<false, false>(P.in[0], P.in[4], mod, 0, 2048, (h16*)(ws + WS_H), G, bid); PHASE_END(1)
    PHASE_BEGIN(2) { pg8::Gemm g{(const h16*)(ws + WS_H), (const h16*)(ws + WS_WIN), NT, DINP, DM}; pg8::StaticOrder S; S.init(NT, DINP, G, bid);
                  pg8::EpiF16<0> E{(h16*)(ws + WS_U), DINP}; pg8::gemm_phase<false>(lds, g, S, E); } PHASE_END(2)
    PHASE_BEGIN(3) post_u_rows(P, G, bid); PHASE_END(3)
    PHASE_BEGIN(4) compress_phase(P, lds, G, bid); PHASE_END(4)
    PHASE_BEGIN(5) attn_fast(P, lds, G, bid); PHASE_END(5)
    PHASE_BEGIN(7) { pg8::Gemm g{(const h16*)(ws + WS_H), (const h16*)(ws + WS_WOUT), NT, DM, DM}; pg8::StaticOrder S; S.init(NT, DM, G, bid);
                  pg8::EpiRes<true> E{P.in[0], (h16*)(ws + WS_X1H), mod + 2 * 2048, 12288}; pg8::gemm_phase<true>(lds, g, S, E); } PHASE_END(7)
    PHASE_BEGIN(8) norm_mod_rows<true, true>(ws + WS_X1H, P.in[17], mod, 3 * 2048, 4 * 2048, (h16*)(ws + WS_H), G, bid); PHASE_END(8)
    PHASE_BEGIN(9) { pg8::Gemm g{(const h16*)(ws + WS_H), (const h16*)(ws + WS_W1), NT, DFF, DM}; pg8::StaticOrder S; S.init(NT, DFF, G, bid);
                  pg8::EpiF16<1, true> E{(h16*)(ws + WS_HID), DFF}; pg8::gemm_phase<true>(lds, g, S, E); } PHASE_END(9)
    PHASE_BEGIN(10) { pg8::Gemm g{(const h16*)(ws + WS_HID), (const h16*)(ws + WS_W2), NT, DM, DFF}; pg8::StaticOrder S; S.init(NT, DM, G, bid);
                   pg8::EpiRes<false> E{ws + WS_X1H, (h16*)(ws + WS_X1H), mod + 5 * 2048, 12288}; pg8::gemm_phase<true>(lds, g, S, E); } PHASE_END(10)
    PHASE_BEGIN(11) final_norm_rows((const h16*)(ws + WS_X1H), P.out, P.in[20], G, bid); PHASE_END(11)
}

extern "C" void kernel_launch(void* const* d_in, const int* in_sizes, int n_in, void* d_out, int out_size, void* d_ws, size_t ws_size, hipStream_t stream) {
    static int grid = 0;
    if (grid == 0) {
        if (n_in != 21 || out_size != NT * DM || ws_size < WS_END2) { fprintf(stderr, "kernel_launch: unexpected shapes (n_in %d out %d ws %zu need %zu)\n", n_in, out_size, ws_size, (size_t)WS_END2); grid = -1; return; }
        int dev = 0, cus = 0, per_cu = 0;
        hipGetDevice(&dev); hipDeviceGetAttribute(&cus, hipDeviceAttributeMultiprocessorCount, dev);
        if (hipFuncSetAttribute((const void*)mega, hipFuncAttributeMaxDynamicSharedMemorySize, LDS_BYTES) != hipSuccess) { fprintf(stderr, "kernel_launch: hipFuncSetAttribute failed\n"); grid = -1; return; }
        if (hipOccupancyMaxActiveBlocksPerMultiprocessor(&per_cu, (const void*)mega, NTHR, LDS_BYTES) != hipSuccess || per_cu < 1) { fprintf(stderr, "kernel_launch: occupancy query says %d\n", per_cu); per_cu = 1; }
        (void)hipGetLastError();
        grid = cus * 1;
        fprintf(stderr, "kernel_launch: cus %d per_cu %d grid %d\n", cus, per_cu, grid);
    }
    if (grid < 0) return;
    if (hipMemsetAsync((char*)d_ws + WS_BAR, 0, WS_BAR_BYTES, stream) != hipSuccess) { fprintf(stderr, "kernel_launch: memset failed\n"); return; }
    Args a{};
    for (int i = 0; i < 21; ++i) a.p.in[i] = (const float*)d_in[i];
    a.p.out = (float*)d_out; a.p.ws = (unsigned char*)d_ws;
    a.ph_lo = 0; a.ph_hi = NPHASE;
    void* kargs[] = {&a};
    hipError_t e = hipLaunchCooperativeKernel((const void*)mega, dim3(grid), dim3(NTHR), kargs, LDS_BYTES, stream);
    if (e != hipSuccess) fprintf(stderr, "cooperative launch failed: %s (grid %d)\n", hipGetErrorString(e), grid);
}
```

```cpp
#include <hip/hip_runtime.h>
#include <hip/hip_cooperative_groups.h>
#include <cstdint>
#include <cstdio>
namespace cg = cooperative_groups;


#define LAS __attribute__((address_space(3)))
typedef _Float16 h16;
typedef _Float16 half8 __attribute__((ext_vector_type(8)));
typedef _Float16 half4 __attribute__((ext_vector_type(4)));
typedef _Float16 half2v __attribute__((ext_vector_type(2)));
typedef float f32x4 __attribute__((ext_vector_type(4)));
typedef float f32x2 __attribute__((ext_vector_type(2)));
typedef unsigned u32x4 __attribute__((ext_vector_type(4)));
typedef unsigned u32x2 __attribute__((ext_vector_type(2)));

constexpr int NB = 4, SEQ = 8192, NT = NB * SEQ, DM = 2048, DIN = 5656, DINP = 5888, DFF = 8192;
constexpr int OFF_UB = 0, OFF_UC = 1024, OFF_UH = 2048, OFF_Q = 3072, OFF_KC = 4096, OFF_VC = 4352, OFF_KS = 4608, OFF_VS = 4864,
              OFF_KW = 5120, OFF_VW = 5376, OFF_GL = 5632;
constexpr float EPS = 1e-6f;
constexpr int NTHR = 512;
constexpr int LDS_BYTES = 136 * 1024;

constexpr size_t WS_BAR   = 0;
constexpr size_t WS_BAR_BYTES = 16384;
constexpr size_t WS_MOD   = 16384;
constexpr size_t WS_B1P   = WS_MOD + (size_t)4 * 12288 * 4;
constexpr size_t WS_WIN   = WS_B1P + (size_t)2 * 32 * 256 * 4;
constexpr size_t WS_WOUT  = WS_WIN + (size_t)DINP * DM * 2;
constexpr size_t WS_W1    = WS_WOUT + (size_t)DM * DM * 2;
constexpr size_t WS_W2    = WS_W1 + (size_t)DFF * DM * 2;
constexpr size_t WS_CW1K  = WS_W2 + (size_t)DFF * DM * 2;
constexpr size_t WS_CW1V  = WS_CW1K + (size_t)256 * 4096 * 2;
constexpr size_t WS_CW2K  = WS_CW1V + (size_t)256 * 4096 * 2;
constexpr size_t WS_CW2V  = WS_CW2K + (size_t)128 * 256 * 2;
constexpr size_t WS_KCMP  = WS_CW2V + (size_t)128 * 256 * 2;
constexpr size_t WS_VCMP  = WS_KCMP + (size_t)8 * 512 * 128 * 2;
constexpr size_t WS_H     = WS_VCMP + (size_t)8 * 512 * 128 * 2;
constexpr size_t WS_BIG   = WS_H + (size_t)NT * DM * 2;
constexpr size_t WS_U     = WS_BIG;
constexpr size_t WS_YACC  = WS_U + (size_t)NT * DINP * 2;
constexpr size_t WS_HID   = WS_BIG;
constexpr size_t WS_END   = WS_BIG + (size_t)NT * DFF * 2;
static_assert(WS_YACC + (size_t)NT * 1024 * 4 <= WS_END, "ws map");
constexpr size_t WS_X1H   = WS_END;
constexpr size_t WS_END2  = WS_X1H + (size_t)NT * DM * 2;
static_assert(WS_END2 <= (size_t)1073741824, "ws map fits 4x largest tensor");
static_assert(WS_WIN % 256 == 0 && WS_H % 256 == 0 && WS_BIG % 256 == 0 && WS_YACC % 256 == 0, "alignment");

namespace pg8 {
constexpr int BM = 256, BK = 64, HALF = 128, HTB = HALF * BK * 2, STAGE_BYTES = 8 * HTB, NXCD = 8, WGM = 8;
__host__ __device__ __forceinline__ int lds_byte(int r, int c) { const int st = (r >> 4) * 2 + (c >> 5), rr = r & 15, cc = c & 31, ob = rr * 64 + cc * 2; return st * 1024 + (ob ^ (((ob >> 9) & 1) << 5)); }
__host__ __device__ __forceinline__ void stage_rc(int b, int& R, int& C) { const int st = b / 1024, sb = b % 1024, swz = sb ^ (((sb >> 9) & 1) << 5); R = (st >> 1) * 16 + swz / 64; C = (st & 1) * 32 + (swz % 64) / 2; }
__host__ __device__ __forceinline__ int perm32(int rho) { const int n = rho >> 4, i = rho & 15; return 8 * (i >> 2) + 4 * n + (i & 3); }

struct Unit { int pm, pn; };
struct Gemm { const h16* A; const h16* Bt; int M, N, K; };

struct StaticOrder {
    int nM, nN, nwg, G, c;
    __host__ __device__ void init(int M, int N, int G_, int c_) { nM = M / BM; nN = N / BM; nwg = nM * nN; G = G_; c = c_; }
    __host__ __device__ bool next(int i, Unit& u) const {
        const long L = (long)i * G + c; if (L >= nwg) return false;
        int wgid = (int)L; { const int q = nwg / NXCD, r = nwg % NXCD, xcd = wgid % NXCD, off = wgid / NXCD; wgid = (xcd < r ? xcd * (q + 1) : r * (q + 1) + (xcd - r) * q) + off; }
        const int nig = WGM * nN, gid = wgid / nig, fm = gid * WGM, gsz = (nM - fm) < WGM ? (nM - fm) : WGM;
        u.pm = fm + ((wgid % nig) % gsz); u.pn = (wgid % nig) / gsz; return true;
    }
    __device__ __forceinline__ void a_ready(const Unit&) const {}
    __device__ __forceinline__ void done(const Unit&) const {}
};

__device__ __forceinline__ unsigned pk_h2(float lo, float hi) { half2v v; v.x = (h16)lo; v.y = (h16)hi; return __builtin_bit_cast(unsigned, v); }
__device__ __forceinline__ unsigned pk_bf2(float lo, float hi) { unsigned r; asm("v_cvt_pk_bf16_f32 %0, %1, %2" : "=v"(r) : "v"(lo), "v"(hi)); return r; }
template <bool BF> __device__ __forceinline__ unsigned pk2(float lo, float hi) { return BF ? pk_bf2(lo, hi) : pk_h2(lo, hi); }
typedef short bfx8 __attribute__((ext_vector_type(8)));

template <int ACT, bool BF = false> struct EpiF16 {
    static constexpr bool PERM = true, AFTER_DRAIN = false;
    h16* O; int ldc;
    __device__ __forceinline__ void operator()(const f32x4 (&acc)[2][2][4][2], const Unit& u, int wr, int wc, int fr, int fq) const {
        const int row0 = u.pm * BM + wr * 64 + fr; const int col0 = u.pn * BM + wc * 32 + 8 * fq;
#pragma unroll
        for (int ai = 0; ai < 2; ++ai)
#pragma unroll
            for (int m = 0; m < 4; ++m) { h16* rowp = O + (size_t)(row0 + ai * HALF + m * 16) * ldc + col0;
#pragma unroll
                for (int bj = 0; bj < 2; ++bj) { f32x4 v0 = acc[ai][bj][m][0], v1 = acc[ai][bj][m][1];
                    if (ACT == 1) {
#pragma unroll
                        for (int j = 0; j < 4; ++j) { const float a = fmaxf(v0[j], 0.f), b = fmaxf(v1[j], 0.f); v0[j] = a * a; v1[j] = b * b; } }
                    u32x4 w; w.x = pk2<BF>(v0[0], v0[1]); w.y = pk2<BF>(v0[2], v0[3]); w.z = pk2<BF>(v1[0], v1[1]); w.w = pk2<BF>(v1[2], v1[3]);
                    *(u32x4*)(rowp + bj * HALF) = w; } }
    }
};
template <bool BASE_F32> struct EpiRes {
    static constexpr bool PERM = true, AFTER_DRAIN = false;
    const void* base; h16* out; const float* gate; int gate_ld;
    __device__ __forceinline__ void operator()(const f32x4 (&acc)[2][2][4][2], const Unit& u, int wr, int wc, int fr, int fq) const {
        const int row0 = u.pm * BM + wr * 64 + fr, col0 = u.pn * BM + wc * 32 + 8 * fq; const int b = (u.pm * BM) / SEQ;
        f32x4 gv[2][2];
#pragma unroll
        for (int bj = 0; bj < 2; ++bj)
#pragma unroll
            for (int n = 0; n < 2; ++n) gv[bj][n] = *(const f32x4*)(gate + (size_t)b * gate_ld + col0 + bj * HALF + 4 * n);
#pragma unroll
        for (int ai = 0; ai < 2; ++ai)
#pragma unroll
            for (int m = 0; m < 4; ++m) { const size_t ro = (size_t)(row0 + ai * HALF + m * 16) * DM + col0;
#pragma unroll
                for (int bj = 0; bj < 2; ++bj) { f32x4 b0, b1;
                    if (BASE_F32) { b0 = *(const f32x4*)((const float*)base + ro + bj * HALF); b1 = *(const f32x4*)((const float*)base + ro + bj * HALF + 4); }
                    else { const half8 hb = *(const half8*)((const h16*)base + ro + bj * HALF);
                           b0 = (f32x4){(float)hb[0], (float)hb[1], (float)hb[2], (float)hb[3]}; b1 = (f32x4){(float)hb[4], (float)hb[5], (float)hb[6], (float)hb[7]}; }
                    const f32x4 v0 = b0 + gv[bj][0] * acc[ai][bj][m][0], v1 = b1 + gv[bj][1] * acc[ai][bj][m][1];
                    u32x4 w; w.x = pk_h2(v0[0], v0[1]); w.y = pk_h2(v0[2], v0[3]); w.z = pk_h2(v1[0], v1[1]); w.w = pk_h2(v1[2], v1[3]);
                    *(u32x4*)(out + ro + bj * HALF) = w; } }
    }
};

template <bool BF16, class Epi, class Sched, bool ALIGN_EPI = true, bool SP2 = true>
__device__ __forceinline__ void gemm_phase(LAS unsigned char* lds, const Gemm g, const Sched& S, const Epi& E) {
    const int tid = threadIdx.x, wid = __builtin_amdgcn_readfirstlane(tid >> 6), lane = tid & 63, wr = wid >> 2, wc = wid & 3, fr = lane & 15, fq = lane >> 4;
    const int K = g.K, nt = K / BK;
    unsigned voffA[2], voffB[2];
#pragma unroll
    for (int i = 0; i < 2; ++i) { int R, C; stage_rc(tid * 16 + i * 8192, R, C); const int Rb = Epi::PERM ? ((R & ~31) + perm32(R & 31)) : R;
        voffA[i] = (unsigned)(R * K + C) * 2u; voffB[i] = (unsigned)(Rb * K + C) * 2u; }
    const size_t kstep = (size_t)(BK * 2);
    const size_t hstep = (size_t)HALF * K * 2;
    const size_t tstep = 2 * hstep;
    const unsigned ldsw = (unsigned)wid * 1024u;
    const int aoff = lds_byte(wr * 64 + fr, fq * 8), boff = lds_byte(wc * 32 + fr, fq * 8);
#define PG8_SA(b, h) (((b) * 2 + (h)) * HTB)
#define PG8_SB(b, h) ((4 + (b) * 2 + (h)) * HTB)
#define PG8_STAGE(bufoff, gbase, voff) do { _Pragma("unroll") for (int _i = 0; _i < 2; ++_i) \
        __builtin_amdgcn_global_load_lds((const unsigned*)((const char*)(gbase) + (voff)[_i]), (LAS unsigned*)(lds + (bufoff) + ldsw + _i * 8192), 16, 0, 0); } while (0)
#define PG8_LDA(dst, b, h) do { _Pragma("unroll") for (int m = 0; m < 4; ++m) _Pragma("unroll") for (int k = 0; k < 2; ++k) dst[m][k] = *(const LAS half8*)(lds + PG8_SA(b, h) + aoff + m * 2048 + k * 1024); } while (0)
#define PG8_LDB(dst, b, h) do { _Pragma("unroll") for (int n = 0; n < 2; ++n) _Pragma("unroll") for (int k = 0; k < 2; ++k) dst[n][k] = *(const LAS half8*)(lds + PG8_SB(b, h) + boff + n * 2048 + k * 1024); } while (0)
#define PG8_MMA(ai, bj, At, Bt) do { __builtin_amdgcn_s_setprio(1); _Pragma("unroll") for (int m = 0; m < 4; ++m) _Pragma("unroll") for (int n = 0; n < 2; ++n) _Pragma("unroll") for (int k = 0; k < 2; ++k) \
        acc[ai][bj][m][n] = BF16 ? __builtin_amdgcn_mfma_f32_16x16x32_bf16(__builtin_bit_cast(bfx8, Bt[n][k]), __builtin_bit_cast(bfx8, At[m][k]), acc[ai][bj][m][n], 0, 0, 0) \
                                 : __builtin_amdgcn_mfma_f32_16x16x32_f16(Bt[n][k], At[m][k], acc[ai][bj][m][n], 0, 0, 0); __builtin_amdgcn_s_setprio(0); } while (0)
#define PG8_WAIT_V(n) asm volatile("s_waitcnt vmcnt(" #n ")" ::: "memory")
#define PG8_WAIT_L(n) asm volatile("s_waitcnt lgkmcnt(" #n ")" ::: "memory")
#define PG8_BAR __builtin_amdgcn_s_barrier()
#define PG8_SCHED __builtin_amdgcn_sched_barrier(0)
    Unit cur, nxt; int ui = 0;
    if (!S.next(0, cur)) return;
    f32x4 acc[2][2][4][2];
#pragma unroll
    for (int a = 0; a < 2; ++a)
#pragma unroll
        for (int b = 0; b < 2; ++b)
#pragma unroll
            for (int m = 0; m < 4; ++m)
#pragma unroll
                for (int n = 0; n < 2; ++n) acc[a][b][m][n] = (f32x4){0.f, 0.f, 0.f, 0.f};
    half8 At[4][2], B0[2][2], B1[2][2];
    const char* cA = (const char*)g.A + (size_t)cur.pm * tstep; const char* cB = (const char*)g.Bt + (size_t)cur.pn * tstep;
    S.a_ready(cur);
    if constexpr (SP2) {
        PG8_STAGE(PG8_SB(0, 0), cB, voffB); PG8_STAGE(PG8_SB(0, 1), cB + hstep, voffB); PG8_STAGE(PG8_SA(0, 0), cA, voffA); PG8_STAGE(PG8_SA(0, 1), cA + hstep, voffA);
        if (wr == 1) PG8_BAR;
        PG8_WAIT_V(2); PG8_BAR;
        PG8_STAGE(PG8_SB(1, 0), cB + kstep, voffB); PG8_STAGE(PG8_SA(1, 0), cA + kstep, voffA); PG8_STAGE(PG8_SB(1, 1), cB + hstep + kstep, voffB);
        PG8_WAIT_V(6); PG8_BAR;
    } else {
        PG8_STAGE(PG8_SB(0, 0), cB, voffB); PG8_STAGE(PG8_SA(0, 0), cA, voffA); PG8_STAGE(PG8_SB(0, 1), cB + hstep, voffB); PG8_STAGE(PG8_SA(0, 1), cA + hstep, voffA);
        if (wr == 1) PG8_BAR;
        PG8_WAIT_V(4); PG8_BAR;
        PG8_STAGE(PG8_SB(1, 0), cB + kstep, voffB); PG8_STAGE(PG8_SA(1, 0), cA + kstep, voffA); PG8_STAGE(PG8_SB(1, 1), cB + hstep + kstep, voffB);
        PG8_WAIT_V(6); PG8_BAR;
    }
    for (;;) {
        const bool has_next = S.next(ui + 1, nxt);
        const char* nA = has_next ? (const char*)g.A + (size_t)nxt.pm * tstep : cA; const char* nB = has_next ? (const char*)g.Bt + (size_t)nxt.pn * tstep : cB;
        for (int t = 0; t < nt; t += 2) {
            const bool last = (t == nt - 2);
            const char* a1 = cA + (size_t)(t + 1) * kstep;
            const char* a2 = last ? nA : cA + (size_t)(t + 2) * kstep; const char* b2 = last ? nB : cB + (size_t)(t + 2) * kstep;
            const char* a3 = a2 + kstep; const char* b3 = b2 + kstep;
            if (last && has_next) S.a_ready(nxt);
            if constexpr (SP2) {
            PG8_LDB(B0, 0, 0); PG8_LDB(B1, 0, 1); PG8_SCHED; PG8_LDA(At, 0, 0); PG8_STAGE(PG8_SA(1, 1), a1 + hstep, voffA);
            PG8_WAIT_V(8); PG8_WAIT_L(0); PG8_BAR; PG8_MMA(0, 0, At, B0); PG8_MMA(0, 1, At, B1); PG8_BAR; PG8_SCHED;
            PG8_LDA(At, 0, 1); PG8_STAGE(PG8_SB(0, 0), b2, voffB); PG8_STAGE(PG8_SB(0, 1), b2 + hstep, voffB); PG8_STAGE(PG8_SA(0, 0), a2, voffA);
            PG8_WAIT_V(8); PG8_WAIT_L(0); PG8_BAR; PG8_MMA(1, 0, At, B0); PG8_MMA(1, 1, At, B1); PG8_BAR; PG8_SCHED;
            PG8_LDB(B0, 1, 0); PG8_LDB(B1, 1, 1); PG8_SCHED; PG8_LDA(At, 1, 0); PG8_STAGE(PG8_SA(0, 1), a2 + hstep, voffA);
            PG8_WAIT_V(8); PG8_WAIT_L(0); PG8_BAR; PG8_MMA(0, 0, At, B0); PG8_MMA(0, 1, At, B1); PG8_BAR; PG8_SCHED;
            PG8_LDA(At, 1, 1); PG8_STAGE(PG8_SB(1, 0), b3, voffB); PG8_STAGE(PG8_SB(1, 1), b3 + hstep, voffB); PG8_STAGE(PG8_SA(1, 0), a3, voffA);
            PG8_WAIT_V(8); PG8_WAIT_L(0); PG8_BAR; PG8_MMA(1, 0, At, B0); PG8_MMA(1, 1, At, B1); PG8_BAR; PG8_SCHED;
            } else {
            PG8_LDB(B0, 0, 0); PG8_SCHED; PG8_LDA(At, 0, 0); PG8_STAGE(PG8_SA(1, 1), a1 + hstep, voffA);
            PG8_WAIT_L(8); PG8_BAR; PG8_WAIT_L(0); PG8_MMA(0, 0, At, B0); PG8_BAR; PG8_SCHED;
            PG8_LDB(B1, 0, 1); PG8_STAGE(PG8_SB(0, 0), b2, voffB);
            PG8_BAR; PG8_WAIT_L(0); PG8_MMA(0, 1, At, B1); PG8_BAR;
            PG8_LDA(At, 0, 1); PG8_STAGE(PG8_SA(0, 0), a2, voffA);
            PG8_BAR; PG8_WAIT_L(0); PG8_MMA(1, 0, At, B0); PG8_BAR; PG8_SCHED;
            PG8_STAGE(PG8_SB(0, 1), b2 + hstep, voffB);
            PG8_WAIT_V(6); PG8_BAR; PG8_MMA(1, 1, At, B1); PG8_BAR;
            PG8_LDB(B0, 1, 0); PG8_SCHED; PG8_LDA(At, 1, 0); PG8_STAGE(PG8_SA(0, 1), a2 + hstep, voffA);
            PG8_WAIT_L(8); PG8_BAR; PG8_WAIT_L(0); PG8_MMA(0, 0, At, B0); PG8_BAR; PG8_SCHED;
            PG8_LDB(B1, 1, 1); PG8_STAGE(PG8_SB(1, 0), b3, voffB);
            PG8_BAR; PG8_WAIT_L(0); PG8_MMA(0, 1, At, B1); PG8_BAR;
            PG8_LDA(At, 1, 1); PG8_STAGE(PG8_SA(1, 0), a3, voffA);
            PG8_BAR; PG8_WAIT_L(0); PG8_MMA(1, 0, At, B0); PG8_BAR; PG8_SCHED;
            PG8_STAGE(PG8_SB(1, 1), b3 + hstep, voffB);
            PG8_WAIT_V(6); PG8_BAR; PG8_MMA(1, 1, At, B1); PG8_BAR;
            }
        }
        if constexpr (ALIGN_EPI) { if (wr == 0) PG8_BAR; }
        E(acc, cur, wr, wc, fr, fq); S.done(cur);
        if (!has_next) break;
#pragma unroll
        for (int a = 0; a < 2; ++a)
#pragma unroll
            for (int b = 0; b < 2; ++b)
#pragma unroll
                for (int m = 0; m < 4; ++m)
#pragma unroll
                    for (int n = 0; n < 2; ++n) acc[a][b][m][n] = (f32x4){0.f, 0.f, 0.f, 0.f};
        cur = nxt; cA = nA; cB = nB; ++ui;
        if constexpr (ALIGN_EPI) { if (wr == 1) PG8_BAR; }
    }
    PG8_WAIT_V(0);
    if constexpr (!ALIGN_EPI) { if (wr == 0) PG8_BAR; }
    PG8_BAR;
#undef PG8_SA
#undef PG8_SB
#undef PG8_STAGE
#undef PG8_LDA
#undef PG8_LDB
#undef PG8_MMA
#undef PG8_WAIT_V
#undef PG8_WAIT_L
#undef PG8_BAR
#undef PG8_SCHED
}
}

__device__ __forceinline__ float wave_sum(float v) {
#pragma unroll
    for (int o = 1; o < 64; o <<= 1) v += __shfl_xor(v, o);
    return v;
}
__device__ __forceinline__ float wave_max(float v) {
#pragma unroll
    for (int o = 1; o < 64; o <<= 1) v = fmaxf(v, __shfl_xor(v, o));
    return v;
}
__device__ __forceinline__ float bcast_lane(float v, int j) { return __builtin_bit_cast(float, __builtin_amdgcn_readlane(__builtin_bit_cast(int, v), j)); }

struct Ptrs {
    const float* in[21]; float* out; unsigned char* ws;
};

constexpr int P0_ADA = 192, P0_B1 = 64;
constexpr int P0_TWIN = 32 * 23, P0_TWOUT = 32 * 8, P0_TW1 = 32 * 32, P0_TW2 = 128 * 8, P0_TC1 = 64 * 1, P0_TC2 = 4 * 1;
constexpr int P0_OFF_B1 = P0_ADA, P0_OFF_TWIN = P0_OFF_B1 + P0_B1, P0_OFF_TWOUT = P0_OFF_TWIN + P0_TWIN, P0_OFF_TW1 = P0_OFF_TWOUT + P0_TWOUT,
              P0_OFF_TW2 = P0_OFF_TW1 + P0_TW1, P0_OFF_TC1K = P0_OFF_TW2 + P0_TW2, P0_OFF_TC1V = P0_OFF_TC1K + P0_TC1, P0_OFF_TC2K = P0_OFF_TC1V + P0_TC1,
              P0_OFF_TC2V = P0_OFF_TC2K + P0_TC2, P0_ITEMS = P0_OFF_TC2V + P0_TC2;

__device__ __forceinline__ void transpose_tile(const float* __restrict__ W, int K, int N, int Nout, h16* __restrict__ Wt, int item, LAS float* scr, int tid, bool bf = false) {
    const int nkt = K / 64; const int kt = item % nkt, ntl = item / nkt;
    { const int c4 = tid & 63, r = tid >> 6; f32x4 v[8];
#pragma unroll
      for (int i = 0; i < 8; ++i) { const int k = kt * 64 + r + 8 * i, n = ntl * 256 + 4 * c4;
          v[i] = (f32x4){0.f, 0.f, 0.f, 0.f}; if (n < N) v[i] = *(const f32x4*)(W + (size_t)k * N + n); }
#pragma unroll
      for (int i = 0; i < 8; ++i) *(LAS f32x4*)(scr + (r + 8 * i) * 260 + 4 * c4) = v[i]; }
    __syncthreads();
    { const int n = tid >> 1, hf = tid & 1;
      if (ntl * 256 + n < Nout) {
#pragma unroll
          for (int q = 0; q < 4; ++q) { float f[8];
#pragma unroll
              for (int j = 0; j < 8; ++j) f[j] = scr[(32 * hf + 8 * q + j) * 260 + n];
              u32x4 o;
              if (bf) { o.x = pg8::pk_bf2(f[0], f[1]); o.y = pg8::pk_bf2(f[2], f[3]); o.z = pg8::pk_bf2(f[4], f[5]); o.w = pg8::pk_bf2(f[6], f[7]); }
              else    { o.x = pg8::pk_h2(f[0], f[1]);  o.y = pg8::pk_h2(f[2], f[3]);  o.z = pg8::pk_h2(f[4], f[5]);  o.w = pg8::pk_h2(f[6], f[7]); }
              *(u32x4*)(Wt + (size_t)(ntl * 256 + n) * K + kt * 64 + 32 * hf + 8 * q) = o; } } }
    __syncthreads();
}

__device__ __forceinline__ void p0_prologue(const Ptrs& P, LAS unsigned char* lds, int G, int bid) {
    const int tid = threadIdx.x;
    LAS float* scr = (LAS float*)lds;
    unsigned char* ws = P.ws;
    for (int it = bid; it < P0_ITEMS; it += G) {
        if (it < P0_ADA) {
            LAS float* sc = scr;
            LAS float* red = scr + 8192;
            const float* c = P.in[1];
            for (int i = tid; i < 8192; i += NTHR) { const float v = c[i]; sc[i] = v / (1.f + __expf(-v)); }
            __syncthreads();
            const int cl = tid & 15, kg = tid >> 4;
            f32x4 a0 = {0, 0, 0, 0}, a1 = a0, a2 = a0, a3 = a0;
            const float* W = P.in[2] + 64 * it + 4 * cl;
#pragma unroll 8
            for (int k = kg; k < 2048; k += 32) { const f32x4 w = *(const f32x4*)(W + (size_t)k * 12288);
                a0 += sc[k] * w; a1 += sc[2048 + k] * w; a2 += sc[4096 + k] * w; a3 += sc[6144 + k] * w; }
#pragma unroll
            for (int j = 0; j < 4; ++j) { red[(kg * 4 + 0) * 64 + 4 * cl + j] = a0[j]; red[(kg * 4 + 1) * 64 + 4 * cl + j] = a1[j];
                red[(kg * 4 + 2) * 64 + 4 * cl + j] = a2[j]; red[(kg * 4 + 3) * 64 + 4 * cl + j] = a3[j]; }
            __syncthreads();
            if (tid < 256) { const int b = tid >> 6, col = tid & 63; float s = 0.f;
                for (int q = 0; q < 32; ++q) s += red[(q * 4 + b) * 64 + col];
                ((float*)(ws + WS_MOD))[b * 12288 + 64 * it + col] = s + P.in[3][64 * it + col]; }
            __syncthreads();
        } else if (it < P0_OFF_TWIN) {
            const int q = it - P0_OFF_B1, kv = q >> 5, part = q & 31;
            const float* pe = P.in[8 + kv]; const float* W1 = P.in[kv ? 12 : 10];
            const int col = tid & 255, kh = tid >> 8; float s = 0.f;
            for (int k = 128 * part + 64 * kh; k < 128 * part + 64 * kh + 64; ++k) s += pe[k] * W1[(size_t)k * 256 + col];
            scr[tid] = s; __syncthreads();
            if (tid < 256) ((float*)(ws + WS_B1P))[(kv * 32 + part) * 256 + tid] = scr[tid] + scr[tid + 256];
            __syncthreads();
        } else if (it < P0_OFF_TWOUT) transpose_tile(P.in[5], DM, DIN, DINP, (h16*)(ws + WS_WIN), it - P0_OFF_TWIN, scr, tid);
        else if (it < P0_OFF_TW1)     transpose_tile(P.in[16], DM, DM, DM, (h16*)(ws + WS_WOUT), it - P0_OFF_TWOUT, scr, tid, true);
        else if (it < P0_OFF_TW2)     transpose_tile(P.in[18], DM, DFF, DFF, (h16*)(ws + WS_W1), it - P0_OFF_TW1, scr, tid, true);
        else if (it < P0_OFF_TC1K)    transpose_tile(P.in[19], DFF, DM, DM, (h16*)(ws + WS_W2), it - P0_OFF_TW2, scr, tid, true);
        else if (it < P0_OFF_TC1V)    transpose_tile(P.in[10], 4096, 256, 256, (h16*)(ws + WS_CW1K), it - P0_OFF_TC1K, scr, tid);
        else if (it < P0_OFF_TC2K)    transpose_tile(P.in[12], 4096, 256, 256, (h16*)(ws + WS_CW1V), it - P0_OFF_TC1V, scr, tid);
        else if (it < P0_OFF_TC2V)    transpose_tile(P.in[11], 256, 128, 128, (h16*)(ws + WS_CW2K), it - P0_OFF_TC2K, scr, tid);
        else                          transpose_tile(P.in[13], 256, 128, 128, (h16*)(ws + WS_CW2V), it - P0_OFF_TC2V, scr, tid);
    }
}

template <bool BF, bool IN_F16> __device__ __forceinline__ void norm_mod_rows(const void* __restrict__ Xv, const float* __restrict__ gw, const float* __restrict__ mod, int sh_off, int sc_off,
                                              h16* __restrict__ H, int G, int bid) {
    const int lane = threadIdx.x & 63, wave = threadIdx.x >> 6;
    for (int r = bid * 8 + wave; r < NT; r += G * 8) {
        const int b = r >> 13; f32x4 v[8]; float ss = 0.f;
        if (IN_F16) { const h16* xr = (const h16*)Xv + (size_t)r * DM;
#pragma unroll
            for (int i = 0; i < 8; ++i) { const half4 hv = *(const half4*)(xr + 4 * (lane + 64 * i)); v[i] = (f32x4){(float)hv[0], (float)hv[1], (float)hv[2], (float)hv[3]}; } }
        else { const float* xr = (const float*)Xv + (size_t)r * DM;
#pragma unroll
            for (int i = 0; i < 8; ++i) v[i] = *(const f32x4*)(xr + 4 * (lane + 64 * i)); }
#pragma unroll
        for (int i = 0; i < 8; ++i) ss += v[i][0] * v[i][0] + v[i][1] * v[i][1] + v[i][2] * v[i][2] + v[i][3] * v[i][3];
        ss = wave_sum(ss); const float rstd = rsqrtf(ss * (1.f / DM) + EPS);
        const float* mb = mod + (size_t)b * 12288;
#pragma unroll
        for (int i = 0; i < 8; ++i) { const int c = 4 * (lane + 64 * i);
            const f32x4 g = *(const f32x4*)(gw + c), sh = *(const f32x4*)(mb + sh_off + c), sc = *(const f32x4*)(mb + sc_off + c);
            const f32x4 o = (v[i] * rstd) * g * (1.f + sc) + sh;
            u32x2 w; w.x = pg8::pk2<BF>(o[0], o[1]); w.y = pg8::pk2<BF>(o[2], o[3]);
            *(u32x2*)(H + (size_t)r * DM + c) = w; }
    }
}
__device__ __forceinline__ void final_norm_rows(const h16* __restrict__ X, float* __restrict__ O, const float* __restrict__ gw, int G, int bid) {
    const int lane = threadIdx.x & 63, wave = threadIdx.x >> 6;
    for (int r = bid * 8 + wave; r < NT; r += G * 8) {
        const h16* xr = X + (size_t)r * DM; f32x4 v[8]; float ss = 0.f;
#pragma unroll
        for (int i = 0; i < 8; ++i) { const half4 hv = *(const half4*)(xr + 4 * (lane + 64 * i)); v[i] = (f32x4){(float)hv[0], (float)hv[1], (float)hv[2], (float)hv[3]};
            ss += v[i][0] * v[i][0] + v[i][1] * v[i][1] + v[i][2] * v[i][2] + v[i][3] * v[i][3]; }
        ss = wave_sum(ss); const float rstd = rsqrtf(ss * (1.f / DM) + EPS);
#pragma unroll
        for (int i = 0; i < 8; ++i) { const int c = 4 * (lane + 64 * i); const f32x4 g = *(const f32x4*)(gw + c); *(f32x4*)(O + (size_t)r * DM + c) = (v[i] * rstd) * g; }
    }
}

__device__ __forceinline__ void post_u_rows(const Ptrs& P, int G, int bid) {
    const int lane = threadIdx.x & 63, wave = threadIdx.x >> 6;
    h16* U = (h16*)(P.ws + WS_U); h16* MIX = (h16*)(P.ws + WS_H);
    const float* cw = P.in[6]; const float* cb = P.in[7]; const float* gcv = P.in[14];
    const int hsel = lane >> 3, c8 = lane & 7;
    float inv[8];
#pragma unroll
    for (int e = 0; e < 8; ++e) inv[e] = (float)exp2(-(double)(8 * c8 + e) * (13.287712379549449 / 64.0));
    float wcb[16], wc0[16], wc1[16], wc2[16], wg[16];
#pragma unroll
    for (int hf = 0; hf < 2; ++hf)
#pragma unroll
        for (int j = 0; j < 8; ++j) { const int ch = 512 * hf + 8 * lane + j; wcb[8 * hf + j] = cb[ch]; wc0[8 * hf + j] = cw[ch]; wc1[8 * hf + j] = cw[1024 + ch]; wc2[8 * hf + j] = cw[2048 + ch]; wg[8 * hf + j] = gcv[ch]; }
    for (int r = bid * 8 + wave; r < NT; r += G * 8) {
        const int pos = r & (SEQ - 1); h16* u = U + (size_t)r * DINP;
        float cs[8], sn[8];
#pragma unroll
        for (int e = 0; e < 8; ++e) { const float ang = (float)pos * inv[e];
            double rev = (double)ang * 0.15915494309189535; rev -= __builtin_rint(rev);
            const float rf = (float)rev; cs[e] = __builtin_amdgcn_cosf(rf); sn[e] = __builtin_amdgcn_sinf(rf); }
#pragma unroll
        for (int rd = 0; rd < 2; ++rd) {
            const int base = rd == 0 ? OFF_Q + 128 * hsel : (hsel < 2 ? OFF_KC + 128 * hsel : (hsel < 4 ? OFF_KS + 128 * (hsel - 2) : OFF_KW + 128 * (hsel - 4)));
            if (rd == 0 || hsel < 6) {
                const half8 x1 = *(const half8*)(u + base + 8 * c8), x2 = *(const half8*)(u + base + 64 + 8 * c8); half8 o1, o2;
#pragma unroll
                for (int e = 0; e < 8; ++e) { const float a = (float)x1[e], bq = (float)x2[e]; o1[e] = (h16)(a * cs[e] - bq * sn[e]); o2[e] = (h16)(bq * cs[e] + a * sn[e]); }
                *(half8*)(u + base + 8 * c8) = o1; *(half8*)(u + base + 64 + 8 * c8) = o2; }
        }
        float y[16]; float ss = 0.f;
#pragma unroll
        for (int hf = 0; hf < 2; ++hf) {
            const int ch = 512 * hf + 8 * lane;
            const half8 ub = *(const half8*)(u + OFF_UB + ch), c0 = *(const half8*)(u + OFF_UC + ch), h0 = *(const half8*)(u + OFF_UH + ch);
            half8 c1 = c0 * (h16)0, h1 = c1, c2 = c1, h2 = c1;
            if (pos >= 1) { c1 = *(const half8*)(u - DINP + OFF_UC + ch); h1 = *(const half8*)(u - DINP + OFF_UH + ch); }
            if (pos >= 2) { c2 = *(const half8*)(u - 2 * DINP + OFF_UC + ch); h2 = *(const half8*)(u - 2 * DINP + OFF_UH + ch); }
#pragma unroll
            for (int j = 0; j < 8; ++j) {
                const float v0 = (float)c0[j] * (float)h0[j], v1 = (float)c1[j] * (float)h1[j], v2 = (float)c2[j] * (float)h2[j];
                const float z = wcb[8 * hf + j] + wc0[8 * hf + j] * v2 + wc1[8 * hf + j] * v1 + wc2[8 * hf + j] * v0;
                const float yy = (float)ub[j] * z; y[8 * hf + j] = yy; ss += yy * yy; }
        }
        ss = wave_sum(ss); const float rstd = rsqrtf(ss * (1.f / 1024.f) + EPS);
#pragma unroll
        for (int hf = 0; hf < 2; ++hf) { const int ch = 512 * hf + 8 * lane; float f[8];
#pragma unroll
            for (int j = 0; j < 8; ++j) f[j] = y[8 * hf + j] * rstd * wg[8 * hf + j];
            u32x4 o; o.x = pg8::pk_bf2(f[0], f[1]); o.y = pg8::pk_bf2(f[2], f[3]); o.z = pg8::pk_bf2(f[4], f[5]); o.w = pg8::pk_bf2(f[6], f[7]);
            *(u32x4*)(MIX + (size_t)r * DM + ch) = o; }
    }
}

__device__ __forceinline__ float gelu_tanh(float x) {
    const float z = 0.7978845608028654f * (x + 0.044715f * x * x * x);
    const float e = __expf(2.f * z);
    const float th = 1.f - 2.f / (e + 1.f);
    return 0.5f * x * (1.f + th);
}
__device__ __forceinline__ void compress_phase(const Ptrs& P, LAS unsigned char* lds, int G, int bid) {
    const int tid = threadIdx.x, lane = tid & 63, w = tid >> 6, fr = lane & 15, fq = lane >> 4;
    const h16* U = (const h16*)(P.ws + WS_U);
    LAS h16* hid = (LAS h16*)lds;
    for (int unit = bid; unit < 256; unit += G) {
        const int kv = unit >> 7, bg = (unit >> 4) & 7, nb = unit & 15, b = bg >> 1, g = bg & 1, n0 = nb * 32;
        const h16* W1t = (const h16*)(P.ws + (kv ? WS_CW1V : WS_CW1K));
        const h16* W2t = (const h16*)(P.ws + (kv ? WS_CW2V : WS_CW2K));
        const float* b1p = (const float*)(P.ws + WS_B1P) + kv * 32 * 256;
        h16* OUT = (h16*)(P.ws + (kv ? WS_VCMP : WS_KCMP)) + (size_t)bg * 512 * 128;
        const int coff = (kv ? OFF_VC : OFF_KC) + g * 128;
        f32x4 acc[2][2];
#pragma unroll
        for (int i = 0; i < 2; ++i)
#pragma unroll
            for (int j = 0; j < 2; ++j) acc[i][j] = (f32x4){0.f, 0.f, 0.f, 0.f};
        {   const h16* abase = U + (size_t)b * SEQ * DINP + coff;
            u32x4 st[17];
#pragma unroll
            for (int i = 0; i < 17; ++i) { const int c = tid + 512 * i; const int row = c >> 4, ch = c & 15; int tok = 512 * nb + row; tok = tok < SEQ ? tok : SEQ - 1;
                if (c < 528 * 16) st[i] = *(const u32x4*)(abase + (size_t)tok * DINP + 8 * ch); }
#pragma unroll
            for (int i = 0; i < 17; ++i) { const int c = tid + 512 * i; const int row = c >> 4, ch = c & 15;
                if (c < 528 * 16) *(LAS u32x4*)(lds + row * 256 + ((ch ^ ((row >> 4) & 15)) << 4)) = st[i]; }
        }
        half8 fb[3][4][2];
        const h16* brow[2];
#pragma unroll
        for (int nt = 0; nt < 2; ++nt) brow[nt] = W1t + (size_t)(32 * w + 16 * nt + fr) * 4096 + 8 * fq;
#define CP_LOADB(buf_, pos_) do { _Pragma("unroll") for (int ks = 0; ks < 4; ++ks) _Pragma("unroll") for (int nt = 0; nt < 2; ++nt) fb[buf_][ks][nt] = *(const half8*)(brow[nt] + (pos_) * 128 + 32 * ks); } while (0)
#define CP_MMA(bb_, pos_) do { half8 fa[4][2]; _Pragma("unroll") for (int mt = 0; mt < 2; ++mt) { const int rl = 16 * (16 * mt + fr) + (pos_); const int sw = (fr + ((pos_) >> 4)) & 15; \
            _Pragma("unroll") for (int ks = 0; ks < 4; ++ks) fa[ks][mt] = *(const LAS half8*)(lds + rl * 256 + (((4 * ks + fq) ^ sw) << 4)); } \
            _Pragma("unroll") for (int ks = 0; ks < 4; ++ks) _Pragma("unroll") for (int mt = 0; mt < 2; ++mt) _Pragma("unroll") for (int nt = 0; nt < 2; ++nt) \
            acc[mt][nt] = __builtin_amdgcn_mfma_f32_16x16x32_f16(fa[ks][mt], fb[bb_][ks][nt], acc[mt][nt], 0, 0, 0); } while (0)
        CP_LOADB(0, 0); CP_LOADB(1, 1);
        __syncthreads();
#pragma unroll 1
        for (int pos = 0; pos < 33; pos += 3) {
            if (pos + 2 < 32) CP_LOADB(2, pos + 2);
            CP_MMA(0, pos);
            if (pos + 3 < 32) CP_LOADB(0, pos + 3);
            if (pos + 1 < 32) CP_MMA(1, pos + 1);
            if (pos + 4 < 32) CP_LOADB(1, pos + 4);
            if (pos + 2 < 32) CP_MMA(2, pos + 2);
        }
#undef CP_LOADB
#undef CP_MMA
        __syncthreads();
#pragma unroll
        for (int nt = 0; nt < 2; ++nt) { const int col = 32 * w + 16 * nt + fr; float bias = 0.f;
            { float bp[8];
#pragma unroll
              for (int q = 0; q < 8; ++q) bp[q] = b1p[(8 * fq + q) * 256 + col];
              bias = ((bp[0] + bp[1]) + (bp[2] + bp[3])) + ((bp[4] + bp[5]) + (bp[6] + bp[7]));
              bias += __shfl_xor(bias, 16); bias += __shfl_xor(bias, 32); }
#pragma unroll
            for (int mt = 0; mt < 2; ++mt)
#pragma unroll
                for (int j = 0; j < 4; ++j) hid[(16 * mt + 4 * fq + j) * 264 + col] = (h16)gelu_tanh(acc[mt][nt][j] + bias); }
        __syncthreads();
        f32x4 acc2[2]; acc2[0] = (f32x4){0.f, 0.f, 0.f, 0.f}; acc2[1] = acc2[0];
#pragma unroll
        for (int ks = 0; ks < 8; ++ks) {
            const half8 bb = *(const half8*)(W2t + (size_t)(16 * w + fr) * 256 + 32 * ks + 8 * fq);
#pragma unroll
            for (int mt = 0; mt < 2; ++mt) { const half8 a = *(const LAS half8*)(hid + (16 * mt + fr) * 264 + 32 * ks + 8 * fq);
                acc2[mt] = __builtin_amdgcn_mfma_f32_16x16x32_f16(a, bb, acc2[mt], 0, 0, 0); }
        }
#pragma unroll
        for (int mt = 0; mt < 2; ++mt)
#pragma unroll
            for (int j = 0; j < 4; ++j) OUT[(size_t)(n0 + 16 * mt + 4 * fq + j) * 128 + 16 * w + fr] = (h16)acc2[mt][j];
        __syncthreads();
    }
}

typedef short s16x4 __attribute__((ext_vector_type(4)));
typedef short s16x8 __attribute__((ext_vector_type(8)));
template <bool a0, bool a1> __device__ __forceinline__ void af_qk(const LAS unsigned char* kbuf, const unsigned (&kl)[4], const half8 (&qf)[2][4], f32x4 (&s)[2][4]) {
    const LAS unsigned char* ka[4];
    { int _ln; asm volatile("v_mov_b32 %0, %1" : "=v"(_ln) : "v"(kl[0]));
      const int fr_ = _ln & 15, e_ = (_ln >> 4) ^ fr_;
#pragma unroll
      for (int ks = 0; ks < 4; ++ks) ka[ks] = kbuf + fr_ * 256 + ((e_ ^ (4 * ks)) << 4); }
    half8 kf[2][4];
#pragma unroll
    for (int ks = 0; ks < 4; ++ks) kf[0][ks] = *(const LAS half8*)(ka[ks]);
#pragma unroll
    for (int kt = 0; kt < 4; ++kt) {
        if (kt < 3) {
#pragma unroll
            for (int ks = 0; ks < 4; ++ks) kf[(kt + 1) & 1][ks] = *(const LAS half8*)(ka[ks] + (kt + 1) * 4096); }
        s[0][kt] = (f32x4){0.f, 0.f, 0.f, 0.f}; s[1][kt] = (f32x4){0.f, 0.f, 0.f, 0.f};
#pragma unroll
        for (int ks = 0; ks < 4; ++ks) {
            if (a0) s[0][kt] = __builtin_amdgcn_mfma_f32_16x16x32_f16(kf[kt & 1][ks], qf[0][ks], s[0][kt], 0, 0, 0);
            if (a1) s[1][kt] = __builtin_amdgcn_mfma_f32_16x16x32_f16(kf[kt & 1][ks], qf[1][ks], s[1][kt], 0, 0, 0); }
        __builtin_amdgcn_sched_barrier(0);
    }
}
template <bool a0, bool a1> __device__ __forceinline__ void af_pv(const LAS unsigned char* vbuf, unsigned vl0, int z, const half8 (&pf)[2][2], f32x4 (&o)[2][8]) {
    const unsigned rb = (unsigned)(__UINTPTR_TYPE__)(vbuf + vl0);
    s16x4 vr[2][8];
#define AF_VLOAD(buf_, dt_) asm volatile("ds_read_b64_tr_b16 %0, %8\n\tds_read_b64_tr_b16 %1, %8 offset:4096\n\tds_read_b64_tr_b16 %2, %8 offset:8192\n\tds_read_b64_tr_b16 %3, %8 offset:12288\n\t" \
        "ds_read_b64_tr_b16 %4, %9\n\tds_read_b64_tr_b16 %5, %9 offset:4096\n\tds_read_b64_tr_b16 %6, %9 offset:8192\n\tds_read_b64_tr_b16 %7, %9 offset:12288" \
        : "=&v"(vr[buf_][0]), "=&v"(vr[buf_][1]), "=&v"(vr[buf_][2]), "=&v"(vr[buf_][3]), "=&v"(vr[buf_][4]), "=&v"(vr[buf_][5]), "=&v"(vr[buf_][6]), "=&v"(vr[buf_][7]) \
        : "v"(rb + ((unsigned)((dt_) ^ z) << 5)), "v"(rb + ((unsigned)(((dt_) + 1) ^ z) << 5)) : "memory")
#define AF_VWAIT(buf_, n_) asm volatile("s_waitcnt lgkmcnt(" #n_ ")" : "+v"(vr[buf_][0]), "+v"(vr[buf_][1]), "+v"(vr[buf_][2]), "+v"(vr[buf_][3]), "+v"(vr[buf_][4]), "+v"(vr[buf_][5]), "+v"(vr[buf_][6]), "+v"(vr[buf_][7]) :: "memory")
#define AF_VMMA(buf_, dt0_) do { _Pragma("unroll") for (int dd = 0; dd < 2; ++dd) _Pragma("unroll") for (int kp = 0; kp < 2; ++kp) { \
            const s16x4 lo = vr[buf_][4 * dd + 2 * kp], hi = vr[buf_][4 * dd + 2 * kp + 1]; \
            s16x8 v8; v8[0] = lo[0]; v8[1] = lo[1]; v8[2] = lo[2]; v8[3] = lo[3]; v8[4] = hi[0]; v8[5] = hi[1]; v8[6] = hi[2]; v8[7] = hi[3]; \
            const half8 vf = __builtin_bit_cast(half8, v8); \
            if (a0) o[0][(dt0_) + dd] = __builtin_amdgcn_mfma_f32_16x16x32_f16(vf, pf[0][kp], o[0][(dt0_) + dd], 0, 0, 0); \
            if (a1) o[1][(dt0_) + dd] = __builtin_amdgcn_mfma_f32_16x16x32_f16(vf, pf[1][kp], o[1][(dt0_) + dd], 0, 0, 0); } \
        __builtin_amdgcn_sched_barrier(0); } while (0)
    AF_VLOAD(0, 0); AF_VLOAD(1, 2);
    AF_VWAIT(0, 8); AF_VMMA(0, 0); AF_VLOAD(0, 4);
    AF_VWAIT(1, 8); AF_VMMA(1, 2); AF_VLOAD(1, 6);
    AF_VWAIT(0, 8); AF_VMMA(0, 4);
    AF_VWAIT(1, 0); AF_VMMA(1, 6);
#undef AF_VMMA
#undef AF_VLOAD
#undef AF_VWAIT
}
__device__ __forceinline__ void af_maskraw(f32x4 (&s)[4], int mbase, int mstep, int fq, int hi, int lo) {
#pragma unroll
    for (int kt = 0; kt < 4; ++kt)
#pragma unroll
        for (int jj = 0; jj < 4; ++jj) { const int met = mbase + mstep * (16 * kt + 4 * fq + jj); s[kt][jj] = (met <= hi && met > lo) ? s[kt][jj] : -3.0e38f; }
}
__device__ __forceinline__ float af_colmax(const f32x4 (&s)[4]) {
    float v = -1.0e30f;
#pragma unroll
    for (int kt = 0; kt < 4; ++kt) v = fmaxf(v, fmaxf(fmaxf(s[kt][0], s[kt][1]), fmaxf(s[kt][2], s[kt][3])));
    v = fmaxf(v, __shfl_xor(v, 16)); v = fmaxf(v, __shfl_xor(v, 32)); return v;
}
__device__ __forceinline__ void af_pack(const f32x4 (&s)[4], half8 (&pf)[2]) {
#pragma unroll
    for (int kp = 0; kp < 2; ++kp) { half8 h;
#pragma unroll
        for (int jj = 0; jj < 4; ++jj) { h[jj] = (h16)s[2 * kp][jj]; h[4 + jj] = (h16)s[2 * kp + 1][jj]; }
        pf[kp] = h; }
}
__device__ __forceinline__ float af_rawmax(const f32x4 (&s)[4]) {
    float v = fmaxf(fmaxf(s[0][0], s[0][1]), fmaxf(s[0][2], s[0][3]));
#pragma unroll
    for (int kt = 1; kt < 4; ++kt) v = fmaxf(v, fmaxf(fmaxf(s[kt][0], s[kt][1]), fmaxf(s[kt][2], s[kt][3])));
    v = fmaxf(v, __shfl_xor(v, 16)); v = fmaxf(v, __shfl_xor(v, 32)); return v;
}
__device__ __forceinline__ void af_online_fast(f32x4 (&s)[4], bool colsel, float& m, float& l, f32x4 (&o)[8], half8 (&pf)[2], float SC) {
    float lm = fmaxf(fmaxf(s[0][0], s[0][1]), fmaxf(s[0][2], s[0][3]));
#pragma unroll
    for (int kt = 1; kt < 4; ++kt) lm = fmaxf(lm, fmaxf(fmaxf(s[kt][0], s[kt][1]), fmaxf(s[kt][2], s[kt][3])));
    if (__ballot(colsel && (lm * SC > m + 8.f)) != 0ull) {
        float v = lm; v = fmaxf(v, __shfl_xor(v, 16)); v = fmaxf(v, __shfl_xor(v, 32));
        const float mloc = colsel ? v * SC : -1.0e30f;
        const float mn = fmaxf(m, mloc); const float al = __builtin_amdgcn_exp2f(m - mn); m = mn;
        l *= al;
#pragma unroll
        for (int dt = 0; dt < 8; ++dt) o[dt] *= al;
    }
    const float bias = colsel ? -m : -1.0e30f; float ps = 0.f;
#pragma unroll
    for (int kt = 0; kt < 4; ++kt)
#pragma unroll
        for (int jj = 0; jj < 4; ++jj) { const float p = __builtin_amdgcn_exp2f(__builtin_fmaf(s[kt][jj], SC, bias)); s[kt][jj] = p; ps += p; }
    l += ps;
    af_pack(s, pf);
}
__device__ __forceinline__ float af_write(float* Y, size_t row, int colbase, const f32x4 (&o)[8], float sc, bool accumulate) {
    float ss = 0.f;
#pragma unroll
    for (int dt = 0; dt < 8; ++dt) { float* p = Y + row * 1024 + colbase + 16 * dt; f32x4 v = o[dt] * sc; if (accumulate) v += *(const f32x4*)p; *(f32x4*)p = v;
        ss += (v[0] * v[0] + v[1] * v[1]) + (v[2] * v[2] + v[3] * v[3]); }
    return ss;
}
__device__ __forceinline__ float af_sigmoid(float x) { return 1.f / (1.f + __expf(-x)); }

template <bool A0, bool A1>
__device__ __forceinline__ void af_tile_online(const LAS unsigned char* stage, const unsigned (&kl)[4], unsigned vl0, int vz, const half8 (&qf)[2][4], f32x4 (&s)[2][4],
                                               float (&m)[2], float (&l)[2], f32x4 (&o)[2][8], bool needmask, int mbase, int fq, const int (&hi)[2], const int (&lo)[2], float SC) {
    af_qk<A0, A1>(stage, kl, qf, s);
    half8 pf[2][2];
    if (A0) { if (needmask) af_maskraw(s[0], mbase, 1, fq, hi[0], lo[0]); af_online_fast(s[0], hi[0] >= 0, m[0], l[0], o[0], pf[0], SC); } else { pf[0][0] = qf[0][0]; pf[0][1] = qf[0][0]; }
    if (A1) { if (needmask) af_maskraw(s[1], mbase, 1, fq, hi[1], lo[1]); af_online_fast(s[1], hi[1] >= 0, m[1], l[1], o[1], pf[1], SC); } else { pf[1][0] = qf[1][0]; pf[1][1] = qf[1][0]; }
    af_pv<A0, A1>(stage + 16384, vl0, vz, pf, o);
}
#define AF_ISSUE(st_, kb_, vb_, gs_, r0_, needv_) do { int _ln; asm volatile("v_mov_b32 %0, %1" : "=v"(_ln) : "v"(lane)); \
      _Pragma("unroll") for (int _c = 0; _c < 2; ++_c) { const int _row = 8 * w + 4 * _c + (_ln >> 4); \
      const h16* _kp = (kb_) + (size_t)((r0_) + _row) * (gs_) + (((_ln & 15) ^ (_row & 15)) << 3); \
      __builtin_amdgcn_global_load_lds((const unsigned*)_kp, (LAS unsigned*)(lds + (st_) * 32768 + (2 * w + _c) * 1024), 16, 0, 0); \
      if (needv_) { const h16* _vp = (vb_) + (size_t)((r0_) + _row) * (gs_) + (((_ln & 15) ^ (2 * (_row & 7))) << 3); \
      __builtin_amdgcn_global_load_lds((const unsigned*)_vp, (LAS unsigned*)(lds + (st_) * 32768 + 16384 + (2 * w + _c) * 1024), 16, 0, 0); } } } while (0)
#define AF_WAITV(n) asm volatile("s_waitcnt vmcnt(" #n ")" ::: "memory")
#define AF_BAR() do { __builtin_amdgcn_s_barrier(); asm volatile("" ::: "memory"); } while (0)

__device__ __forceinline__ void attn_fast(const Ptrs& P, LAS unsigned char* lds, int G, int bid) {
    const int tid = threadIdx.x, lane = tid & 63, w = __builtin_amdgcn_readfirstlane(tid >> 6), fr = lane & 15, fq = lane >> 4, qi = fr >> 2, hh = fr & 3;
    LAS float* IMP = (LAS float*)(lds + 98304) + w * (8 * 132);
    LAS unsigned* SELM = (LAS unsigned*)(lds + 132096);
    const h16* U = (const h16*)(P.ws + WS_U); float* Y = (float*)(P.ws + WS_YACC);
    const float SC = 0.08838834764831845f * 1.4426950408889634f;
    const int NEGBIG = -(1 << 30);
    unsigned kl[4]; kl[0] = (unsigned)lane; kl[1] = kl[2] = kl[3] = 0u;
    const int vz = (4 * fq + (fr >> 2)) & 7;
    const unsigned vl0 = (unsigned)((4 * fq + (fr >> 2)) * 256 + 8 * (fr & 1) + 16 * ((fr >> 1) & 1));
    const int nunits = (512 + G - 1) / G;
#pragma unroll 1
    for (int ui = 0; ui < nunits; ++ui) {
        int b, qb;
        if (G == 256) { const int idx = (bid & 1) * 32 + (bid >> 3); b = (bid & 7) >> 1; qb = ui == 0 ? 127 - idx : idx; }
        else { const int u = ui * G + bid; if (u >= 512) break;
               b = u >> 7; qb = (((u & 1) ^ ((u >> 8) & 1)) != 0) ? 127 - ((u >> 1) & 63) : ((u >> 1) & 63); }
#pragma unroll 1
        for (int g = 0; g < 2; ++g) {
            const int bg = 2 * b + g;
            int tq[2]; tq[0] = 64 * qb + 8 * w + qi; tq[1] = tq[0] + 4;
            const h16* Ub = U + (size_t)b * SEQ * DINP;
            half8 qf[2][4];
#pragma unroll
            for (int ct = 0; ct < 2; ++ct)
#pragma unroll
                for (int ks = 0; ks < 4; ++ks) qf[ct][ks] = *(const half8*)(Ub + (size_t)tq[ct] * DINP + OFF_Q + (4 * g + hh) * 128 + 32 * ks + 8 * fq);
            for (int i = lane; i < 8 * 132; i += 64) IMP[i] = 0.f;
            f32x4 s[2][4];
            const h16* KC = (const h16*)(P.ws + WS_KCMP) + (size_t)bg * 512 * 128;
            const h16* VC = (const h16*)(P.ws + WS_VCMP) + (size_t)bg * 512 * 128;
            const int ntc = ((4 * qb + 2) >> 6) + 1;
            float m[2], l[2];
            m[0] = m[1] = -1.0e30f; l[0] = l[1] = 0.f;
            AF_ISSUE(0, KC, VC, 128, 0, false);
            if (ntc > 1) AF_ISSUE(1, KC, VC, 128, 64, false);
#pragma unroll 1
            for (int T = 0; T < ntc; ++T) {
                if (T + 1 < ntc) AF_WAITV(2); else AF_WAITV(0);
                AF_BAR();
                if (T + 2 < ntc) AF_ISSUE((T + 2) % 3, KC, VC, 128, 64 * (T + 2), false);
                af_qk<true, true>(lds + (T % 3) * 32768, kl, qf, s);
#pragma unroll
                for (int ct = 0; ct < 2; ++ct) {
                    if (1024 * T + 1039 > 64 * qb) af_maskraw(s[ct], 1024 * T + 31, 16, fq, tq[ct], NEGBIG);
                    const float mn = fmaxf(m[ct], af_rawmax(s[ct]) * SC); const float al = __builtin_amdgcn_exp2f(m[ct] - mn); m[ct] = mn; float ps = 0.f;
#pragma unroll
                    for (int kt = 0; kt < 4; ++kt)
#pragma unroll
                        for (int jj = 0; jj < 4; ++jj) ps += __builtin_amdgcn_exp2f(__builtin_fmaf(s[ct][kt][jj], SC, -mn));
                    l[ct] = l[ct] * al + ps; }
            }
            float il[2];
#pragma unroll
            for (int ct = 0; ct < 2; ++ct) { float lt = l[ct]; lt += __shfl_xor(lt, 16); lt += __shfl_xor(lt, 32); il[ct] = lt > 0.f ? 1.f / lt : 0.f; }
            f32x4 o[2][8];
#pragma unroll
            for (int ct = 0; ct < 2; ++ct)
#pragma unroll
                for (int dt = 0; dt < 8; ++dt) o[ct][dt] = (f32x4){0.f, 0.f, 0.f, 0.f};
            AF_BAR();
            AF_ISSUE(0, KC, VC, 128, 0, true);
            if (ntc > 1) AF_ISSUE(1, KC, VC, 128, 64, true);
#pragma unroll 1
            for (int T = 0; T < ntc; ++T) {
                if (T + 1 < ntc) AF_WAITV(4); else AF_WAITV(0);
                AF_BAR();
                if (T + 2 < ntc) AF_ISSUE((T + 2) % 3, KC, VC, 128, 64 * (T + 2), true);
                af_qk<true, true>(lds + (T % 3) * 32768, kl, qf, s);
                half8 pf[2][2];
#pragma unroll
                for (int ct = 0; ct < 2; ++ct) {
                    if (1024 * T + 1039 > 64 * qb) af_maskraw(s[ct], 1024 * T + 31, 16, fq, tq[ct], NEGBIG);
#pragma unroll
                    for (int kt = 0; kt < 4; ++kt) {
#pragma unroll
                        for (int jj = 0; jj < 4; ++jj) s[ct][kt][jj] = __builtin_amdgcn_exp2f(__builtin_fmaf(s[ct][kt][jj], SC, -m[ct])) * il[ct];
                        float s4 = (s[ct][kt][0] + s[ct][kt][1]) + (s[ct][kt][2] + s[ct][kt][3]), s3 = s[ct][kt][3];
                        s4 += __shfl_xor(s4, 1); s4 += __shfl_xor(s4, 2); s3 += __shfl_xor(s3, 1); s3 += __shfl_xor(s3, 2);
                        if (hh == 0) { LAS float* ip = IMP + (4 * ct + qi) * 132 + 16 * T + 4 * kt + fq;
                            __hip_atomic_fetch_add(ip, s4, __ATOMIC_RELAXED, __HIP_MEMORY_SCOPE_WORKGROUP);
                            __hip_atomic_fetch_add(ip + 1, s3, __ATOMIC_RELAXED, __HIP_MEMORY_SCOPE_WORKGROUP); }
                    }
                    af_pack(s[ct], pf[ct]); }
                af_pv<true, true>(lds + (T % 3) * 32768 + 16384, vl0, vz, pf, o);
            }
#pragma unroll
            for (int ct = 0; ct < 2; ++ct) { int _ln; asm volatile("v_mov_b32 %0, %1" : "=v"(_ln) : "v"(lane));
                const int fr_ = _ln & 15, fq_ = _ln >> 4, hh_ = fr_ & 3;
                const size_t row = (size_t)b * SEQ + 64 * qb + 8 * w + 4 * ct + (fr_ >> 2);
                const float g0 = af_sigmoid((float)U[row * DINP + OFF_GL + (4 * g + hh_) * 3 + 0]);
                af_write(Y, row, (4 * g + hh_) * 128 + 4 * fq_, o[ct], g0, false); }
            __syncthreads();
#pragma unroll 1
            for (int ql = 0; ql < 8; ql += 2) {
                LAS float* rowa = IMP + ql * 132; LAS float* rowb = rowa + 132;
                float a0, a1, b0, b1;
                { const int j = lane; const bool valid = j <= qb, forced = (j == 0) || (j == qb) || (j == qb - 1); const float bonus = forced ? 1.0e4f : 0.f;
                  const float va = rowa[j], vb = rowb[j]; a0 = valid ? va + bonus : -1.f; b0 = valid ? vb + bonus : -1.f; rowa[j] = a0; rowb[j] = b0; }
                { const int j = lane + 64; const bool valid = j <= qb, forced = (j == 0) || (j == qb) || (j == qb - 1); const float bonus = forced ? 1.0e4f : 0.f;
                  const float va = rowa[j], vb = rowb[j]; a1 = valid ? va + bonus : -1.f; b1 = valid ? vb + bonus : -1.f; rowa[j] = a1; rowb[j] = b1; }
                int ra0 = 0, ra1 = 0, rb0 = 0, rb1 = 0;
                for (int j4 = 0; j4 <= qb; j4 += 4) { const f32x4 xa = *(const LAS f32x4*)(rowa + j4); const f32x4 xb = *(const LAS f32x4*)(rowb + j4);
#pragma unroll
                    for (int e = 0; e < 4; ++e) { const int j = j4 + e;
                        ra0 += (xa[e] > a0 || (xa[e] == a0 && j < lane)) ? 1 : 0; ra1 += (xa[e] > a1 || (xa[e] == a1 && j < lane + 64)) ? 1 : 0;
                        rb0 += (xb[e] > b0 || (xb[e] == b0 && j < lane)) ? 1 : 0; rb1 += (xb[e] > b1 || (xb[e] == b1 && j < lane + 64)) ? 1 : 0; } }
                const unsigned long long alo = __ballot(ra0 < 16 && lane <= qb), ahi = __ballot(ra1 < 16 && lane + 64 <= qb);
                const unsigned long long blo = __ballot(rb0 < 16 && lane <= qb), bhi = __ballot(rb1 < 16 && lane + 64 <= qb);
                if (lane == 0) { LAS unsigned* sp = SELM + (8 * w + ql) * 4; sp[0] = (unsigned)alo; sp[1] = (unsigned)(alo >> 32); sp[2] = (unsigned)ahi; sp[3] = (unsigned)(ahi >> 32);
                                 sp[4] = (unsigned)blo; sp[5] = (unsigned)(blo >> 32); sp[6] = (unsigned)bhi; sp[7] = (unsigned)(bhi >> 32); }
            }
            __syncthreads();
#pragma unroll 1
            for (int br = 1; br < 3; ++br) {
                const h16* KB = Ub + (br == 1 ? OFF_KS : OFF_KW) + g * 128;
                const h16* VB = Ub + (br == 1 ? OFF_VS : OFF_VW) + g * 128;
                const int j_lo = br == 1 ? 0 : (qb >= 8 ? qb - 8 : 0);
                const int nt = qb - j_lo + 1;
                m[0] = m[1] = -1.0e30f; l[0] = l[1] = 0.f;
#pragma unroll
                for (int ct = 0; ct < 2; ++ct)
#pragma unroll
                    for (int dt = 0; dt < 8; ++dt) o[ct][dt] = (f32x4){0.f, 0.f, 0.f, 0.f};
                AF_ISSUE(0, KB, VB, DINP, 64 * j_lo, true);
                if (nt > 1) AF_ISSUE(1, KB, VB, DINP, 64 * (j_lo + 1), true);
                if (nt > 2) AF_ISSUE(2, KB, VB, DINP, 64 * (j_lo + 2), true);
#pragma unroll 1
                for (int i = 0; i < nt; ++i) {
                    const int j = j_lo + i;
                    if (i + 2 < nt) AF_WAITV(8); else if (i + 1 < nt) AF_WAITV(4); else AF_WAITV(0);
                    AF_BAR();
                    if (i + 3 < nt) AF_ISSUE((i + 3) & 3, KB, VB, DINP, 64 * (j + 3), true);
                    int hi[2], lo[2]; bool act[2];
                    const bool needmask = (j == qb) || (br == 2 && 64 * j <= 64 * qb + 63 - 512);
#pragma unroll
                    for (int ct = 0; ct < 2; ++ct) {
                        if (br == 1) { const unsigned wd = SELM[(8 * w + 4 * ct + qi) * 4 + (j >> 5)]; const bool bit = (wd >> (j & 31)) & 1u;
                            act[ct] = __ballot(bit) != 0ull; hi[ct] = bit ? tq[ct] : -1; lo[ct] = NEGBIG; }
                        else { act[ct] = true; hi[ct] = tq[ct]; lo[ct] = tq[ct] - 512; }
                    }
                    const LAS unsigned char* stg = lds + (i & 3) * 32768;
                    if (act[0] && act[1]) af_tile_online<true, true>(stg, kl, vl0, vz, qf, s, m, l, o, needmask, 64 * j, fq, hi, lo, SC);
                    else if (act[0])      af_tile_online<true, false>(stg, kl, vl0, vz, qf, s, m, l, o, needmask, 64 * j, fq, hi, lo, SC);
                    else if (act[1])      af_tile_online<false, true>(stg, kl, vl0, vz, qf, s, m, l, o, needmask, 64 * j, fq, hi, lo, SC);
                }
#pragma unroll
                for (int ct = 0; ct < 2; ++ct) { int _ln; asm volatile("v_mov_b32 %0, %1" : "=v"(_ln) : "v"(lane));
                    const int fr_ = _ln & 15, fq_ = _ln >> 4, hh_ = fr_ & 3;
                    const size_t row = (size_t)b * SEQ + 64 * qb + 8 * w + 4 * ct + (fr_ >> 2);
                    float lt = l[ct]; lt += __shfl_xor(lt, 16); lt += __shfl_xor(lt, 32);
                    const float gg = af_sigmoid((float)U[row * DINP + OFF_GL + (4 * g + hh_) * 3 + br]);
                    (void)af_write(Y, row, (4 * g + hh_) * 128 + 4 * fq_, o[ct], lt > 0.f ? gg / lt : 0.f, true); }
                AF_BAR();
            }
        }
        {
            h16* MIX = (h16*)(P.ws + WS_H); const float* gw = P.in[15];
            int _ln; asm volatile("v_mov_b32 %0, %1" : "=v"(_ln) : "v"(lane));
            const int fr_ = _ln & 15, fq_ = _ln >> 4, hh_ = fr_ & 3;
#pragma unroll 1
            for (int ct = 0; ct < 2; ++ct) {
                const size_t row = (size_t)b * SEQ + 64 * qb + 8 * w + 4 * ct + (fr_ >> 2);
                float sv = 0.f;
#pragma unroll
                for (int g2 = 0; g2 < 2; ++g2)
#pragma unroll
                    for (int dt = 0; dt < 8; ++dt) { const f32x4 v = *(const f32x4*)(Y + row * 1024 + (4 * g2 + hh_) * 128 + 16 * dt + 4 * fq_);
                        sv += (v[0] * v[0] + v[1] * v[1]) + (v[2] * v[2] + v[3] * v[3]); }
                sv += __shfl_xor(sv, 1); sv += __shfl_xor(sv, 2); sv += __shfl_xor(sv, 16); sv += __shfl_xor(sv, 32);
                const float rstd = rsqrtf(sv * (1.f / 1024.f) + EPS);
#pragma unroll 1
                for (int g2 = 0; g2 < 2; ++g2)
#pragma unroll
                    for (int dt = 0; dt < 8; ++dt) { const int ch = (4 * g2 + hh_) * 128 + 16 * dt + 4 * fq_;
                        const f32x4 v = *(const f32x4*)(Y + row * 1024 + ch); const f32x4 gv = *(const f32x4*)(gw + ch); const f32x4 ov = v * rstd * gv;
                        u32x2 wv; wv.x = pg8::pk_bf2(ov[0], ov[1]); wv.y = pg8::pk_bf2(ov[2], ov[3]);
                        *(u32x2*)(MIX + row * DM + 1024 + ch) = wv; }
            }
        }
    }
}

#define XB_TMO      128
#define XB_XCNT(j)  (256  + 64 * (j))
#define XB_XSUB(j)  (1280 + 64 * (j))
#define XB_XGEN(j)  (2304 + 64 * (j))
#define XB_TOP      3328
#define XB_TOPGEN   3392
#define XCD_BAR_WORDS 3456
#define XB_SPIN_CAP (1u << 18)
__device__ __forceinline__ unsigned xb_ld(unsigned* p)              { return __hip_atomic_load(p, __ATOMIC_RELAXED, __HIP_MEMORY_SCOPE_AGENT); }
__device__ __forceinline__ unsigned xb_add(unsigned* p, unsigned v) { return __hip_atomic_fetch_add(p, v, __ATOMIC_RELAXED, __HIP_MEMORY_SCOPE_AGENT); }
__device__ __forceinline__ unsigned xb_xcc_id() { return (unsigned)__builtin_amdgcn_s_getreg((3 << 11) | 20) & 0xFu; }
#define XB_SPIN(cond, bar) do { unsigned _sp = 0; while (cond) { __builtin_amdgcn_s_sleep(1); \
    if ((++_sp & 255u) == 0u) { if (xb_ld(&(bar)[XB_TMO])) break; if (_sp > XB_SPIN_CAP) { atomicAdd(&(bar)[XB_TMO], 1u); break; } } } } while (0)
struct XcdBarrier { unsigned* bar; unsigned x; volatile LAS unsigned* st; };
__device__ __forceinline__ XcdBarrier xcd_barrier_post(unsigned* bar, volatile LAS unsigned* st) {
    XcdBarrier b; b.bar = bar; b.x = xb_xcc_id(); b.st = st;
    if (threadIdx.x == 0) (void)xb_add(&bar[XB_XCNT(b.x)], 1u);
    return b;
}
__device__ __forceinline__ void xcd_barrier_complete(unsigned* bar, unsigned x, unsigned& nloc, unsigned& nx) {
    const unsigned G = gridDim.x * gridDim.y * gridDim.z;
    unsigned sum, cnt, mine, sp = 0u;
    for (;;) {
        sum = 0u; cnt = 0u; mine = 0u;
#pragma unroll
        for (unsigned j = 0; j < 16; ++j) { const unsigned c = xb_ld(&bar[XB_XCNT(j)]); sum += c; cnt += (c > 0u) ? 1u : 0u; mine = (j == x) ? c : mine; }
        if (sum == G) break;
        __builtin_amdgcn_s_sleep(1);
        if ((++sp & 255u) == 0u) { if (xb_ld(&bar[XB_TMO])) break; if (sp > XB_SPIN_CAP) { atomicAdd(&bar[XB_TMO], 1u); break; } }
    }
    nloc = mine > 0u ? mine : 1u; nx = cnt > 0u ? cnt : 1u;
}
__device__ __forceinline__ void xcd_barrier(const XcdBarrier& b) {
    asm volatile("s_waitcnt vmcnt(0)" ::: "memory");
    __syncthreads();
    if (threadIdx.x == 0) {
        unsigned* bar = b.bar;
        __builtin_amdgcn_s_waitcnt(0);
        unsigned nloc = b.st[0], nx = b.st[1];
        if (nloc == 0u) { xcd_barrier_complete(bar, b.x, nloc, nx); b.st[0] = nloc; b.st[1] = nx; }
        const unsigned old = xb_add(&bar[XB_XSUB(b.x)], 1u);
        const unsigned gen = old / nloc;
        if (old + 1u == (gen + 1u) * nloc) {
            __builtin_amdgcn_fence(__ATOMIC_RELEASE, "agent");
            asm volatile("s_waitcnt vmcnt(0)" ::: "memory");
            const unsigned og = xb_add(&bar[XB_TOP], 1u);
            const unsigned tg = og / nx;
            if (og + 1u == (tg + 1u) * nx) xb_add(&bar[XB_TOPGEN], 1u);
            else XB_SPIN(xb_ld(&bar[XB_TOPGEN]) == tg, bar);
            __builtin_amdgcn_fence(__ATOMIC_ACQUIRE, "agent");
            xb_add(&bar[XB_XGEN(b.x)], 1u);
            asm volatile("s_waitcnt vmcnt(0)" ::: "memory");
        } else {
            XB_SPIN(xb_ld(&bar[XB_XGEN(b.x)]) == gen, bar);
            __builtin_amdgcn_fence(__ATOMIC_ACQUIRE, "agent");
            asm volatile("s_waitcnt vmcnt(0)" ::: "memory");
        }
    }
    __syncthreads();
}

constexpr int NPHASE = 12;
struct Args { Ptrs p; int ph_lo, ph_hi; };

__global__ void __launch_bounds__(NTHR, 2) mega(Args args) {
    extern __shared__ __attribute__((aligned(16))) unsigned char lds_raw[];
    LAS unsigned char* lds = (LAS unsigned char*)lds_raw;
    const Ptrs& P = args.p;
    const int G = gridDim.x, bid = blockIdx.x;
    unsigned char* ws = P.ws;
    const float* mod = (const float*)(ws + WS_MOD);
    const int lo = args.ph_lo, hi = args.ph_hi;
    volatile LAS unsigned* MISC = (volatile LAS unsigned*)(lds + LDS_BYTES - 64);
    if (threadIdx.x < 16) MISC[threadIdx.x] = 0u;
    __syncthreads();
    XcdBarrier xbar; xbar.bar = (unsigned*)(ws + WS_BAR); xbar.x = 0; xbar.st = MISC;
    if (hi - lo > 1) xbar = xcd_barrier_post((unsigned*)(ws + WS_BAR), MISC);
#define PHASE_BEGIN(n) if (lo <= (n) && (n) < hi) {
#define PHASE_END(n) if ((n) + 1 < hi) { if (G != 256) cg::this_grid().sync(); else xcd_barrier(xbar); } }
    PHASE_BEGIN(0) p0_prologue(P, lds, G, bid); PHASE_END(0)
    PHASE_BEGIN(1) norm_mod_rows<false, false>(P.in[0], P.in[4], mod, 0, 2048, (h16*)(ws + WS_H), G, bid); PHASE_END(1)
    PHASE_BEGIN(2) { pg8::Gemm g{(const h16*)(ws + WS_H), (const h16*)(ws + WS_WIN), NT, DINP, DM}; pg8::StaticOrder S; S.init(NT, DINP, G, bid);
                  pg8::EpiF16<0> E{(h16*)(ws + WS_U), DINP}; pg8::gemm_phase<false>(lds, g, S, E); } PHASE_END(2)
    PHASE_BEGIN(3) post_u_rows(P, G, bid); PHASE_END(3)
    PHASE_BEGIN(4) compress_phase(P, lds, G, bid); PHASE_END(4)
    PHASE_BEGIN(5) attn_fast(P, lds, G, bid); PHASE_END(5)
    PHASE_BEGIN(7) { pg8::Gemm g{(const h16*)(ws + WS_H), (const h16*)(ws + WS_WOUT), NT, DM, DM}; pg8::StaticOrder S; S.init(NT, DM, G, bid);
                  pg8::EpiRes<true> E{P.in[0], (h16*)(ws + WS_X1H), mod + 2 * 2048, 12288}; pg8::gemm_phase<true>(lds, g, S, E); } PHASE_END(7)
    PHASE_BEGIN(8) norm_mod_rows<true, true>(ws + WS_X1H, P.in[17], mod, 3 * 2048, 4 * 2048, (h16*)(ws + WS_H), G, bid); PHASE_END(8)
    PHASE_BEGIN(9) { pg8::Gemm g{(const h16*)(ws + WS_H), (const h16*)(ws + WS_W1), NT, DFF, DM}; pg8::StaticOrder S; S.init(NT, DFF, G, bid);
                  pg8::EpiF16<1, true> E{(h16*)(ws + WS_HID), DFF}; pg8::gemm_phase<true>(lds, g, S, E); } PHASE_END(9)
    PHASE_BEGIN(10) { pg8::Gemm g{(const h16*)(ws + WS_HID), (const h16*)(ws + WS_W2), NT, DM, DFF}; pg8::StaticOrder S; S.init(NT, DM, G, bid);
                   pg8::EpiRes<false> E{ws + WS_X1H, (h16*)(ws + WS_X1H), mod + 5 * 2048, 12288}; pg8::gemm_phase<true>(lds, g, S, E); } PHASE_END(10)
    PHASE_BEGIN(11) final_norm_rows((const h16*)(ws + WS_X1H), P.out, P.in[20], G, bid); PHASE_END(11)
}

extern "C" void kernel_launch(void* const* d_in, const int* in_sizes, int n_in, void* d_out, int out_size, void* d_ws, size_t ws_size, hipStream_t stream) {
    static int grid = 0;
    if (grid == 0) {
        if (n_in != 21 || out_size != NT * DM || ws_size < WS_END2) { fprintf(stderr, "kernel_launch: unexpected shapes (n_in %d out %d ws %zu need %zu)\n", n_in, out_size, ws_size, (size_t)WS_END2); grid = -1; return; }
        int dev = 0, cus = 0, per_cu = 0;
        hipGetDevice(&dev); hipDeviceGetAttribute(&cus, hipDeviceAttributeMultiprocessorCount, dev);
        if (hipFuncSetAttribute((const void*)mega, hipFuncAttributeMaxDynamicSharedMemorySize, LDS_BYTES) != hipSuccess) { fprintf(stderr, "kernel_launch: hipFuncSetAttribute failed\n"); grid = -1; return; }
        if (hipOccupancyMaxActiveBlocksPerMultiprocessor(&per_cu, (const void*)mega, NTHR, LDS_BYTES) != hipSuccess || per_cu < 1) { fprintf(stderr, "kernel_launch: occupancy query says %d\n", per_cu); per_cu = 1; }
        (void)hipGetLastError();
        grid = cus * 1;
        fprintf(stderr, "kernel_launch: cus %d per_cu %d grid %d\n", cus, per_cu, grid);
    }
    if (grid < 0) return;
    if (hipMemsetAsync((char*)d_ws + WS_BAR, 0, WS_BAR_BYTES, stream) != hipSuccess) { fprintf(stderr, "kernel_launch: memset failed\n"); return; }
    Args a{};
    for (int i = 0; i < 21; ++i) a.p.in[i] = (const float*)d_in[i];
    a.p.out = (float*)d_out; a.p.ws = (unsigned char*)d_ws;
    a.ph_lo = 0; a.ph_hi = NPHASE;
    void* kargs[] = {&a};
    hipError_t e = hipLaunchCooperativeKernel((const void*)mega, dim3(grid), dim3(NTHR), kargs, LDS_BYTES, stream);
    if (e != hipSuccess) fprintf(stderr, "cooperative launch failed: %s (grid %d)\n", hipGetErrorString(e), grid);
}
```

```cpp
#include <hip/hip_runtime.h>
#include <hip/hip_cooperative_groups.h>
#include <cstdint>
#include <cstdio>
namespace cg = cooperative_groups;


#define LAS __attribute__((address_space(3)))
typedef _Float16 h16;
typedef _Float16 half8 __attribute__((ext_vector_type(8)));
typedef _Float16 half4 __attribute__((ext_vector_type(4)));
typedef _Float16 half2v __attribute__((ext_vector_type(2)));
typedef float f32x4 __attribute__((ext_vector_type(4)));
typedef float f32x2 __attribute__((ext_vector_type(2)));
typedef unsigned u32x4 __attribute__((ext_vector_type(4)));
typedef unsigned u32x2 __attribute__((ext_vector_type(2)));

constexpr int NB = 4, SEQ = 8192, NT = NB * SEQ, DM = 2048, DIN = 5656, DINP = 5888, DFF = 8192;
constexpr int OFF_UB = 0, OFF_UC = 1024, OFF_UH = 2048, OFF_Q = 3072, OFF_KC = 4096, OFF_VC = 4352, OFF_KS = 4608, OFF_VS = 4864,
              OFF_KW = 5120, OFF_VW = 5376, OFF_GL = 5632;
constexpr float EPS = 1e-6f;
constexpr int NTHR = 512;
constexpr int LDS_BYTES = 136 * 1024;

constexpr size_t WS_BAR   = 0;
constexpr size_t WS_BAR_BYTES = 16384;
constexpr size_t WS_MOD   = 16384;
constexpr size_t WS_B1P   = WS_MOD + (size_t)4 * 12288 * 4;
constexpr size_t WS_WIN   = WS_B1P + (size_t)2 * 32 * 256 * 4;
constexpr size_t WS_WOUT  = WS_WIN + (size_t)DINP * DM * 2;
constexpr size_t WS_W1    = WS_WOUT + (size_t)DM * DM * 2;
constexpr size_t WS_W2    = WS_W1 + (size_t)DFF * DM * 2;
constexpr size_t WS_CW1K  = WS_W2 + (size_t)DFF * DM * 2;
constexpr size_t WS_CW1V  = WS_CW1K + (size_t)256 * 4096 * 2;
constexpr size_t WS_CW2K  = WS_CW1V + (size_t)256 * 4096 * 2;
constexpr size_t WS_CW2V  = WS_CW2K + (size_t)128 * 256 * 2;
constexpr size_t WS_KCMP  = WS_CW2V + (size_t)128 * 256 * 2;
constexpr size_t WS_VCMP  = WS_KCMP + (size_t)8 * 512 * 128 * 2;
constexpr size_t WS_H     = WS_VCMP + (size_t)8 * 512 * 128 * 2;
constexpr size_t WS_BIG   = WS_H + (size_t)NT * DM * 2;
constexpr size_t WS_U     = WS_BIG;
constexpr size_t WS_YACC  = WS_U + (size_t)NT * DINP * 2;
constexpr size_t WS_HID   = WS_BIG;
constexpr size_t WS_END   = WS_BIG + (size_t)NT * DFF * 2;
static_assert(WS_YACC + (size_t)NT * 1024 * 4 <= WS_END, "ws map");
constexpr size_t WS_X1H   = WS_END;
constexpr size_t WS_END2  = WS_X1H + (size_t)NT * DM * 2;
static_assert(WS_END2 <= (size_t)1073741824, "ws map fits 4x largest tensor");
static_assert(WS_WIN % 256 == 0 && WS_H % 256 == 0 && WS_BIG % 256 == 0 && WS_YACC % 256 == 0, "alignment");

namespace pg8 {
constexpr int BM = 256, BK = 64, HALF = 128, HTB = HALF * BK * 2, STAGE_BYTES = 8 * HTB, NXCD = 8, WGM = 8;
__host__ __device__ __forceinline__ int lds_byte(int r, int c) { const int st = (r >> 4) * 2 + (c >> 5), rr = r & 15, cc = c & 31, ob = rr * 64 + cc * 2; return st * 1024 + (ob ^ (((ob >> 9) & 1) << 5)); }
__host__ __device__ __forceinline__ void stage_rc(int b, int& R, int& C) { const int st = b / 1024, sb = b % 1024, swz = sb ^ (((sb >> 9) & 1) << 5); R = (st >> 1) * 16 + swz / 64; C = (st & 1) * 32 + (swz % 64) / 2; }
__host__ __device__ __forceinline__ int perm32(int rho) { const int n = rho >> 4, i = rho & 15; return 8 * (i >> 2) + 4 * n + (i & 3); }

struct Unit { int pm, pn; };
struct Gemm { const h16* A; const h16* Bt; int M, N, K; };

struct StaticOrder {
    int nM, nN, nwg, G, c;
    __host__ __device__ void init(int M, int N, int G_, int c_) { nM = M / BM; nN = N / BM; nwg = nM * nN; G = G_; c = c_; }
    __host__ __device__ bool next(int i, Unit& u) const {
        const long L = (long)i * G + c; if (L >= nwg) return false;
        int wgid = (int)L; { const int q = nwg / NXCD, r = nwg % NXCD, xcd = wgid % NXCD, off = wgid / NXCD; wgid = (xcd < r ? xcd * (q + 1) : r * (q + 1) + (xcd - r) * q) + off; }
        const int nig = WGM * nN, gid = wgid / nig, fm = gid * WGM, gsz = (nM - fm) < WGM ? (nM - fm) : WGM;
        u.pm = fm + ((wgid % nig) % gsz); u.pn = (wgid % nig) / gsz; return true;
    }
    __device__ __forceinline__ void a_ready(const Unit&) const {}
    __device__ __forceinline__ void done(const Unit&) const {}
};

__device__ __forceinline__ unsigned pk_h2(float lo, float hi) { half2v v; v.x = (h16)lo; v.y = (h16)hi; return __builtin_bit_cast(unsigned, v); }
__device__ __forceinline__ unsigned pk_bf2(float lo, float hi) { unsigned r; asm("v_cvt_pk_bf16_f32 %0, %1, %2" : "=v"(r) : "v"(lo), "v"(hi)); return r; }
template <bool BF> __device__ __forceinline__ unsigned pk2(float lo, float hi) { return BF ? pk_bf2(lo, hi) : pk_h2(lo, hi); }
typedef short bfx8 __attribute__((ext_vector_type(8)));

template <int ACT, bool BF = false> struct EpiF16 {
    static constexpr bool PERM = true, AFTER_DRAIN = false;
    h16* O; int ldc;
    __device__ __forceinline__ void operator()(const f32x4 (&acc)[2][2][4][2], const Unit& u, int wr, int wc, int fr, int fq) const {
        const int row0 = u.pm * BM + wr * 64 + fr; const int col0 = u.pn * BM + wc * 32 + 8 * fq;
#pragma unroll
        for (int ai = 0; ai < 2; ++ai)
#pragma unroll
            for (int m = 0; m < 4; ++m) { h16* rowp = O + (size_t)(row0 + ai * HALF + m * 16) * ldc + col0;
#pragma unroll
                for (int bj = 0; bj < 2; ++bj) { f32x4 v0 = acc[ai][bj][m][0], v1 = acc[ai][bj][m][1];
                    if (ACT == 1) {
#pragma unroll
                        for (int j = 0; j < 4; ++j) { const float a = fmaxf(v0[j], 0.f), b = fmaxf(v1[j], 0.f); v0[j] = a * a; v1[j] = b * b; } }
                    u32x4 w; w.x = pk2<BF>(v0[0], v0[1]); w.y = pk2<BF>(v0[2], v0[3]); w.z = pk2<BF>(v1[0], v1[1]); w.w = pk2<BF>(v1[2], v1[3]);
                    *(u32x4*)(rowp + bj * HALF) = w; } }
    }
};
template <bool BASE_F32> struct EpiRes {
    static constexpr bool PERM = true, AFTER_DRAIN = false;
    const void* base; h16* out; const float* gate; int gate_ld;
    __device__ __forceinline__ void operator()(const f32x4 (&acc)[2][2][4][2], const Unit& u, int wr, int wc, int fr, int fq) const {
        const int row0 = u.pm * BM + wr * 64 + fr, col0 = u.pn * BM + wc * 32 + 8 * fq; const int b = (u.pm * BM) / SEQ;
        f32x4 gv[2][2];
#pragma unroll
        for (int bj = 0; bj < 2; ++bj)
#pragma unroll
            for (int n = 0; n < 2; ++n) gv[bj][n] = *(const f32x4*)(gate + (size_t)b * gate_ld + col0 + bj * HALF + 4 * n);
#pragma unroll
        for (int ai = 0; ai < 2; ++ai)
#pragma unroll
            for (int m = 0; m < 4; ++m) { const size_t ro = (size_t)(row0 + ai * HALF + m * 16) * DM + col0;
#pragma unroll
                for (int bj = 0; bj < 2; ++bj) { f32x4 b0, b1;
                    if (BASE_F32) { b0 = *(const f32x4*)((const float*)base + ro + bj * HALF); b1 = *(const f32x4*)((const float*)base + ro + bj * HALF + 4); }
                    else { const half8 hb = *(const half8*)((const h16*)base + ro + bj * HALF);
                           b0 = (f32x4){(float)hb[0], (float)hb[1], (float)hb[2], (float)hb[3]}; b1 = (f32x4){(float)hb[4], (float)hb[5], (float)hb[6], (float)hb[7]}; }
                    const f32x4 v0 = b0 + gv[bj][0] * acc[ai][bj][m][0], v1 = b1 + gv[bj][1] * acc[ai][bj][m][1];
                    u32x4 w; w.x = pk_h2(v0[0], v0[1]); w.y = pk_h2(v0[2], v0[3]); w.z = pk_h2(v1[0], v1[1]); w.w = pk_h2(v1[2], v1[3]);
                    *(u32x4*)(out + ro + bj * HALF) = w; } }
    }
};

template <bool BF16, class Epi, class Sched, bool ALIGN_EPI = true, bool SP2 = true>
__device__ __forceinline__ void gemm_phase(LAS unsigned char* lds, const Gemm g, const Sched& S, const Epi& E) {
    const int tid = threadIdx.x, wid = __builtin_amdgcn_readfirstlane(tid >> 6), lane = tid & 63, wr = wid >> 2, wc = wid & 3, fr = lane & 15, fq = lane >> 4;
    const int K = g.K, nt = K / BK;
    unsigned voffA[2], voffB[2];
#pragma unroll
    for (int i = 0; i < 2; ++i) { int R, C; stage_rc(tid * 16 + i * 8192, R, C); const int Rb = Epi::PERM ? ((R & ~31) + perm32(R & 31)) : R;
        voffA[i] = (unsigned)(R * K + C) * 2u; voffB[i] = (unsigned)(Rb * K + C) * 2u; }
    const size_t kstep = (size_t)(BK * 2);
    const size_t hstep = (size_t)HALF * K * 2;
    const size_t tstep = 2 * hstep;
    const unsigned ldsw = (unsigned)wid * 1024u;
    const int aoff = lds_byte(wr * 64 + fr, fq * 8), boff = lds_byte(wc * 32 + fr, fq * 8);
#define PG8_SA(b, h) (((b) * 2 + (h)) * HTB)
#define PG8_SB(b, h) ((4 + (b) * 2 + (h)) * HTB)
#define PG8_STAGE(bufoff, gbase, voff) do { _Pragma("unroll") for (int _i = 0; _i < 2; ++_i) \
        __builtin_amdgcn_global_load_lds((const unsigned*)((const char*)(gbase) + (voff)[_i]), (LAS unsigned*)(lds + (bufoff) + ldsw + _i * 8192), 16, 0, 0); } while (0)
#define PG8_LDA(dst, b, h) do { _Pragma("unroll") for (int m = 0; m < 4; ++m) _Pragma("unroll") for (int k = 0; k < 2; ++k) dst[m][k] = *(const LAS half8*)(lds + PG8_SA(b, h) + aoff + m * 2048 + k * 1024); } while (0)
#define PG8_LDB(dst, b, h) do { _Pragma("unroll") for (int n = 0; n < 2; ++n) _Pragma("unroll") for (int k = 0; k < 2; ++k) dst[n][k] = *(const LAS half8*)(lds + PG8_SB(b, h) + boff + n * 2048 + k * 1024); } while (0)
#define PG8_MMA(ai, bj, At, Bt) do { __builtin_amdgcn_s_setprio(1); _Pragma("unroll") for (int m = 0; m < 4; ++m) _Pragma("unroll") for (int n = 0; n < 2; ++n) _Pragma("unroll") for (int k = 0; k < 2; ++k) \
        acc[ai][bj][m][n] = BF16 ? __builtin_amdgcn_mfma_f32_16x16x32_bf16(__builtin_bit_cast(bfx8, Bt[n][k]), __builtin_bit_cast(bfx8, At[m][k]), acc[ai][bj][m][n], 0, 0, 0) \
                                 : __builtin_amdgcn_mfma_f32_16x16x32_f16(Bt[n][k], At[m][k], acc[ai][bj][m][n], 0, 0, 0); __builtin_amdgcn_s_setprio(0); } while (0)
#define PG8_WAIT_V(n) asm volatile("s_waitcnt vmcnt(" #n ")" ::: "memory")
#define PG8_WAIT_L(n) asm volatile("s_waitcnt lgkmcnt(" #n ")" ::: "memory")
#define PG8_BAR __builtin_amdgcn_s_barrier()
#define PG8_SCHED __builtin_amdgcn_sched_barrier(0)
    Unit cur, nxt; int ui = 0;
    if (!S.next(0, cur)) return;
    f32x4 acc[2][2][4][2];
#pragma unroll
    for (int a = 0; a < 2; ++a)
#pragma unroll
        for (int b = 0; b < 2; ++b)
#pragma unroll
            for (int m = 0; m < 4; ++m)
#pragma unroll
                for (int n = 0; n < 2; ++n) acc[a][b][m][n] = (f32x4){0.f, 0.f, 0.f, 0.f};
    half8 At[4][2], B0[2][2], B1[2][2];
    const char* cA = (const char*)g.A + (size_t)cur.pm * tstep; const char* cB = (const char*)g.Bt + (size_t)cur.pn * tstep;
    S.a_ready(cur);
    if constexpr (SP2) {
        PG8_STAGE(PG8_SB(0, 0), cB, voffB); PG8_STAGE(PG8_SB(0, 1), cB + hstep, voffB); PG8_STAGE(PG8_SA(0, 0), cA, voffA); PG8_STAGE(PG8_SA(0, 1), cA + hstep, voffA);
        if (wr == 1) PG8_BAR;
        PG8_WAIT_V(2); PG8_BAR;
        PG8_STAGE(PG8_SB(1, 0), cB + kstep, voffB); PG8_STAGE(PG8_SA(1, 0), cA + kstep, voffA); PG8_STAGE(PG8_SB(1, 1), cB + hstep + kstep, voffB);
        PG8_WAIT_V(6); PG8_BAR;
    } else {
        PG8_STAGE(PG8_SB(0, 0), cB, voffB); PG8_STAGE(PG8_SA(0, 0), cA, voffA); PG8_STAGE(PG8_SB(0, 1), cB + hstep, voffB); PG8_STAGE(PG8_SA(0, 1), cA + hstep, voffA);
        if (wr == 1) PG8_BAR;
        PG8_WAIT_V(4); PG8_BAR;
        PG8_STAGE(PG8_SB(1, 0), cB + kstep, voffB); PG8_STAGE(PG8_SA(1, 0), cA + kstep, voffA); PG8_STAGE(PG8_SB(1, 1), cB + hstep + kstep, voffB);
        PG8_WAIT_V(6); PG8_BAR;
    }
    for (;;) {
        const bool has_next = S.next(ui + 1, nxt);
        const char* nA = has_next ? (const char*)g.A + (size_t)nxt.pm * tstep : cA; const char* nB = has_next ? (const char*)g.Bt + (size_t)nxt.pn * tstep : cB;
        for (int t = 0; t < nt; t += 2) {
            const bool last = (t == nt - 2);
            const char* a1 = cA + (size_t)(t + 1) * kstep;
            const char* a2 = last ? nA : cA + (size_t)(t + 2) * kstep; const char* b2 = last ? nB : cB + (size_t)(t + 2) * kstep;
            const char* a3 = a2 + kstep; const char* b3 = b2 + kstep;
            if (last && has_next) S.a_ready(nxt);
            if constexpr (SP2) {
            PG8_LDB(B0, 0, 0); PG8_LDB(B1, 0, 1); PG8_SCHED; PG8_LDA(At, 0, 0); PG8_STAGE(PG8_SA(1, 1), a1 + hstep, voffA);
            PG8_WAIT_V(8); PG8_WAIT_L(0); PG8_BAR; PG8_MMA(0, 0, At, B0); PG8_MMA(0, 1, At, B1); PG8_BAR; PG8_SCHED;
            PG8_LDA(At, 0, 1); PG8_STAGE(PG8_SB(0, 0), b2, voffB); PG8_STAGE(PG8_SB(0, 1), b2 + hstep, voffB); PG8_STAGE(PG8_SA(0, 0), a2, voffA);
            PG8_WAIT_V(8); PG8_WAIT_L(0); PG8_BAR; PG8_MMA(1, 0, At, B0); PG8_MMA(1, 1, At, B1); PG8_BAR; PG8_SCHED;
            PG8_LDB(B0, 1, 0); PG8_LDB(B1, 1, 1); PG8_SCHED; PG8_LDA(At, 1, 0); PG8_STAGE(PG8_SA(0, 1), a2 + hstep, voffA);
            PG8_WAIT_V(8); PG8_WAIT_L(0); PG8_BAR; PG8_MMA(0, 0, At, B0); PG8_MMA(0, 1, At, B1); PG8_BAR; PG8_SCHED;
            PG8_LDA(At, 1, 1); PG8_STAGE(PG8_SB(1, 0), b3, voffB); PG8_STAGE(PG8_SB(1, 1), b3 + hstep, voffB); PG8_STAGE(PG8_SA(1, 0), a3, voffA);
            PG8_WAIT_V(8); PG8_WAIT_L(0); PG8_BAR; PG8_MMA(1, 0, At, B0); PG8_MMA(1, 1, At, B1); PG8_BAR; PG8_SCHED;
            } else {
            PG8_LDB(B0, 0, 0); PG8_SCHED; PG8_LDA(At, 0, 0); PG8_STAGE(PG8_SA(1, 1), a1 + hstep, voffA);
            PG8_WAIT_L(8); PG8_BAR; PG8_WAIT_L(0); PG8_MMA(0, 0, At, B0); PG8_BAR; PG8_SCHED;
            PG8_LDB(B1, 0, 1); PG8_STAGE(PG8_SB(0, 0), b2, voffB);
            PG8_BAR; PG8_WAIT_L(0); PG8_MMA(0, 1, At, B1); PG8_BAR;
            PG8_LDA(At, 0, 1); PG8_STAGE(PG8_SA(0, 0), a2, voffA);
            PG8_BAR; PG8_WAIT_L(0); PG8_MMA(1, 0, At, B0); PG8_BAR; PG8_SCHED;
            PG8_STAGE(PG8_SB(0, 1), b2 + hstep, voffB);
            PG8_WAIT_V(6); PG8_BAR; PG8_MMA(1, 1, At, B1); PG8_BAR;
            PG8_LDB(B0, 1, 0); PG8_SCHED; PG8_LDA(At, 1, 0); PG8_STAGE(PG8_SA(0, 1), a2 + hstep, voffA);
            PG8_WAIT_L(8); PG8_BAR; PG8_WAIT_L(0); PG8_MMA(0, 0, At, B0); PG8_BAR; PG8_SCHED;
            PG8_LDB(B1, 1, 1); PG8_STAGE(PG8_SB(1, 0), b3, voffB);
            PG8_BAR; PG8_WAIT_L(0); PG8_MMA(0, 1, At, B1); PG8_BAR;
            PG8_LDA(At, 1, 1); PG8_STAGE(PG8_SA(1, 0), a3, voffA);
            PG8_BAR; PG8_WAIT_L(0); PG8_MMA(1, 0, At, B0); PG8_BAR; PG8_SCHED;
            PG8_STAGE(PG8_SB(1, 1), b3 + hstep, voffB);
            PG8_WAIT_V(6); PG8_BAR; PG8_MMA(1, 1, At, B1); PG8_BAR;
            }
        }
        if constexpr (ALIGN_EPI) { if (wr == 0) PG8_BAR; }
        E(acc, cur, wr, wc, fr, fq); S.done(cur);
        if (!has_next) break;
#pragma unroll
        for (int a = 0; a < 2; ++a)
#pragma unroll
            for (int b = 0; b < 2; ++b)
#pragma unroll
                for (int m = 0; m < 4; ++m)
#pragma unroll
                    for (int n = 0; n < 2; ++n) acc[a][b][m][n] = (f32x4){0.f, 0.f, 0.f, 0.f};
        cur = nxt; cA = nA; cB = nB; ++ui;
        if constexpr (ALIGN_EPI) { if (wr == 1) PG8_BAR; }
    }
    PG8_WAIT_V(0);
    if constexpr (!ALIGN_EPI) { if (wr == 0) PG8_BAR; }
    PG8_BAR;
#undef PG8_SA
#undef PG8_SB
#undef PG8_STAGE
#undef PG8_LDA
#undef PG8_LDB
#undef PG8_MMA
#undef PG8_WAIT_V
#undef PG8_WAIT_L
#undef PG8_BAR
#undef PG8_SCHED
}
}

__device__ __forceinline__ float wave_sum(float v) {
#pragma unroll
    for (int o = 1; o < 64; o <<= 1) v += __shfl_xor(v, o);
    return v;
}
__device__ __forceinline__ float wave_max(float v) {
#pragma unroll
    for (int o = 1; o < 64; o <<= 1) v = fmaxf(v, __shfl_xor(v, o));
    return v;
}
__device__ __forceinline__ float bcast_lane(float v, int j) { return __builtin_bit_cast(float, __builtin_amdgcn_readlane(__builtin_bit_cast(int, v), j)); }

struct Ptrs {
    const float* in[21]; float* out; unsigned char* ws;
};

constexpr int P0_ADA = 192, P0_B1 = 64;
constexpr int P0_TWIN = 32 * 23, P0_TWOUT = 32 * 8, P0_TW1 = 32 * 32, P0_TW2 = 128 * 8, P0_TC1 = 64 * 1, P0_TC2 = 4 * 1;
constexpr int P0_OFF_B1 = P0_ADA, P0_OFF_TWIN = P0_OFF_B1 + P0_B1, P0_OFF_TWOUT = P0_OFF_TWIN + P0_TWIN, P0_OFF_TW1 = P0_OFF_TWOUT + P0_TWOUT,
              P0_OFF_TW2 = P0_OFF_TW1 + P0_TW1, P0_OFF_TC1K = P0_OFF_TW2 + P0_TW2, P0_OFF_TC1V = P0_OFF_TC1K + P0_TC1, P0_OFF_TC2K = P0_OFF_TC1V + P0_TC1,
              P0_OFF_TC2V = P0_OFF_TC2K + P0_TC2, P0_ITEMS = P0_OFF_TC2V + P0_TC2;

__device__ __forceinline__ void transpose_tile(const float* __restrict__ W, int K, int N, int Nout, h16* __restrict__ Wt, int item, LAS float* scr, int tid, bool bf = false) {
    const int nkt = K / 64; const int kt = item % nkt, ntl = item / nkt;
    { const int c4 = tid & 63, r = tid >> 6; f32x4 v[8];
#pragma unroll
      for (int i = 0; i < 8; ++i) { const int k = kt * 64 + r + 8 * i, n = ntl * 256 + 4 * c4;
          v[i] = (f32x4){0.f, 0.f, 0.f, 0.f}; if (n < N) v[i] = *(const f32x4*)(W + (size_t)k * N + n); }
#pragma unroll
      for (int i = 0; i < 8; ++i) *(LAS f32x4*)(scr + (r + 8 * i) * 260 + 4 * c4) = v[i]; }
    __syncthreads();
    { const int n = tid >> 1, hf = tid & 1;
      if (ntl * 256 + n < Nout) {
#pragma unroll
          for (int q = 0; q < 4; ++q) { float f[8];
#pragma unroll
              for (int j = 0; j < 8; ++j) f[j] = scr[(32 * hf + 8 * q + j) * 260 + n];
              u32x4 o;
              if (bf) { o.x = pg8::pk_bf2(f[0], f[1]); o.y = pg8::pk_bf2(f[2], f[3]); o.z = pg8::pk_bf2(f[4], f[5]); o.w = pg8::pk_bf2(f[6], f[7]); }
              else    { o.x = pg8::pk_h2(f[0], f[1]);  o.y = pg8::pk_h2(f[2], f[3]);  o.z = pg8::pk_h2(f[4], f[5]);  o.w = pg8::pk_h2(f[6], f[7]); }
              *(u32x4*)(Wt + (size_t)(ntl * 256 + n) * K + kt * 64 + 32 * hf + 8 * q) = o; } } }
    __syncthreads();
}

__device__ __forceinline__ void p0_prologue(const Ptrs& P, LAS unsigned char* lds, int G, int bid) {
    const int tid = threadIdx.x;
    LAS float* scr = (LAS float*)lds;
    unsigned char* ws = P.ws;
    for (int it = bid; it < P0_ITEMS; it += G) {
        if (it < P0_ADA) {
            LAS float* sc = scr;
            LAS float* red = scr + 8192;
            const float* c = P.in[1];
            for (int i = tid; i < 8192; i += NTHR) { const float v = c[i]; sc[i] = v / (1.f + __expf(-v)); }
            __syncthreads();
            const int cl = tid & 15, kg = tid >> 4;
            f32x4 a0 = {0, 0, 0, 0}, a1 = a0, a2 = a0, a3 = a0;
            const float* W = P.in[2] + 64 * it + 4 * cl;
#pragma unroll 8
            for (int k = kg; k < 2048; k += 32) { const f32x4 w = *(const f32x4*)(W + (size_t)k * 12288);
                a0 += sc[k] * w; a1 += sc[2048 + k] * w; a2 += sc[4096 + k] * w; a3 += sc[6144 + k] * w; }
#pragma unroll
            for (int j = 0; j < 4; ++j) { red[(kg * 4 + 0) * 64 + 4 * cl + j] = a0[j]; red[(kg * 4 + 1) * 64 + 4 * cl + j] = a1[j];
                red[(kg * 4 + 2) * 64 + 4 * cl + j] = a2[j]; red[(kg * 4 + 3) * 64 + 4 * cl + j] = a3[j]; }
            __syncthreads();
            if (tid < 256) { const int b = tid >> 6, col = tid & 63; float s = 0.f;
                for (int q = 0; q < 32; ++q) s += red[(q * 4 + b) * 64 + col];
                ((float*)(ws + WS_MOD))[b * 12288 + 64 * it + col] = s + P.in[3][64 * it + col]; }
            __syncthreads();
        } else if (it < P0_OFF_TWIN) {
            const int q = it - P0_OFF_B1, kv = q >> 5, part = q & 31;
            const float* pe = P.in[8 + kv]; const float* W1 = P.in[kv ? 12 : 10];
            const int col = tid & 255, kh = tid >> 8; float s = 0.f;
            for (int k = 128 * part + 64 * kh; k < 128 * part + 64 * kh + 64; ++k) s += pe[k] * W1[(size_t)k * 256 + col];
            scr[tid] = s; __syncthreads();
            if (tid < 256) ((float*)(ws + WS_B1P))[(kv * 32 + part) * 256 + tid] = scr[tid] + scr[tid + 256];
            __syncthreads();
        } else if (it < P0_OFF_TWOUT) transpose_tile(P.in[5], DM, DIN, DINP, (h16*)(ws + WS_WIN), it - P0_OFF_TWIN, scr, tid);
        else if (it < P0_OFF_TW1)     transpose_tile(P.in[16], DM, DM, DM, (h16*)(ws + WS_WOUT), it - P0_OFF_TWOUT, scr, tid, true);
        else if (it < P0_OFF_TW2)     transpose_tile(P.in[18], DM, DFF, DFF, (h16*)(ws + WS_W1), it - P0_OFF_TW1, scr, tid, true);
        else if (it < P0_OFF_TC1K)    transpose_tile(P.in[19], DFF, DM, DM, (h16*)(ws + WS_W2), it - P0_OFF_TW2, scr, tid, true);
        else if (it < P0_OFF_TC1V)    transpose_tile(P.in[10], 4096, 256, 256, (h16*)(ws + WS_CW1K), it - P0_OFF_TC1K, scr, tid);
        else if (it < P0_OFF_TC2K)    transpose_tile(P.in[12], 4096, 256, 256, (h16*)(ws + WS_CW1V), it - P0_OFF_TC1V, scr, tid);
        else if (it < P0_OFF_TC2V)    transpose_tile(P.in[11], 256, 128, 128, (h16*)(ws + WS_CW2K), it - P0_OFF_TC2K, scr, tid);
        else                          transpose_tile(P.in[13], 256, 128, 128, (h16*)(ws + WS_CW2V), it - P0_OFF_TC2V, scr, tid);
    }
}

template <bool BF, bool IN_F16> __device__ __forceinline__ void norm_mod_rows(const void* __restrict__ Xv, const float* __restrict__ gw, const float* __restrict__ mod, int sh_off, int sc_off,
                                              h16* __restrict__ H, int G, int bid) {
    const int lane = threadIdx.x & 63, wave = threadIdx.x >> 6;
    for (int r = bid * 8 + wave; r < NT; r += G * 8) {
        const int b = r >> 13; f32x4 v[8]; float ss = 0.f;
        if (IN_F16) { const h16* xr = (const h16*)Xv + (size_t)r * DM;
#pragma unroll
            for (int i = 0; i < 8; ++i) { const half4 hv = *(const half4*)(xr + 4 * (lane + 64 * i)); v[i] = (f32x4){(float)hv[0], (float)hv[1], (float)hv[2], (float)hv[3]}; } }
        else { const float* xr = (const float*)Xv + (size_t)r * DM;
#pragma unroll
            for (int i = 0; i < 8; ++i) v[i] = *(const f32x4*)(xr + 4 * (lane + 64 * i)); }
#pragma unroll
        for (int i = 0; i < 8; ++i) ss += v[i][0] * v[i][0] + v[i][1] * v[i][1] + v[i][2] * v[i][2] + v[i][3] * v[i][3];
        ss = wave_sum(ss); const float rstd = rsqrtf(ss * (1.f / DM) + EPS);
        const float* mb = mod + (size_t)b * 12288;
#pragma unroll
        for (int i = 0; i < 8; ++i) { const int c = 4 * (lane + 64 * i);
            const f32x4 g = *(const f32x4*)(gw + c), sh = *(const f32x4*)(mb + sh_off + c), sc = *(const f32x4*)(mb + sc_off + c);
            const f32x4 o = (v[i] * rstd) * g * (1.f + sc) + sh;
            u32x2 w; w.x = pg8::pk2<BF>(o[0], o[1]); w.y = pg8::pk2<BF>(o[2], o[3]);
            *(u32x2*)(H + (size_t)r * DM + c) = w; }
    }
}
__device__ __forceinline__ void final_norm_rows(const h16* __restrict__ X, float* __restrict__ O, const float* __restrict__ gw, int G, int bid) {
    const int lane = threadIdx.x & 63, wave = threadIdx.x >> 6;
    for (int r = bid * 8 + wave; r < NT; r += G * 8) {
        const h16* xr = X + (size_t)r * DM; f32x4 v[8]; float ss = 0.f;
#pragma unroll
        for (int i = 0; i < 8; ++i) { const half4 hv = *(const half4*)(xr + 4 * (lane + 64 * i)); v[i] = (f32x4){(float)hv[0], (float)hv[1], (float)hv[2], (float)hv[3]};
            ss += v[i][0] * v[i][0] + v[i][1] * v[i][1] + v[i][2] * v[i][2] + v[i][3] * v[i][3]; }
        ss = wave_sum(ss); const float rstd = rsqrtf(ss * (1.f / DM) + EPS);
#pragma unroll
        for (int i = 0; i < 8; ++i) { const int c = 4 * (lane + 64 * i); const f32x4 g = *(const f32x4*)(gw + c); *(f32x4*)(O + (size_t)r * DM + c) = (v[i] * rstd) * g; }
    }
}

__device__ __forceinline__ void post_u_rows(const Ptrs& P, int G, int bid) {
    const int lane = threadIdx.x & 63, wave = threadIdx.x >> 6;
    h16* U = (h16*)(P.ws + WS_U); h16* MIX = (h16*)(P.ws + WS_H);
    const float* cw = P.in[6]; const float* cb = P.in[7]; const float* gcv = P.in[14];
    const int hsel = lane >> 3, c8 = lane & 7;
    float inv[8];
#pragma unroll
    for (int e = 0; e < 8; ++e) inv[e] = (float)exp2(-(double)(8 * c8 + e) * (13.287712379549449 / 64.0));
    float wcb[16], wc0[16], wc1[16], wc2[16], wg[16];
#pragma unroll
    for (int hf = 0; hf < 2; ++hf)
#pragma unroll
        for (int j = 0; j < 8; ++j) { const int ch = 512 * hf + 8 * lane + j; wcb[8 * hf + j] = cb[ch]; wc0[8 * hf + j] = cw[ch]; wc1[8 * hf + j] = cw[1024 + ch]; wc2[8 * hf + j] = cw[2048 + ch]; wg[8 * hf + j] = gcv[ch]; }
    for (int r = bid * 8 + wave; r < NT; r += G * 8) {
        const int pos = r & (SEQ - 1); h16* u = U + (size_t)r * DINP;
        float cs[8], sn[8];
#pragma unroll
        for (int e = 0; e < 8; ++e) { const float ang = (float)pos * inv[e];
            double rev = (double)ang * 0.15915494309189535; rev -= __builtin_rint(rev);
            const float rf = (float)rev; cs[e] = __builtin_amdgcn_cosf(rf); sn[e] = __builtin_amdgcn_sinf(rf); }
#pragma unroll
        for (int rd = 0; rd < 2; ++rd) {
            const int base = rd == 0 ? OFF_Q + 128 * hsel : (hsel < 2 ? OFF_KC + 128 * hsel : (hsel < 4 ? OFF_KS + 128 * (hsel - 2) : OFF_KW + 128 * (hsel - 4)));
            if (rd == 0 || hsel < 6) {
                const half8 x1 = *(const half8*)(u + base + 8 * c8), x2 = *(const half8*)(u + base + 64 + 8 * c8); half8 o1, o2;
#pragma unroll
                for (int e = 0; e < 8; ++e) { const float a = (float)x1[e], bq = (float)x2[e]; o1[e] = (h16)(a * cs[e] - bq * sn[e]); o2[e] = (h16)(bq * cs[e] + a * sn[e]); }
                *(half8*)(u + base + 8 * c8) = o1; *(half8*)(u + base + 64 + 8 * c8) = o2; }
        }
        float y[16]; float ss = 0.f;
#pragma unroll
        for (int hf = 0; hf < 2; ++hf) {
            const int ch = 512 * hf + 8 * lane;
            const half8 ub = *(const half8*)(u + OFF_UB + ch), c0 = *(const half8*)(u + OFF_UC + ch), h0 = *(const half8*)(u + OFF_UH + ch);
            half8 c1 = c0 * (h16)0, h1 = c1, c2 = c1, h2 = c1;
            if (pos >= 1) { c1 = *(const half8*)(u - DINP + OFF_UC + ch); h1 = *(const half8*)(u - DINP + OFF_UH + ch); }
            if (pos >= 2) { c2 = *(const half8*)(u - 2 * DINP + OFF_UC + ch); h2 = *(const half8*)(u - 2 * DINP + OFF_UH + ch); }
#pragma unroll
            for (int j = 0; j < 8; ++j) {
                const float v0 = (float)c0[j] * (float)h0[j], v1 = (float)c1[j] * (float)h1[j], v2 = (float)c2[j] * (float)h2[j];
                const float z = wcb[8 * hf + j] + wc0[8 * hf + j] * v2 + wc1[8 * hf + j] * v1 + wc2[8 * hf + j] * v0;
                const float yy = (float)ub[j] * z; y[8 * hf + j] = yy; ss += yy * yy; }
        }
        ss = wave_sum(ss); const float rstd = rsqrtf(ss * (1.f / 1024.f) + EPS);
#pragma unroll
        for (int hf = 0; hf < 2; ++hf) { const int ch = 512 * hf + 8 * lane; float f[8];
#pragma unroll
            for (int j = 0; j < 8; ++j) f[j] = y[8 * hf + j] * rstd * wg[8 * hf + j];
            u32x4 o; o.x = pg8::pk_bf2(f[0], f[1]); o.y = pg8::pk_bf2(f[2], f[3]); o.z = pg8::pk_bf2(f[4], f[5]); o.w = pg8::pk_bf2(f[6], f[7]);
            *(u32x4*)(MIX + (size_t)r * DM + ch) = o; }
    }
}

__device__ __forceinline__ float gelu_tanh(float x) {
    const float z = 0.7978845608028654f * (x + 0.044715f * x * x * x);
    const float e = __expf(2.f * z);
    const float th = 1.f - 2.f / (e + 1.f);
    return 0.5f * x * (1.f + th);
}
__device__ __forceinline__ void compress_phase(const Ptrs& P, LAS unsigned char* lds, int G, int bid) {
    const int tid = threadIdx.x, lane = tid & 63, w = tid >> 6, fr = lane & 15, fq = lane >> 4;
    const h16* U = (const h16*)(P.ws + WS_U);
    LAS h16* hid = (LAS h16*)lds;
    for (int unit = bid; unit < 256; unit += G) {
        const int kv = unit >> 7, bg = (unit >> 4) & 7, nb = unit & 15, b = bg >> 1, g = bg & 1, n0 = nb * 32;
        const h16* W1t = (const h16*)(P.ws + (kv ? WS_CW1V : WS_CW1K));
        const h16* W2t = (const h16*)(P.ws + (kv ? WS_CW2V : WS_CW2K));
        const float* b1p = (const float*)(P.ws + WS_B1P) + kv * 32 * 256;
        h16* OUT = (h16*)(P.ws + (kv ? WS_VCMP : WS_KCMP)) + (size_t)bg * 512 * 128;
        const int coff = (kv ? OFF_VC : OFF_KC) + g * 128;
        f32x4 acc[2][2];
#pragma unroll
        for (int i = 0; i < 2; ++i)
#pragma unroll
            for (int j = 0; j < 2; ++j) acc[i][j] = (f32x4){0.f, 0.f, 0.f, 0.f};
        {   const h16* abase = U + (size_t)b * SEQ * DINP + coff;
            u32x4 st[17];
#pragma unroll
            for (int i = 0; i < 17; ++i) { const int c = tid + 512 * i; const int row = c >> 4, ch = c & 15; int tok = 512 * nb + row; tok = tok < SEQ ? tok : SEQ - 1;
                if (c < 528 * 16) st[i] = *(const u32x4*)(abase + (size_t)tok * DINP + 8 * ch); }
#pragma unroll
            for (int i = 0; i < 17; ++i) { const int c = tid + 512 * i; const int row = c >> 4, ch = c & 15;
                if (c < 528 * 16) *(LAS u32x4*)(lds + row * 256 + ((ch ^ ((row >> 4) & 15)) << 4)) = st[i]; }
        }
        half8 fb[3][4][2];
        const h16* brow[2];
#pragma unroll
        for (int nt = 0; nt < 2; ++nt) brow[nt] = W1t + (size_t)(32 * w + 16 * nt + fr) * 4096 + 8 * fq;
#define CP_LOADB(buf_, pos_) do { _Pragma("unroll") for (int ks = 0; ks < 4; ++ks) _Pragma("unroll") for (int nt = 0; nt < 2; ++nt) fb[buf_][ks][nt] = *(const half8*)(brow[nt] + (pos_) * 128 + 32 * ks); } while (0)
#define CP_MMA(bb_, pos_) do { half8 fa[4][2]; _Pragma("unroll") for (int mt = 0; mt < 2; ++mt) { const int rl = 16 * (16 * mt + fr) + (pos_); const int sw = (fr + ((pos_) >> 4)) & 15; \
            _Pragma("unroll") for (int ks = 0; ks < 4; ++ks) fa[ks][mt] = *(const LAS half8*)(lds + rl * 256 + (((4 * ks + fq) ^ sw) << 4)); } \
            _Pragma("unroll") for (int ks = 0; ks < 4; ++ks) _Pragma("unroll") for (int mt = 0; mt < 2; ++mt) _Pragma("unroll") for (int nt = 0; nt < 2; ++nt) \
            acc[mt][nt] = __builtin_amdgcn_mfma_f32_16x16x32_f16(fa[ks][mt], fb[bb_][ks][nt], acc[mt][nt], 0, 0, 0); } while (0)
        CP_LOADB(0, 0); CP_LOADB(1, 1);
        __syncthreads();
#pragma unroll 1
        for (int pos = 0; pos < 33; pos += 3) {
            if (pos + 2 < 32) CP_LOADB(2, pos + 2);
            CP_MMA(0, pos);
            if (pos + 3 < 32) CP_LOADB(0, pos + 3);
            if (pos + 1 < 32) CP_MMA(1, pos + 1);
            if (pos + 4 < 32) CP_LOADB(1, pos + 4);
            if (pos + 2 < 32) CP_MMA(2, pos + 2);
        }
#undef CP_LOADB
#undef CP_MMA
        __syncthreads();
#pragma unroll
        for (int nt = 0; nt < 2; ++nt) { const int col = 32 * w + 16 * nt + fr; float bias = 0.f;
            { float bp[8];
#pragma unroll
              for (int q = 0; q < 8; ++q) bp[q] = b1p[(8 * fq + q) * 256 + col];
              bias = ((bp[0] + bp[1]) + (bp[2] + bp[3])) + ((bp[4] + bp[5]) + (bp[6] + bp[7]));
              bias += __shfl_xor(bias, 16); bias += __shfl_xor(bias, 32); }
#pragma unroll
            for (int mt = 0; mt < 2; ++mt)
#pragma unroll
                for (int j = 0; j < 4; ++j) hid[(16 * mt + 4 * fq + j) * 264 + col] = (h16)gelu_tanh(acc[mt][nt][j] + bias); }
        __syncthreads();
        f32x4 acc2[2]; acc2[0] = (f32x4){0.f, 0.f, 0.f, 0.f}; acc2[1] = acc2[0];
#pragma unroll
        for (int ks = 0; ks < 8; ++ks) {
            const half8 bb = *(const half8*)(W2t + (size_t)(16 * w + fr) * 256 + 32 * ks + 8 * fq);
#pragma unroll
            for (int mt = 0; mt < 2; ++mt) { const half8 a = *(const LAS half8*)(hid + (16 * mt + fr) * 264 + 32 * ks + 8 * fq);
                acc2[mt] = __builtin_amdgcn_mfma_f32_16x16x32_f16(a, bb, acc2[mt], 0, 0, 0); }
        }
#pragma unroll
        for (int mt = 0; mt < 2; ++mt)
#pragma unroll
            for (int j = 0; j < 4; ++j) OUT[(size_t)(n0 + 16 * mt + 4 * fq + j) * 128 + 16 * w + fr] = (h16)acc2[mt][j];
        __syncthreads();
    }
}

typedef short s16x4 __attribute__((ext_vector_type(4)));
typedef short s16x8 __attribute__((ext_vector_type(8)));
template <bool a0, bool a1> __device__ __forceinline__ void af_qk(const LAS unsigned char* kbuf, const unsigned (&kl)[4], const half8 (&qf)[2][4], f32x4 (&s)[2][4]) {
    const LAS unsigned char* ka[4];
    { int _ln; asm volatile("v_mov_b32 %0, %1" : "=v"(_ln) : "v"(kl[0]));
      const int fr_ = _ln & 15, e_ = (_ln >> 4) ^ fr_;
#pragma unroll
      for (int ks = 0; ks < 4; ++ks) ka[ks] = kbuf + fr_ * 256 + ((e_ ^ (4 * ks)) << 4); }
    half8 kf[2][4];
#pragma unroll
    for (int ks = 0; ks < 4; ++ks) kf[0][ks] = *(const LAS half8*)(ka[ks]);
#pragma unroll
    for (int kt = 0; kt < 4; ++kt) {
        if (kt < 3) {
#pragma unroll
            for (int ks = 0; ks < 4; ++ks) kf[(kt + 1) & 1][ks] = *(const LAS half8*)(ka[ks] + (kt + 1) * 4096); }
        s[0][kt] = (f32x4){0.f, 0.f, 0.f, 0.f}; s[1][kt] = (f32x4){0.f, 0.f, 0.f, 0.f};
#pragma unroll
        for (int ks = 0; ks < 4; ++ks) {
            if (a0) s[0][kt] = __builtin_amdgcn_mfma_f32_16x16x32_f16(kf[kt & 1][ks], qf[0][ks], s[0][kt], 0, 0, 0);
            if (a1) s[1][kt] = __builtin_amdgcn_mfma_f32_16x16x32_f16(kf[kt & 1][ks], qf[1][ks], s[1][kt], 0, 0, 0); }
        __builtin_amdgcn_sched_barrier(0);
    }
}
template <bool a0, bool a1> __device__ __forceinline__ void af_pv(const LAS unsigned char* vbuf, unsigned vl0, int z, const half8 (&pf)[2][2], f32x4 (&o)[2][8]) {
    const unsigned rb = (unsigned)(__UINTPTR_TYPE__)(vbuf + vl0);
    s16x4 vr[2][8];
#define AF_VLOAD(buf_, dt_) asm volatile("ds_read_b64_tr_b16 %0, %8\n\tds_read_b64_tr_b16 %1, %8 offset:4096\n\tds_read_b64_tr_b16 %2, %8 offset:8192\n\tds_read_b64_tr_b16 %3, %8 offset:12288\n\t" \
        "ds_read_b64_tr_b16 %4, %9\n\tds_read_b64_tr_b16 %5, %9 offset:4096\n\tds_read_b64_tr_b16 %6, %9 offset:8192\n\tds_read_b64_tr_b16 %7, %9 offset:12288" \
        : "=&v"(vr[buf_][0]), "=&v"(vr[buf_][1]), "=&v"(vr[buf_][2]), "=&v"(vr[buf_][3]), "=&v"(vr[buf_][4]), "=&v"(vr[buf_][5]), "=&v"(vr[buf_][6]), "=&v"(vr[buf_][7]) \
        : "v"(rb + ((unsigned)((dt_) ^ z) << 5)), "v"(rb + ((unsigned)(((dt_) + 1) ^ z) << 5)) : "memory")
#define AF_VWAIT(buf_, n_) asm volatile("s_waitcnt lgkmcnt(" #n_ ")" : "+v"(vr[buf_][0]), "+v"(vr[buf_][1]), "+v"(vr[buf_][2]), "+v"(vr[buf_][3]), "+v"(vr[buf_][4]), "+v"(vr[buf_][5]), "+v"(vr[buf_][6]), "+v"(vr[buf_][7]) :: "memory")
#define AF_VMMA(buf_, dt0_) do { _Pragma("unroll") for (int dd = 0; dd < 2; ++dd) _Pragma("unroll") for (int kp = 0; kp < 2; ++kp) { \
            const s16x4 lo = vr[buf_][4 * dd + 2 * kp], hi = vr[buf_][4 * dd + 2 * kp + 1]; \
            s16x8 v8; v8[0] = lo[0]; v8[1] = lo[1]; v8[2] = lo[2]; v8[3] = lo[3]; v8[4] = hi[0]; v8[5] = hi[1]; v8[6] = hi[2]; v8[7] = hi[3]; \
            const half8 vf = __builtin_bit_cast(half8, v8); \
            if (a0) o[0][(dt0_) + dd] = __builtin_amdgcn_mfma_f32_16x16x32_f16(vf, pf[0][kp], o[0][(dt0_) + dd], 0, 0, 0); \
            if (a1) o[1][(dt0_) + dd] = __builtin_amdgcn_mfma_f32_16x16x32_f16(vf, pf[1][kp], o[1][(dt0_) + dd], 0, 0, 0); } \
        __builtin_amdgcn_sched_barrier(0); } while (0)
    AF_VLOAD(0, 0); AF_VLOAD(1, 2);
    AF_VWAIT(0, 8); AF_VMMA(0, 0); AF_VLOAD(0, 4);
    AF_VWAIT(1, 8); AF_VMMA(1, 2); AF_VLOAD(1, 6);
    AF_VWAIT(0, 8); AF_VMMA(0, 4);
    AF_VWAIT(1, 0); AF_VMMA(1, 6);
#undef AF_VMMA
#undef AF_VLOAD
#undef AF_VWAIT
}
__device__ __forceinline__ void af_maskraw(f32x4 (&s)[4], int mbase, int mstep, int fq, int hi, int lo) {
#pragma unroll
    for (int kt = 0; kt < 4; ++kt)
#pragma unroll
        for (int jj = 0; jj < 4; ++jj) { const int met = mbase + mstep * (16 * kt + 4 * fq + jj); s[kt][jj] = (met <= hi && met > lo) ? s[kt][jj] : -3.0e38f; }
}
__device__ __forceinline__ float af_colmax(const f32x4 (&s)[4]) {
    float v = -1.0e30f;
#pragma unroll
    for (int kt = 0; kt < 4; ++kt) v = fmaxf(v, fmaxf(fmaxf(s[kt][0], s[kt][1]), fmaxf(s[kt][2], s[kt][3])));
    v = fmaxf(v, __shfl_xor(v, 16)); v = fmaxf(v, __shfl_xor(v, 32)); return v;
}
__device__ __forceinline__ void af_pack(const f32x4 (&s)[4], half8 (&pf)[2]) {
#pragma unroll
    for (int kp = 0; kp < 2; ++kp) { half8 h;
#pragma unroll
        for (int jj = 0; jj < 4; ++jj) { h[jj] = (h16)s[2 * kp][jj]; h[4 + jj] = (h16)s[2 * kp + 1][jj]; }
        pf[kp] = h; }
}
__device__ __forceinline__ float af_rawmax(const f32x4 (&s)[4]) {
    float v = fmaxf(fmaxf(s[0][0], s[0][1]), fmaxf(s[0][2], s[0][3]));
#pragma unroll
    for (int kt = 1; kt < 4; ++kt) v = fmaxf(v, fmaxf(fmaxf(s[kt][0], s[kt][1]), fmaxf(s[kt][2], s[kt][3])));
    v = fmaxf(v, __shfl_xor(v, 16)); v = fmaxf(v, __shfl_xor(v, 32)); return v;
}
__device__ __forceinline__ void af_online_fast(f32x4 (&s)[4], bool colsel, float& m, float& l, f32x4 (&o)[8], half8 (&pf)[2], float SC) {
    float lm = fmaxf(fmaxf(s[0][0], s[0][1]), fmaxf(s[0][2], s[0][3]));
#pragma unroll
    for (int kt = 1; kt < 4; ++kt) lm = fmaxf(lm, fmaxf(fmaxf(s[kt][0], s[kt][1]), fmaxf(s[kt][2], s[kt][3])));
    if (__ballot(colsel && (lm * SC > m + 8.f)) != 0ull) {
        float v = lm; v = fmaxf(v, __shfl_xor(v, 16)); v = fmaxf(v, __shfl_xor(v, 32));
        const float mloc = colsel ? v * SC : -1.0e30f;
        const float mn = fmaxf(m, mloc); const float al = __builtin_amdgcn_exp2f(m - mn); m = mn;
        l *= al;
#pragma unroll
        for (int dt = 0; dt < 8; ++dt) o[dt] *= al;
    }
    const float bias = colsel ? -m : -1.0e30f; float ps = 0.f;
#pragma unroll
    for (int kt = 0; kt < 4; ++kt)
#pragma unroll
        for (int jj = 0; jj < 4; ++jj) { const float p = __builtin_amdgcn_exp2f(__builtin_fmaf(s[kt][jj], SC, bias)); s[kt][jj] = p; ps += p; }
    l += ps;
    af_pack(s, pf);
}
__device__ __forceinline__ void af_write(h16* Y, size_t row, int colbase, const f32x4 (&o)[8], float sc, bool accumulate) {
#pragma unroll
    for (int dt = 0; dt < 8; ++dt) { h16* p = Y + row * 1024 + colbase + 16 * dt; f32x4 v = o[dt] * sc;
        if (accumulate) { const half4 h = *(const half4*)p; v += (f32x4){(float)h[0], (float)h[1], (float)h[2], (float)h[3]}; }
        half4 hv; hv[0] = (h16)v[0]; hv[1] = (h16)v[1]; hv[2] = (h16)v[2]; hv[3] = (h16)v[3]; *(half4*)p = hv; }
}
__device__ __forceinline__ float af_sigmoid(float x) { return 1.f / (1.f + __expf(-x)); }

template <bool A0, bool A1>
__device__ __forceinline__ void af_tile_online(const LAS unsigned char* stage, const unsigned (&kl)[4], unsigned vl0, int vz, const half8 (&qf)[2][4], f32x4 (&s)[2][4],
                                               float (&m)[2], float (&l)[2], f32x4 (&o)[2][8], bool needmask, int mbase, int fq, const int (&hi)[2], const int (&lo)[2], float SC) {
    af_qk<A0, A1>(stage, kl, qf, s);
    half8 pf[2][2];
    if (A0) { if (needmask) af_maskraw(s[0], mbase, 1, fq, hi[0], lo[0]); af_online_fast(s[0], hi[0] >= 0, m[0], l[0], o[0], pf[0], SC); } else { pf[0][0] = qf[0][0]; pf[0][1] = qf[0][0]; }
    if (A1) { if (needmask) af_maskraw(s[1], mbase, 1, fq, hi[1], lo[1]); af_online_fast(s[1], hi[1] >= 0, m[1], l[1], o[1], pf[1], SC); } else { pf[1][0] = qf[1][0]; pf[1][1] = qf[1][0]; }
    af_pv<A0, A1>(stage + 16384, vl0, vz, pf, o);
}
#define AF_ISSUE(st_, kb_, vb_, gs_, r0_, needv_) do { int _ln; asm volatile("v_mov_b32 %0, %1" : "=v"(_ln) : "v"(lane)); \
      _Pragma("unroll") for (int _c = 0; _c < 2; ++_c) { const int _row = 8 * w + 4 * _c + (_ln >> 4); \
      const h16* _kp = (kb_) + (size_t)((r0_) + _row) * (gs_) + (((_ln & 15) ^ (_row & 15)) << 3); \
      __builtin_amdgcn_global_load_lds((const unsigned*)_kp, (LAS unsigned*)(lds + (st_) * 32768 + (2 * w + _c) * 1024), 16, 0, 0); \
      if (needv_) { const h16* _vp = (vb_) + (size_t)((r0_) + _row) * (gs_) + (((_ln & 15) ^ (2 * (_row & 7))) << 3); \
      __builtin_amdgcn_global_load_lds((const unsigned*)_vp, (LAS unsigned*)(lds + (st_) * 32768 + 16384 + (2 * w + _c) * 1024), 16, 0, 0); } } } while (0)
#define AF_WAITV(n) asm volatile("s_waitcnt vmcnt(" #n ")" ::: "memory")
#define AF_BAR() do { __builtin_amdgcn_s_barrier(); asm volatile("" ::: "memory"); } while (0)

__device__ __forceinline__ void attn_fast(const Ptrs& P, LAS unsigned char* lds, int G, int bid) {
    const int tid = threadIdx.x, lane = tid & 63, w = __builtin_amdgcn_readfirstlane(tid >> 6), fr = lane & 15, fq = lane >> 4, qi = fr >> 2, hh = fr & 3;
    LAS float* IMP = (LAS float*)(lds + 98304) + w * (8 * 132);
    LAS unsigned* SELM = (LAS unsigned*)(lds + 132096);
    const h16* U = (const h16*)(P.ws + WS_U); h16* Y = (h16*)(P.ws + WS_YACC);
    const float SC = 0.08838834764831845f * 1.4426950408889634f;
    const int NEGBIG = -(1 << 30);
    unsigned kl[4]; kl[0] = (unsigned)lane; kl[1] = kl[2] = kl[3] = 0u;
    const int vz = (4 * fq + (fr >> 2)) & 7;
    const unsigned vl0 = (unsigned)((4 * fq + (fr >> 2)) * 256 + 8 * (fr & 1) + 16 * ((fr >> 1) & 1));
    const int nunits = (512 + G - 1) / G;
#pragma unroll 1
    for (int ui = 0; ui < nunits; ++ui) {
        int b, qb;
        if (G == 256) { const int idx = (bid & 1) * 32 + (bid >> 3); b = (bid & 7) >> 1; qb = ui == 0 ? 127 - idx : idx; }
        else { const int u = ui * G + bid; if (u >= 512) break;
               b = u >> 7; qb = (((u & 1) ^ ((u >> 8) & 1)) != 0) ? 127 - ((u >> 1) & 63) : ((u >> 1) & 63); }
#pragma unroll 1
        for (int g = 0; g < 2; ++g) {
            const int bg = 2 * b + g;
            int tq[2]; tq[0] = 64 * qb + 8 * w + qi; tq[1] = tq[0] + 4;
            const h16* Ub = U + (size_t)b * SEQ * DINP;
            half8 qf[2][4];
#pragma unroll
            for (int ct = 0; ct < 2; ++ct)
#pragma unroll
                for (int ks = 0; ks < 4; ++ks) qf[ct][ks] = *(const half8*)(Ub + (size_t)tq[ct] * DINP + OFF_Q + (4 * g + hh) * 128 + 32 * ks + 8 * fq);
            for (int i = lane; i < 8 * 132; i += 64) IMP[i] = 0.f;
            f32x4 s[2][4];
            const h16* KC = (const h16*)(P.ws + WS_KCMP) + (size_t)bg * 512 * 128;
            const h16* VC = (const h16*)(P.ws + WS_VCMP) + (size_t)bg * 512 * 128;
            const int ntc = ((4 * qb + 2) >> 6) + 1;
            float m[2], l[2];
            m[0] = m[1] = -1.0e30f; l[0] = l[1] = 0.f;
            AF_ISSUE(0, KC, VC, 128, 0, false);
            if (ntc > 1) AF_ISSUE(1, KC, VC, 128, 64, false);
#pragma unroll 1
            for (int T = 0; T < ntc; ++T) {
                if (T + 1 < ntc) AF_WAITV(2); else AF_WAITV(0);
                AF_BAR();
                if (T + 2 < ntc) AF_ISSUE((T + 2) % 3, KC, VC, 128, 64 * (T + 2), false);
                af_qk<true, true>(lds + (T % 3) * 32768, kl, qf, s);
#pragma unroll
                for (int ct = 0; ct < 2; ++ct) {
                    if (1024 * T + 1039 > 64 * qb) af_maskraw(s[ct], 1024 * T + 31, 16, fq, tq[ct], NEGBIG);
                    const float mn = fmaxf(m[ct], af_rawmax(s[ct]) * SC); const float al = __builtin_amdgcn_exp2f(m[ct] - mn); m[ct] = mn; float ps = 0.f;
#pragma unroll
                    for (int kt = 0; kt < 4; ++kt)
#pragma unroll
                        for (int jj = 0; jj < 4; ++jj) ps += __builtin_amdgcn_exp2f(__builtin_fmaf(s[ct][kt][jj], SC, -mn));
                    l[ct] = l[ct] * al + ps; }
            }
            float il[2];
#pragma unroll
            for (int ct = 0; ct < 2; ++ct) { float lt = l[ct]; lt += __shfl_xor(lt, 16); lt += __shfl_xor(lt, 32); il[ct] = lt > 0.f ? 1.f / lt : 0.f; }
            f32x4 o[2][8];
#pragma unroll
            for (int ct = 0; ct < 2; ++ct)
#pragma unroll
                for (int dt = 0; dt < 8; ++dt) o[ct][dt] = (f32x4){0.f, 0.f, 0.f, 0.f};
            AF_BAR();
            AF_ISSUE(0, KC, VC, 128, 0, true);
            if (ntc > 1) AF_ISSUE(1, KC, VC, 128, 64, true);
#pragma unroll 1
            for (int T = 0; T < ntc; ++T) {
                if (T + 1 < ntc) AF_WAITV(4); else AF_WAITV(0);
                AF_BAR();
                if (T + 2 < ntc) AF_ISSUE((T + 2) % 3, KC, VC, 128, 64 * (T + 2), true);
                af_qk<true, true>(lds + (T % 3) * 32768, kl, qf, s);
                half8 pf[2][2];
#pragma unroll
                for (int ct = 0; ct < 2; ++ct) {
                    if (1024 * T + 1039 > 64 * qb) af_maskraw(s[ct], 1024 * T + 31, 16, fq, tq[ct], NEGBIG);
#pragma unroll
                    for (int kt = 0; kt < 4; ++kt) {
#pragma unroll
                        for (int jj = 0; jj < 4; ++jj) s[ct][kt][jj] = __builtin_amdgcn_exp2f(__builtin_fmaf(s[ct][kt][jj], SC, -m[ct])) * il[ct];
                        float s4 = (s[ct][kt][0] + s[ct][kt][1]) + (s[ct][kt][2] + s[ct][kt][3]), s3 = s[ct][kt][3];
                        s4 += __shfl_xor(s4, 1); s4 += __shfl_xor(s4, 2); s3 += __shfl_xor(s3, 1); s3 += __shfl_xor(s3, 2);
                        if (hh == 0) { LAS float* ip = IMP + (4 * ct + qi) * 132 + 16 * T + 4 * kt + fq;
                            __hip_atomic_fetch_add(ip, s4, __ATOMIC_RELAXED, __HIP_MEMORY_SCOPE_WORKGROUP);
                            __hip_atomic_fetch_add(ip + 1, s3, __ATOMIC_RELAXED, __HIP_MEMORY_SCOPE_WORKGROUP); }
                    }
                    af_pack(s[ct], pf[ct]); }
                af_pv<true, true>(lds + (T % 3) * 32768 + 16384, vl0, vz, pf, o);
            }
#pragma unroll
            for (int ct = 0; ct < 2; ++ct) { int _ln; asm volatile("v_mov_b32 %0, %1" : "=v"(_ln) : "v"(lane));
                const int fr_ = _ln & 15, fq_ = _ln >> 4, hh_ = fr_ & 3;
                const size_t row = (size_t)b * SEQ + 64 * qb + 8 * w + 4 * ct + (fr_ >> 2);
                const float g0 = af_sigmoid((float)U[row * DINP + OFF_GL + (4 * g + hh_) * 3 + 0]);
                af_write(Y, row, (4 * g + hh_) * 128 + 4 * fq_, o[ct], 64.f * g0, false); }
            __syncthreads();
#pragma unroll 1
            for (int ql = 0; ql < 8; ql += 2) {
                LAS float* rowa = IMP + ql * 132; LAS float* rowb = rowa + 132;
                float a0, a1, b0, b1;
                { const int j = lane; const bool valid = j <= qb, forced = (j == 0) || (j == qb) || (j == qb - 1); const float bonus = forced ? 1.0e4f : 0.f;
                  const float va = rowa[j], vb = rowb[j]; a0 = valid ? va + bonus : -1.f; b0 = valid ? vb + bonus : -1.f; rowa[j] = a0; rowb[j] = b0; }
                { const int j = lane + 64; const bool valid = j <= qb, forced = (j == 0) || (j == qb) || (j == qb - 1); const float bonus = forced ? 1.0e4f : 0.f;
                  const float va = rowa[j], vb = rowb[j]; a1 = valid ? va + bonus : -1.f; b1 = valid ? vb + bonus : -1.f; rowa[j] = a1; rowb[j] = b1; }
                int ra0 = 0, ra1 = 0, rb0 = 0, rb1 = 0;
                for (int j4 = 0; j4 <= qb; j4 += 4) { const f32x4 xa = *(const LAS f32x4*)(rowa + j4); const f32x4 xb = *(const LAS f32x4*)(rowb + j4);
#pragma unroll
                    for (int e = 0; e < 4; ++e) { const int j = j4 + e;
                        ra0 += (xa[e] > a0 || (xa[e] == a0 && j < lane)) ? 1 : 0; ra1 += (xa[e] > a1 || (xa[e] == a1 && j < lane + 64)) ? 1 : 0;
                        rb0 += (xb[e] > b0 || (xb[e] == b0 && j < lane)) ? 1 : 0; rb1 += (xb[e] > b1 || (xb[e] == b1 && j < lane + 64)) ? 1 : 0; } }
                const unsigned long long alo = __ballot(ra0 < 16 && lane <= qb), ahi = __ballot(ra1 < 16 && lane + 64 <= qb);
                const unsigned long long blo = __ballot(rb0 < 16 && lane <= qb), bhi = __ballot(rb1 < 16 && lane + 64 <= qb);
                if (lane == 0) { LAS unsigned* sp = SELM + (8 * w + ql) * 4; sp[0] = (unsigned)alo; sp[1] = (unsigned)(alo >> 32); sp[2] = (unsigned)ahi; sp[3] = (unsigned)(ahi >> 32);
                                 sp[4] = (unsigned)blo; sp[5] = (unsigned)(blo >> 32); sp[6] = (unsigned)bhi; sp[7] = (unsigned)(bhi >> 32); }
            }
            __syncthreads();
#pragma unroll 1
            for (int br = 1; br < 3; ++br) {
                const h16* KB = Ub + (br == 1 ? OFF_KS : OFF_KW) + g * 128;
                const h16* VB = Ub + (br == 1 ? OFF_VS : OFF_VW) + g * 128;
                const int j_lo = br == 1 ? 0 : (qb >= 8 ? qb - 8 : 0);
                const int nt = qb - j_lo + 1;
                m[0] = m[1] = -1.0e30f; l[0] = l[1] = 0.f;
#pragma unroll
                for (int ct = 0; ct < 2; ++ct)
#pragma unroll
                    for (int dt = 0; dt < 8; ++dt) o[ct][dt] = (f32x4){0.f, 0.f, 0.f, 0.f};
                AF_ISSUE(0, KB, VB, DINP, 64 * j_lo, true);
                if (nt > 1) AF_ISSUE(1, KB, VB, DINP, 64 * (j_lo + 1), true);
                if (nt > 2) AF_ISSUE(2, KB, VB, DINP, 64 * (j_lo + 2), true);
#pragma unroll 1
                for (int i = 0; i < nt; ++i) {
                    const int j = j_lo + i;
                    if (i + 2 < nt) AF_WAITV(8); else if (i + 1 < nt) AF_WAITV(4); else AF_WAITV(0);
                    AF_BAR();
                    if (i + 3 < nt) AF_ISSUE((i + 3) & 3, KB, VB, DINP, 64 * (j + 3), true);
                    int hi[2], lo[2]; bool act[2];
                    const bool needmask = (j == qb) || (br == 2 && 64 * j <= 64 * qb + 63 - 512);
#pragma unroll
                    for (int ct = 0; ct < 2; ++ct) {
                        if (br == 1) { const unsigned wd = SELM[(8 * w + 4 * ct + qi) * 4 + (j >> 5)]; const bool bit = (wd >> (j & 31)) & 1u;
                            act[ct] = __ballot(bit) != 0ull; hi[ct] = bit ? tq[ct] : -1; lo[ct] = NEGBIG; }
                        else { act[ct] = true; hi[ct] = tq[ct]; lo[ct] = tq[ct] - 512; }
                    }
                    const LAS unsigned char* stg = lds + (i & 3) * 32768;
                    if (act[0] && act[1]) af_tile_online<true, true>(stg, kl, vl0, vz, qf, s, m, l, o, needmask, 64 * j, fq, hi, lo, SC);
                    else if (act[0])      af_tile_online<true, false>(stg, kl, vl0, vz, qf, s, m, l, o, needmask, 64 * j, fq, hi, lo, SC);
                    else if (act[1])      af_tile_online<false, true>(stg, kl, vl0, vz, qf, s, m, l, o, needmask, 64 * j, fq, hi, lo, SC);
                }
#pragma unroll
                for (int ct = 0; ct < 2; ++ct) { int _ln; asm volatile("v_mov_b32 %0, %1" : "=v"(_ln) : "v"(lane));
                    const int fr_ = _ln & 15, fq_ = _ln >> 4, hh_ = fr_ & 3;
                    const size_t row = (size_t)b * SEQ + 64 * qb + 8 * w + 4 * ct + (fr_ >> 2);
                    float lt = l[ct]; lt += __shfl_xor(lt, 16); lt += __shfl_xor(lt, 32);
                    const float gg = af_sigmoid((float)U[row * DINP + OFF_GL + (4 * g + hh_) * 3 + br]);
                    af_write(Y, row, (4 * g + hh_) * 128 + 4 * fq_, o[ct], lt > 0.f ? 64.f * gg / lt : 0.f, true); }
                AF_BAR();
            }
        }
        {
            h16* MIX = (h16*)(P.ws + WS_H); const float* gw = P.in[15];
            int _ln; asm volatile("v_mov_b32 %0, %1" : "=v"(_ln) : "v"(lane));
            const int fr_ = _ln & 15, fq_ = _ln >> 4, hh_ = fr_ & 3;
#pragma unroll 1
            for (int ct = 0; ct < 2; ++ct) {
                const size_t row = (size_t)b * SEQ + 64 * qb + 8 * w + 4 * ct + (fr_ >> 2);
                float sv = 0.f;
#pragma unroll
                for (int g2 = 0; g2 < 2; ++g2)
#pragma unroll
                    for (int dt = 0; dt < 8; ++dt) { const half4 hv4 = *(const half4*)(Y + row * 1024 + (4 * g2 + hh_) * 128 + 16 * dt + 4 * fq_); const f32x4 v = {(float)hv4[0], (float)hv4[1], (float)hv4[2], (float)hv4[3]};
                        sv += (v[0] * v[0] + v[1] * v[1]) + (v[2] * v[2] + v[3] * v[3]); }
                sv += __shfl_xor(sv, 1); sv += __shfl_xor(sv, 2); sv += __shfl_xor(sv, 16); sv += __shfl_xor(sv, 32);
                const float rstd = rsqrtf(sv * (1.f / 1024.f) + 4096.f * EPS);
#pragma unroll 1
                for (int g2 = 0; g2 < 2; ++g2)
#pragma unroll
                    for (int dt = 0; dt < 8; ++dt) { const int ch = (4 * g2 + hh_) * 128 + 16 * dt + 4 * fq_;
                        const half4 hv4 = *(const half4*)(Y + row * 1024 + ch); const f32x4 v = {(float)hv4[0], (float)hv4[1], (float)hv4[2], (float)hv4[3]}; const f32x4 gv = *(const f32x4*)(gw + ch); const f32x4 ov = v * rstd * gv;
                        u32x2 wv; wv.x = pg8::pk_bf2(ov[0], ov[1]); wv.y = pg8::pk_bf2(ov[2], ov[3]);
                        *(u32x2*)(MIX + row * DM + 1024 + ch) = wv; }
            }
        }
    }
}

#define XB_TMO      128
#define XB_XCNT(j)  (256  + 64 * (j))
#define XB_XSUB(j)  (1280 + 64 * (j))
#define XB_XGEN(j)  (2304 + 64 * (j))
#define XB_TOP      3328
#define XB_TOPGEN   3392
#define XCD_BAR_WORDS 3456
#define XB_SPIN_CAP (1u << 18)
__device__ __forceinline__ unsigned xb_ld(unsigned* p)              { return __hip_atomic_load(p, __ATOMIC_RELAXED, __HIP_MEMORY_SCOPE_AGENT); }
__device__ __forceinline__ unsigned xb_add(unsigned* p, unsigned v) { return __hip_atomic_fetch_add(p, v, __ATOMIC_RELAXED, __HIP_MEMORY_SCOPE_AGENT); }
__device__ __forceinline__ unsigned xb_xcc_id() { return (unsigned)__builtin_amdgcn_s_getreg((3 << 11) | 20) & 0xFu; }
#define XB_SPIN(cond, bar) do { unsigned _sp = 0; while (cond) { __builtin_amdgcn_s_sleep(1); \
    if ((++_sp & 255u) == 0u) { if (xb_ld(&(bar)[XB_TMO])) break; if (_sp > XB_SPIN_CAP) { atomicAdd(&(bar)[XB_TMO], 1u); break; } } } } while (0)
struct XcdBarrier { unsigned* bar; unsigned x; volatile LAS unsigned* st; };
__device__ __forceinline__ XcdBarrier xcd_barrier_post(unsigned* bar, volatile LAS unsigned* st) {
    XcdBarrier b; b.bar = bar; b.x = xb_xcc_id(); b.st = st;
    if (threadIdx.x == 0) (void)xb_add(&bar[XB_XCNT(b.x)], 1u);
    return b;
}
__device__ __forceinline__ void xcd_barrier_complete(unsigned* bar, unsigned x, unsigned& nloc, unsigned& nx) {
    const unsigned G = gridDim.x * gridDim.y * gridDim.z;
    unsigned sum, cnt, mine, sp = 0u;
    for (;;) {
        sum = 0u; cnt = 0u; mine = 0u;
#pragma unroll
        for (unsigned j = 0; j < 16; ++j) { const unsigned c = xb_ld(&bar[XB_XCNT(j)]); sum += c; cnt += (c > 0u) ? 1u : 0u; mine = (j == x) ? c : mine; }
        if (sum == G) break;
        __builtin_amdgcn_s_sleep(1);
        if ((++sp & 255u) == 0u) { if (xb_ld(&bar[XB_TMO])) break; if (sp > XB_SPIN_CAP) { atomicAdd(&bar[XB_TMO], 1u); break; } }
    }
    nloc = mine > 0u ? mine : 1u; nx = cnt > 0u ? cnt : 1u;
}
__device__ __forceinline__ void xcd_barrier(const XcdBarrier& b) {
    asm volatile("s_waitcnt vmcnt(0)" ::: "memory");
    __syncthreads();
    if (threadIdx.x == 0) {
        unsigned* bar = b.bar;
        __builtin_amdgcn_s_waitcnt(0);
        unsigned nloc = b.st[0], nx = b.st[1];
        if (nloc == 0u) { xcd_barrier_complete(bar, b.x, nloc, nx); b.st[0] = nloc; b.st[1] = nx; }
        const unsigned old = xb_add(&bar[XB_XSUB(b.x)], 1u);
        const unsigned gen = old / nloc;
        if (old + 1u == (gen + 1u) * nloc) {
            __builtin_amdgcn_fence(__ATOMIC_RELEASE, "agent");
            asm volatile("s_waitcnt vmcnt(0)" ::: "memory");
            const unsigned og = xb_add(&bar[XB_TOP], 1u);
            const unsigned tg = og / nx;
            if (og + 1u == (tg + 1u) * nx) xb_add(&bar[XB_TOPGEN], 1u);
            else XB_SPIN(xb_ld(&bar[XB_TOPGEN]) == tg, bar);
            __builtin_amdgcn_fence(__ATOMIC_ACQUIRE, "agent");
            xb_add(&bar[XB_XGEN(b.x)], 1u);
            asm volatile("s_waitcnt vmcnt(0)" ::: "memory");
        } else {
            XB_SPIN(xb_ld(&bar[XB_XGEN(b.x)]) == gen, bar);
            __builtin_amdgcn_fence(__ATOMIC_ACQUIRE, "agent");
            asm volatile("s_waitcnt vmcnt(0)" ::: "memory");
        }
    }
    __syncthreads();
}

constexpr int NPHASE = 12;
struct Args { Ptrs p; int ph_lo, ph_hi; };

__global__ void __launch_bounds__(NTHR, 2) mega(Args args) {
    extern __shared__ __attribute__((aligned(16))) unsigned char lds_raw[];
    LAS unsigned char* lds = (LAS unsigned char*)lds_raw;
    const Ptrs& P = args.p;
    const int G = gridDim.x, bid = blockIdx.x;
    unsigned char* ws = P.ws;
    const float* mod = (const float*)(ws + WS_MOD);
    const int lo = args.ph_lo, hi = args.ph_hi;
    volatile LAS unsigned* MISC = (volatile LAS unsigned*)(lds + LDS_BYTES - 64);
    if (threadIdx.x < 16) MISC[threadIdx.x] = 0u;
    __syncthreads();
    XcdBarrier xbar; xbar.bar = (unsigned*)(ws + WS_BAR); xbar.x = 0; xbar.st = MISC;
    if (hi - lo > 1) xbar = xcd_barrier_post((unsigned*)(ws + WS_BAR), MISC);
#define PHASE_BEGIN(n) if (lo <= (n) && (n) < hi) {
#define PHASE_END(n) if ((n) + 1 < hi) { if (G != 256) cg::this_grid().sync(); else xcd_barrier(xbar); } }
    PHASE_BEGIN(0) p0_prologue(P, lds, G, bid); PHASE_END(0)
    PHASE_BEGIN(1) norm_mod_rows<false, false>(P.in[0], P.in[4], mod, 0, 2048, (h16*)(ws + WS_H), G, bid); PHASE_END(1)
    PHASE_BEGIN(2) { pg8::Gemm g{(const h16*)(ws + WS_H), (const h16*)(ws + WS_WIN), NT, DINP, DM}; pg8::StaticOrder S; S.init(NT, DINP, G, bid);
                  pg8::EpiF16<0> E{(h16*)(ws + WS_U), DINP}; pg8::gemm_phase<false>(lds, g, S, E); } PHASE_END(2)
    PHASE_BEGIN(3) post_u_rows(P, G, bid); PHASE_END(3)
    PHASE_BEGIN(4) compress_phase(P, lds, G, bid); PHASE_END(4)
    PHASE_BEGIN(5) attn_fast(P, lds, G, bid); PHASE_END(5)
    PHASE_BEGIN(7) { pg8::Gemm g{(const h16*)(ws + WS_H), (const h16*)(ws + WS_WOUT), NT, DM, DM}; pg8::StaticOrder S; S.init(NT, DM, G, bid);
                  pg8::EpiRes<true> E{P.in[0], (h16*)(ws + WS_X1H), mod + 2 * 2048, 12288}; pg8::gemm_phase<true>(lds, g, S, E); } PHASE_END(7)
    PHASE_BEGIN(8) norm_mod_rows<true, true>(ws + WS_X1H, P.in[17], mod, 3 * 2048, 4 * 2048, (h16*)(ws + WS_H), G, bid); PHASE_END(8)
    PHASE_BEGIN(9) { pg8::Gemm g{(const h16*)(ws + WS_H), (const h16*)(ws + WS_W1), NT, DFF, DM}; pg8::StaticOrder S; S.init(NT, DFF, G, bid);
                  pg8::EpiF16<1, true> E{(h16*)(ws + WS_HID), DFF}; pg8::gemm_phase<true>(lds, g, S, E); } PHASE_END(9)
    PHASE_BEGIN(10) { pg8::Gemm g{(const h16*)(ws + WS_HID), (const h16*)(ws + WS_W2), NT, DM, DFF}; pg8::StaticOrder S; S.init(NT, DM, G, bid);
                   pg8::EpiRes<false> E{ws + WS_X1H, (h16*)(ws + WS_X1H), mod + 5 * 2048, 12288}; pg8::gemm_phase<true>(lds, g, S, E); } PHASE_END(10)
    PHASE_BEGIN(11) final_norm_rows((const h16*)(ws + WS_X1H), P.out, P.in[20], G, bid); PHASE_END(11)
}

extern "C" void kernel_launch(void* const* d_in, const int* in_sizes, int n_in, void* d_out, int out_size, void* d_ws, size_t ws_size, hipStream_t stream) {
    static int grid = 0;
    if (grid == 0) {
        if (n_in != 21 || out_size != NT * DM || ws_size < WS_END2) { fprintf(stderr, "kernel_launch: unexpected shapes (n_in %d out %d ws %zu need %zu)\n", n_in, out_size, ws_size, (size_t)WS_END2); grid = -1; return; }
        int dev = 0, cus = 0, per_cu = 0;
        hipGetDevice(&dev); hipDeviceGetAttribute(&cus, hipDeviceAttributeMultiprocessorCount, dev);
        if (hipFuncSetAttribute((const void*)mega, hipFuncAttributeMaxDynamicSharedMemorySize, LDS_BYTES) != hipSuccess) { fprintf(stderr, "kernel_launch: hipFuncSetAttribute failed\n"); grid = -1; return; }
        if (hipOccupancyMaxActiveBlocksPerMultiprocessor(&per_cu, (const void*)mega, NTHR, LDS_BYTES) != hipSuccess || per_cu < 1) { fprintf(stderr, "kernel_launch: occupancy query says %d\n", per_cu); per_cu = 1; }
        (void)hipGetLastError();
        grid = cus * 1;
        fprintf(stderr, "kernel_launch: cus %d per_cu %d grid %d\n", cus, per_cu, grid);
    }
    if (grid < 0) return;
    if (hipMemsetAsync((char*)d_ws + WS_BAR, 0, WS_BAR_BYTES, stream) != hipSuccess) { fprintf(stderr, "kernel_launch: memset failed\n"); return; }
    Args a{};
    for (int i = 0; i < 21; ++i) a.p.in[i] = (const float*)d_in[i];
    a.p.out = (float*)d_out; a.p.ws = (unsigned char*)d_ws;
    a.ph_lo = 0; a.ph_hi = NPHASE;
    void* kargs[] = {&a};
    hipError_t e = hipLaunchCooperativeKernel((const void*)mega, dim3(grid), dim3(NTHR), kargs, LDS_BYTES, stream);
    if (e != hipSuccess) fprintf(stderr, "cooperative launch failed: %s (grid %d)\n", hipGetErrorString(e), grid);
}
```
